# Optimizing an MI355X kernel written in HIP

```python
import math
import jax, jax.numpy as jnp
from jax import lax
import numpy as np

D_MODEL = 2048
BATCH = 2
SEQ = 4096
DEPTH = 4

HEAD_DIM = 128
N_DIFF_HEADS = 4
N_NA_HEADS = 4
N_MEM_HEADS = 4
N_MEM = 256
DIFF_V_DIM = 2 * HEAD_DIM
DIFF_WIDTH = N_DIFF_HEADS * DIFF_V_DIM
NA_WIDTH = N_NA_HEADS * HEAD_DIM
MEM_WIDTH = N_MEM_HEADS * HEAD_DIM
MIX_WIDTH = DIFF_WIDTH + NA_WIDTH + MEM_WIDTH
DQ_W = N_DIFF_HEADS * 2 * HEAD_DIM
DK_W = N_DIFF_HEADS * 2 * HEAD_DIM
DV_W = DIFF_WIDTH
OFF_DQ = 0
OFF_DK = OFF_DQ + DQ_W
OFF_DV = OFF_DK + DK_W
OFF_NQ = OFF_DV + DV_W
OFF_NK = OFF_NQ + NA_WIDTH
OFF_NV = OFF_NK + NA_WIDTH
OFF_MQ = OFF_NV + NA_WIDTH
IN_WIDTH = OFF_MQ + MEM_WIDTH
ROPE_THETA = 500000.0
ROT_DIM = HEAD_DIM // 4
Q_BLOCK = 128
GRID_W = 64
MAX_WIN_H = 8
WIN_W = 16
PEER_HEADS = 8
N_KEYS = 128
N_EXPERTS = N_KEYS * N_KEYS
PEER_HALF = 128
PEER_KEY_DIM = 2 * PEER_HALF
PEER_TOPK = 16
PEER_TOK_BLOCK = 128
EPS = 1e-6

kernel_name = "hybrid_diffattn_natten_mem_peer_encoder"


def rms_norm(x, g):
    xf = x.astype(jnp.float32)
    y = xf * lax.rsqrt(jnp.mean(xf * xf, axis=-1, keepdims=True) + EPS) * g.astype(jnp.float32)
    return y.astype(x.dtype)


def rope_tables(seq):
    inv = ROPE_THETA ** (-jnp.arange(0, ROT_DIM, 2, dtype=jnp.float32) / ROT_DIM)
    ang = jnp.arange(seq, dtype=jnp.float32)[:, None] * inv[None, :]
    return jnp.cos(ang), jnp.sin(ang)


def partial_rope(x, cos, sin):
    half = ROT_DIM // 2
    shp = (cos.shape[0],) + (1,) * (x.ndim - 3) + (half,)
    c = cos.reshape(shp)
    s = sin.reshape(shp)
    xf = x.astype(jnp.float32)
    x1 = xf[..., :half]
    x2 = xf[..., half:ROT_DIM]
    out = jnp.concatenate([x1 * c - x2 * s, x2 * c + x1 * s, xf[..., ROT_DIM:]], axis=-1)
    return out.astype(x.dtype)


def diff_attention(q, k, v, lam, sub_g, lam_init):
    B, S = q.shape[0], q.shape[1]
    nb = S // Q_BLOCK
    scale = HEAD_DIM ** -0.5
    qb = q.reshape(B, nb, Q_BLOCK, N_DIFF_HEADS, 2, HEAD_DIM).swapaxes(0, 1)

    def block(qblk):
        s = jnp.einsum('bqhcd,bkhcd->bhcqk', qblk, k).astype(jnp.float32) * scale
        p = jax.nn.softmax(s, axis=-1)
        pd = p[:, :, 0] - lam * p[:, :, 1]
        return jnp.einsum('bhqk,bkhe->bqhe', pd.astype(v.dtype), v)

    o = lax.map(block, qb)
    o = o.swapaxes(0, 1).reshape(B, S, N_DIFF_HEADS, DIFF_V_DIM)
    o = rms_norm(o, sub_g) * (1.0 - lam_init)
    return o.reshape(B, S, DIFF_WIDTH)


def neighbourhood_attention(q, k, v, bias):
    B, S = q.shape[0], q.shape[1]
    R = S // GRID_W
    wh = min(MAX_WIN_H, R)
    scale = HEAD_DIM ** -0.5
    qg = q.reshape(B, R, GRID_W, N_NA_HEADS, HEAD_DIM)
    kg = k.reshape(B, R, GRID_W, N_NA_HEADS, HEAD_DIM)
    vg = v.reshape(B, R, GRID_W, N_NA_HEADS, HEAD_DIM)
    cols = jnp.arange(GRID_W)
    cs = jnp.clip(cols - WIN_W // 2, 0, GRID_W - WIN_W)
    cidx = cs[:, None] + jnp.arange(WIN_W)[None, :]
    dcol = cidx - cols[:, None] + (WIN_W - 1)

    def row(args):
        q_r, r = args
        rs = jnp.clip(r - wh // 2, 0, R - wh)
        kb = lax.dynamic_slice_in_dim(kg, rs, wh, axis=1)[:, :, cidx]
        vb = lax.dynamic_slice_in_dim(vg, rs, wh, axis=1)[:, :, cidx]
        drow = rs + jnp.arange(wh) - r + (MAX_WIN_H - 1)
        b_r = bias[:, drow[:, None, None], dcol[None, :, :]]
        s = jnp.einsum('bqhd,biqjhd->bhiqj', q_r, kb).astype(jnp.float32) * scale
        s = s + b_r.astype(jnp.float32)
        p = jax.nn.softmax(s, axis=(2, 4))
        return jnp.einsum('bhiqj,biqjhd->bqhd', p.astype(vb.dtype), vb)

    o = lax.map(row, (qg.swapaxes(0, 1), jnp.arange(R)))
    return o.swapaxes(0, 1).reshape(B, S, NA_WIDTH)


def memory_attention(q, mem_h, w_kv, gk):
    B, M = mem_h.shape[0], mem_h.shape[1]
    kv = (mem_h @ w_kv).reshape(B, M, 2, N_MEM_HEADS, HEAD_DIM)
    mk = rms_norm(kv[:, :, 0], gk)
    mv = kv[:, :, 1]
    s = jnp.einsum('bshd,bmhd->bhsm', q, mk).astype(jnp.float32) * (HEAD_DIM ** -0.5)
    p = jax.nn.softmax(s, axis=-1)
    o = jnp.einsum('bhsm,bmhd->bshd', p.astype(mv.dtype), mv)
    return o.reshape(q.shape[0], q.shape[1], MEM_WIDTH)


def peer_layer(h, w_pq, keys, u_tab, v_tab):
    B, S, D = h.shape
    q = (h @ w_pq).reshape(B, S, PEER_HEADS, 2, PEER_HALF)
    s = jnp.einsum('bshcd,hcnd->bshcn', q, keys).astype(jnp.float32)
    st, it = lax.top_k(s, PEER_TOPK)
    cand_s = (st[..., 0, :, None] + st[..., 1, None, :]).reshape(B, S, PEER_HEADS, PEER_TOPK * PEER_TOPK)
    cand_i = (it[..., 0, :, None] * N_KEYS + it[..., 1, None, :]).reshape(B, S, PEER_HEADS, PEER_TOPK * PEER_TOPK)
    top_s, pos = lax.top_k(cand_s, PEER_TOPK)
    ids = jnp.take_along_axis(cand_i, pos, axis=-1)
    g = jax.nn.softmax(top_s, axis=-1)
    T = B * S
    nblk = T // PEER_TOK_BLOCK
    hb = h.reshape(nblk, PEER_TOK_BLOCK, D)
    idb = ids.reshape(nblk, PEER_TOK_BLOCK, PEER_HEADS * PEER_TOPK)
    gb = g.reshape(nblk, PEER_TOK_BLOCK, PEER_HEADS * PEER_TOPK)

    def block(args):
        hx, idx, gx = args
        a = jnp.einsum('td,tkd->tk', hx, u_tab[idx]).astype(jnp.float32)
        a = jax.nn.gelu(a, approximate=False)
        return jnp.einsum('tk,tkd->td', (gx * a).astype(hx.dtype), v_tab[idx])

    out = lax.map(block, (hb, idb, gb))
    return out.reshape(B, S, D)


def setup_inputs(seed: int = 0) -> dict:
    key = jax.random.key(seed)
    ks = jax.random.split(key, 17)
    f32 = jnp.float32
    D = D_MODEL
    nrm = lambda k, shp, sc: jax.random.normal(k, shp, f32) * sc
    gain = lambda k, shp: 1.0 + 0.02 * jax.random.normal(k, shp, f32)
    return {
        "x": nrm(ks[0], (BATCH, SEQ, D), 1.0),
        "mem": nrm(ks[1], (BATCH, N_MEM, D), 1.0),
        "attn_norm": gain(ks[2], (DEPTH, D)),
        "w_in": nrm(ks[3], (DEPTH, D, IN_WIDTH), D ** -0.5),
        "qk_gain": gain(ks[4], (DEPTH, 6, HEAD_DIM)),
        "lambda_qk": nrm(ks[5], (DEPTH, 4, HEAD_DIM), 0.1),
        "subln_gain": gain(ks[6], (DEPTH, DIFF_V_DIM)),
        "na_bias": nrm(ks[7], (DEPTH, N_NA_HEADS, 2 * MAX_WIN_H - 1, 2 * WIN_W - 1), 0.1),
        "mem_norm": gain(ks[8], (DEPTH, D)),
        "w_mem_kv": nrm(ks[9], (DEPTH, D, 2 * MEM_WIDTH), D ** -0.5),
        "w_out": nrm(ks[10], (DEPTH, MIX_WIDTH, D), MIX_WIDTH ** -0.5),
        "ffn_norm": gain(ks[11], (DEPTH, D)),
        "w_pq": nrm(ks[12], (DEPTH, D, PEER_HEADS * PEER_KEY_DIM), D ** -0.5),
        "peer_keys": nrm(ks[13], (DEPTH, PEER_HEADS, 2, N_KEYS, PEER_HALF), PEER_HALF ** -0.5),
        "peer_u": nrm(ks[14], (DEPTH, N_EXPERTS, D), D ** -0.5),
        "peer_v": nrm(ks[15], (DEPTH, N_EXPERTS, D), 0.25),
    }


def reference(x, mem, attn_norm, w_in, qk_gain, lambda_qk, subln_gain, na_bias,
              mem_norm, w_mem_kv, w_out, ffn_norm, w_pq, peer_keys, peer_u, peer_v):
    B, S, _ = x.shape
    cos, sin = rope_tables(S)
    for l in range(DEPTH):
        lam_init = 0.8 - 0.6 * math.exp(-0.3 * l)
        h = rms_norm(x, attn_norm[l])
        proj = h @ w_in[l]
        gq = qk_gain[l]
        dq = proj[..., OFF_DQ:OFF_DK].reshape(B, S, N_DIFF_HEADS, 2, HEAD_DIM)
        dk = proj[..., OFF_DK:OFF_DV].reshape(B, S, N_DIFF_HEADS, 2, HEAD_DIM)
        dv = proj[..., OFF_DV:OFF_NQ].reshape(B, S, N_DIFF_HEADS, DIFF_V_DIM)
        dq = partial_rope(rms_norm(dq, gq[0]), cos, sin)
        dk = partial_rope(rms_norm(dk, gq[1]), cos, sin)
        lq = lambda_qk[l].astype(jnp.float32)
        lam = jnp.exp(jnp.sum(lq[0] * lq[1])) - jnp.exp(jnp.sum(lq[2] * lq[3])) + lam_init
        o_diff = diff_attention(dq, dk, dv, lam, subln_gain[l], lam_init)
        nq = rms_norm(proj[..., OFF_NQ:OFF_NK].reshape(B, S, N_NA_HEADS, HEAD_DIM), gq[2])
        nk = rms_norm(proj[..., OFF_NK:OFF_NV].reshape(B, S, N_NA_HEADS, HEAD_DIM), gq[3])
        nv = proj[..., OFF_NV:OFF_MQ].reshape(B, S, N_NA_HEADS, HEAD_DIM)
        o_na = neighbourhood_attention(nq, nk, nv, na_bias[l])
        mq = rms_norm(proj[..., OFF_MQ:IN_WIDTH].reshape(B, S, N_MEM_HEADS, HEAD_DIM), gq[4])
        o_mem = memory_attention(mq, rms_norm(mem, mem_norm[l]), w_mem_kv[l], gq[5])
        mix = jnp.concatenate([o_diff, o_na, o_mem], axis=-1)
        x = x + mix @ w_out[l]
        x = x + peer_layer(rms_norm(x, ffn_norm[l]), w_pq[l], peer_keys[l], peer_u[l], peer_v[l])
    return x
```

```cpp
#include <hip/hip_runtime.h>
#include <cstdio>
#include <cstdint>
namespace pg8 {
#define PG8_LAS __attribute__((address_space(3)))
typedef unsigned short bf16_t;
typedef short bf16x8 __attribute__((ext_vector_type(8)));
typedef float f32x4 __attribute__((ext_vector_type(4)));
typedef unsigned u32x4 __attribute__((ext_vector_type(4)));
constexpr int BM = 256, BK = 64, HALF = 128, HTB = HALF * BK * 2  , STAGE_BYTES = 8 * HTB, NXCD = 8, WGM = 8;

__host__ __device__ __forceinline__ int lds_byte(int r, int c) { const int st = (r >> 4) * 2 + (c >> 5), rr = r & 15, cc = c & 31, ob = rr * 64 + cc * 2; return st * 1024 + (ob ^ (((ob >> 9) & 1) << 5)); }
__host__ __device__ __forceinline__ void stage_rc(int b, int& R, int& C) { const int st = b / 1024, sb = b % 1024, swz = sb ^ (((sb >> 9) & 1) << 5); R = (st >> 1) * 16 + swz / 64; C = (st & 1) * 32 + (swz % 64) / 2; }
__host__ __device__ __forceinline__ int perm32(int rho) { const int n = rho >> 4, i = rho & 15; return 8 * (i >> 2) + 4 * n + (i & 3); }

struct Unit { int pm, pn; };
struct Gemm { const bf16_t* A; const bf16_t* Bt; int M, N, K; };

struct StaticOrder {
    int nM, nN, nwg, G, c;
    __host__ __device__ void init(int M, int N, int G_, int c_) { nM = M / BM; nN = N / BM; nwg = nM * nN; G = G_; c = c_; }
    __host__ __device__ bool next(int i, Unit& u) const {
        const long L = (long)i * G + c; if (L >= nwg) return false;
        int wgid = (int)L; { const int q = nwg / NXCD, r = nwg % NXCD, xcd = wgid % NXCD, off = wgid / NXCD; wgid = (xcd < r ? xcd * (q + 1) : r * (q + 1) + (xcd - r) * q) + off; }
        const int nig = WGM * nN, gid = wgid / nig, fm = gid * WGM, gsz = (nM - fm) < WGM ? (nM - fm) : WGM;
        u.pm = fm + ((wgid % nig) % gsz); u.pn = (wgid % nig) / gsz; return true;
    }
    __device__ __forceinline__ void a_ready(const Unit&) const {}
    __device__ __forceinline__ void done(const Unit&) const {}
};
struct CountedOrder : StaticOrder {
    const unsigned* ready; unsigned need; unsigned* tmo;
    __device__ __forceinline__ void a_ready(const Unit& u) const {
        if (threadIdx.x < 64) {
            const unsigned long long t0 = __builtin_amdgcn_s_memrealtime(); unsigned polls = 0;
            while ((unsigned)__builtin_amdgcn_readfirstlane(__hip_atomic_load(ready + 64 * u.pm, __ATOMIC_RELAXED, __HIP_MEMORY_SCOPE_AGENT)) < need) {
                if ((++polls & 255u) == 0u && __builtin_amdgcn_readfirstlane(__hip_atomic_load(tmo, __ATOMIC_RELAXED, __HIP_MEMORY_SCOPE_AGENT)) != 0u) break;
                if (__builtin_amdgcn_s_memrealtime() - t0 > 2000000ull) {
                    if (threadIdx.x == 0) { unsigned expect = 0u; __hip_atomic_compare_exchange_strong(tmo + 1, &expect, 0x600u | (unsigned)(u.pm & 0xff), __ATOMIC_RELAXED, __ATOMIC_RELAXED, __HIP_MEMORY_SCOPE_AGENT); __hip_atomic_store(tmo, 1u, __ATOMIC_RELAXED, __HIP_MEMORY_SCOPE_AGENT); }
                    break; }
                __builtin_amdgcn_s_sleep(2); }
            __builtin_amdgcn_fence(__ATOMIC_ACQUIRE, "agent");
            asm volatile("s_waitcnt vmcnt(0)" ::: "memory");
        }
#if !defined(BROKEN_HOOK_NO_BARRIER)
        asm volatile("" ::: "memory"); __builtin_amdgcn_s_barrier(); asm volatile("" ::: "memory");
#endif
    }
};

__device__ __forceinline__ unsigned cvt_pk_bf16(float lo, float hi) { unsigned r; asm volatile("v_cvt_pk_bf16_f32 %0, %1, %2" : "=v"(r) : "v"(lo), "v"(hi)); return r; }
typedef float f32x2 __attribute__((ext_vector_type(2)));
__device__ __forceinline__ f32x2 gelu_pk(f32x2 v) {
    const f32x2 av = __builtin_elementwise_abs(v), d = av * 0.2316418882f + 1.0f;
    f32x2 t; t.x = __builtin_amdgcn_rcpf(d.x); t.y = __builtin_amdgcn_rcpf(d.y);
    f32x2 q = t * 0.5307027145f + (-0.7265760135f); q = q * t + 0.7107068705f; q = q * t + (-0.142248368f); q = q * t + 0.127414796f; q = q * t;
    const f32x2 s = (v * v) * (-0.72134752044f);
    f32x2 e; e.x = __builtin_amdgcn_exp2f(s.x); e.y = __builtin_amdgcn_exp2f(s.y);
    const f32x2 m = v * (q * e), r = v - m;
    f32x2 o; o.x = v.x < 0.f ? m.x : r.x; o.y = v.y < 0.f ? m.y : r.y; return o;
}

struct EpiF32 {
    static constexpr bool PERM = false, AFTER_DRAIN = false;
    float* C; int ldc; const float* bias;
    __device__ __forceinline__ void operator()(const f32x4 (&acc)[2][2][4][2], const Unit& u, int wr, int wc, int fr, int fq) const {
        const int row0 = u.pm * BM + wr * 64 + fr, col0 = u.pn * BM + wc * 32 + 4 * fq;
        f32x4 bv[2][2];
#pragma unroll
        for (int bj = 0; bj < 2; ++bj)
#pragma unroll
            for (int n = 0; n < 2; ++n) bv[bj][n] = bias ? *(const f32x4*)(bias + col0 + bj * HALF + n * 16) : (f32x4){0.f, 0.f, 0.f, 0.f};
#pragma unroll
        for (int ai = 0; ai < 2; ++ai)
#pragma unroll
            for (int m = 0; m < 4; ++m) { float* rowp = C + (size_t)(row0 + ai * HALF + m * 16) * ldc + col0;
#pragma unroll
                for (int bj = 0; bj < 2; ++bj)
#pragma unroll
                    for (int n = 0; n < 2; ++n) *(f32x4*)(rowp + bj * HALF + n * 16) = acc[ai][bj][m][n] + bv[bj][n]; }
    }
};
template <int ACT  > struct EpiBf16 {
    static constexpr bool PERM = true, AFTER_DRAIN = false;
    bf16_t* O; int ldc; const float* bias; int split_cols; size_t split_stride;
    __device__ __forceinline__ void operator()(const f32x4 (&acc)[2][2][4][2], const Unit& u, int wr, int wc, int fr, int fq) const {
        const int row0 = u.pm * BM + wr * 64 + fr; int colt = u.pn * BM; bf16_t* base = O;
        if (split_cols) { const int t = colt / split_cols; base += (size_t)t * split_stride; colt -= t * split_cols; }
        const int col0 = colt + wc * 32 + 8 * fq, bcol0 = u.pn * BM + wc * 32 + 8 * fq;
        f32x4 bv[2][2];
#pragma unroll
        for (int bj = 0; bj < 2; ++bj)
#pragma unroll
            for (int n = 0; n < 2; ++n) bv[bj][n] = bias ? *(const f32x4*)(bias + bcol0 + bj * HALF + 4 * n) : (f32x4){0.f, 0.f, 0.f, 0.f};
#pragma unroll
        for (int ai = 0; ai < 2; ++ai)
#pragma unroll
            for (int m = 0; m < 4; ++m) { bf16_t* rowp = base + (size_t)(row0 + ai * HALF + m * 16) * ldc + col0;
#pragma unroll
                for (int bj = 0; bj < 2; ++bj) { f32x4 v0 = acc[ai][bj][m][0] + bv[bj][0], v1 = acc[ai][bj][m][1] + bv[bj][1];
                    if (ACT == 1) { f32x2 a = gelu_pk((f32x2){v0[0], v0[1]}), b = gelu_pk((f32x2){v0[2], v0[3]}), c = gelu_pk((f32x2){v1[0], v1[1]}), d = gelu_pk((f32x2){v1[2], v1[3]});
                        v0 = (f32x4){a.x, a.y, b.x, b.y}; v1 = (f32x4){c.x, c.y, d.x, d.y}; }
                    if (ACT == 2) {
#pragma unroll
                        for (int j = 0; j < 4; ++j) { v0[j] = 0.5f * v0[j] * (1.0f + erff(v0[j] * 0.70710678f)); v1[j] = 0.5f * v1[j] * (1.0f + erff(v1[j] * 0.70710678f)); } }
                    u32x4 w; w.x = cvt_pk_bf16(v0[0], v0[1]); w.y = cvt_pk_bf16(v0[2], v0[3]); w.z = cvt_pk_bf16(v1[0], v1[1]); w.w = cvt_pk_bf16(v1[2], v1[3]);
                    *(u32x4*)(rowp + bj * HALF) = w; } }
    }
};

template <class Epi, class Sched, bool STAMP = false>
__device__ __forceinline__ void gemm_phase(PG8_LAS unsigned char* lds, const Gemm g, const Sched& S, const Epi& E, unsigned long long* stamps) {
    int tid_ = threadIdx.x; asm volatile("" : "+v"(tid_));
    const int tid = tid_, wid = __builtin_amdgcn_readfirstlane(tid >> 6), lane = tid & 63, wr = wid >> 2, wc = wid & 3, fr = lane & 15, fq = lane >> 4;
    const int K = g.K, nt = K / BK;
    int ts_lo = 0, ts_hi = 0, nts = 0; const unsigned long long rt_entry = STAMP ? (unsigned long long)wall_clock64() : 0ull;
#define PG8_STAMP() do { if (STAMP && wid == 0 && nts < 64) { const unsigned long long _c = (unsigned long long)clock64(); \
        ts_lo = (lane == nts) ? (int)(unsigned)_c : ts_lo; ts_hi = (lane == nts) ? (int)(unsigned)(_c >> 32) : ts_hi; ++nts; } } while (0)
    PG8_STAMP();
    unsigned voffA[2], voffB[2];
#pragma unroll
    for (int i = 0; i < 2; ++i) { int R, C; stage_rc(tid * 16 + i * 8192, R, C); const int Rb = Epi::PERM ? ((R & ~31) + perm32(R & 31)) : R;
        voffA[i] = (unsigned)(R * K + C) * 2u; voffB[i] = (unsigned)(Rb * K + C) * 2u; }
    const size_t kstep = (size_t)(BK * 2);
    const size_t hstep = (size_t)HALF * K * 2;
    const size_t tstep = 2 * hstep;
    const unsigned ldsw = (unsigned)wid * 1024u;
    const int aoff = lds_byte(wr * 64 + fr, fq * 8), boff = lds_byte(wc * 32 + fr, fq * 8);
#define PG8_SA(b, h) (((b) * 2 + (h)) * HTB)
#define PG8_SB(b, h) ((4 + (b) * 2 + (h)) * HTB)
#define PG8_STAGE(bufoff, gbase, voff) do { _Pragma("unroll") for (int _i = 0; _i < 2; ++_i) \
        __builtin_amdgcn_global_load_lds((const unsigned*)((const char*)(gbase) + (voff)[_i]), (PG8_LAS unsigned*)(lds + (bufoff) + ldsw + _i * 8192), 16, 0, 0); } while (0)
#define PG8_LDA(dst, b, h) do { _Pragma("unroll") for (int m = 0; m < 4; ++m) _Pragma("unroll") for (int k = 0; k < 2; ++k) dst[m][k] = *(const PG8_LAS bf16x8*)(lds + PG8_SA(b, h) + aoff + m * 2048 + k * 1024); } while (0)
#define PG8_LDB(dst, b, h) do { _Pragma("unroll") for (int n = 0; n < 2; ++n) _Pragma("unroll") for (int k = 0; k < 2; ++k) dst[n][k] = *(const PG8_LAS bf16x8*)(lds + PG8_SB(b, h) + boff + n * 2048 + k * 1024); } while (0)
#define PG8_MMA(ai, bj, At, Bt) do { __builtin_amdgcn_s_setprio(1); _Pragma("unroll") for (int m = 0; m < 4; ++m) _Pragma("unroll") for (int n = 0; n < 2; ++n) _Pragma("unroll") for (int k = 0; k < 2; ++k) \
        acc[ai][bj][m][n] = __builtin_amdgcn_mfma_f32_16x16x32_bf16(Bt[n][k], At[m][k], acc[ai][bj][m][n], 0, 0, 0); __builtin_amdgcn_s_setprio(0); } while (0)
#define PG8_WAIT_V(n) asm volatile("s_waitcnt vmcnt(" #n ")" ::: "memory")
#define PG8_WAIT_L(n) asm volatile("s_waitcnt lgkmcnt(" #n ")" ::: "memory")
#define PG8_BAR __builtin_amdgcn_s_barrier()
#define PG8_SCHED __builtin_amdgcn_sched_barrier(0)
    Unit cur, nxt; int ui = 0;
    if (!S.next(0, cur)) return;
    f32x4 acc[2][2][4][2];
#pragma unroll
    for (int a = 0; a < 2; ++a)
#pragma unroll
        for (int b = 0; b < 2; ++b)
#pragma unroll
            for (int m = 0; m < 4; ++m)
#pragma unroll
                for (int n = 0; n < 2; ++n) acc[a][b][m][n] = (f32x4){0.f, 0.f, 0.f, 0.f};
    bf16x8 At[4][2], B0[2][2], B1[2][2];
    const char* cA = (const char*)g.A + (size_t)cur.pm * tstep; const char* cB = (const char*)g.Bt + (size_t)cur.pn * tstep;
    S.a_ready(cur);
    PG8_STAGE(PG8_SB(0, 0), cB, voffB); PG8_STAGE(PG8_SA(0, 0), cA, voffA); PG8_STAGE(PG8_SB(0, 1), cB + hstep, voffB); PG8_STAGE(PG8_SA(0, 1), cA + hstep, voffA);
    if (wr == 1) PG8_BAR;
    PG8_WAIT_V(4); PG8_BAR;
    PG8_STAGE(PG8_SB(1, 0), cB + kstep, voffB); PG8_STAGE(PG8_SA(1, 0), cA + kstep, voffA); PG8_STAGE(PG8_SB(1, 1), cB + hstep + kstep, voffB);
    PG8_WAIT_V(6); PG8_BAR;
    PG8_STAMP();
    for (;;) {
        const bool has_next = S.next(ui + 1, nxt);
        const char* nA = has_next ? (const char*)g.A + (size_t)nxt.pm * tstep : cA; const char* nB = has_next ? (const char*)g.Bt + (size_t)nxt.pn * tstep : cB;
        for (int t = 0; t < nt; t += 2) {
            const bool last = (t == nt - 2);
            const char* a1 = cA + (size_t)(t + 1) * kstep;
            const char* a2 = last ? nA : cA + (size_t)(t + 2) * kstep; const char* b2 = last ? nB : cB + (size_t)(t + 2) * kstep;
            const char* a3 = a2 + kstep; const char* b3 = b2 + kstep;
            if (last && has_next) S.a_ready(nxt);
            PG8_LDB(B0, 0, 0); PG8_SCHED; PG8_LDA(At, 0, 0); PG8_STAGE(PG8_SA(1, 1), a1 + hstep, voffA);
            PG8_WAIT_L(8); PG8_BAR; PG8_WAIT_L(0); PG8_MMA(0, 0, At, B0); PG8_BAR; PG8_SCHED;
            PG8_LDB(B1, 0, 1); PG8_STAGE(PG8_SB(0, 0), b2, voffB);
            PG8_BAR; PG8_WAIT_L(0); PG8_MMA(0, 1, At, B1); PG8_BAR;
            PG8_LDA(At, 0, 1); PG8_STAGE(PG8_SA(0, 0), a2, voffA);
            PG8_BAR; PG8_WAIT_L(0); PG8_MMA(1, 0, At, B0); PG8_BAR; PG8_SCHED;
            PG8_STAGE(PG8_SB(0, 1), b2 + hstep, voffB);
            PG8_WAIT_V(6); PG8_BAR; PG8_MMA(1, 1, At, B1); PG8_BAR;
            PG8_LDB(B0, 1, 0); PG8_SCHED; PG8_LDA(At, 1, 0); PG8_STAGE(PG8_SA(0, 1), a2 + hstep, voffA);
            PG8_WAIT_L(8); PG8_BAR; PG8_WAIT_L(0); PG8_MMA(0, 0, At, B0); PG8_BAR; PG8_SCHED;
            PG8_LDB(B1, 1, 1); PG8_STAGE(PG8_SB(1, 0), b3, voffB);
            PG8_BAR; PG8_WAIT_L(0); PG8_MMA(0, 1, At, B1); PG8_BAR;
            PG8_LDA(At, 1, 1); PG8_STAGE(PG8_SA(1, 0), a3, voffA);
            PG8_BAR; PG8_WAIT_L(0); PG8_MMA(1, 0, At, B0); PG8_BAR; PG8_SCHED;
            PG8_STAGE(PG8_SB(1, 1), b3 + hstep, voffB);
            PG8_WAIT_V(6); PG8_BAR; PG8_MMA(1, 1, At, B1); PG8_BAR;
        }
        PG8_STAMP();
        if constexpr (!Epi::AFTER_DRAIN) { E(acc, cur, wr, wc, fr, fq); S.done(cur); }
        PG8_STAMP();
        if (!has_next) break;
#pragma unroll
        for (int a = 0; a < 2; ++a)
#pragma unroll
            for (int b = 0; b < 2; ++b)
#pragma unroll
                for (int m = 0; m < 4; ++m)
#pragma unroll
                    for (int n = 0; n < 2; ++n) acc[a][b][m][n] = (f32x4){0.f, 0.f, 0.f, 0.f};
        cur = nxt; cA = nA; cB = nB; ++ui;
    }
    PG8_WAIT_V(0);
    if (wr == 0) PG8_BAR;
    PG8_BAR;
    if constexpr (Epi::AFTER_DRAIN) { E.fused(acc, cur, wr, wc, fr, fq, lds, wid, lane); S.done(cur); }
    PG8_STAMP();
    if (STAMP && wid == 0) { stamps[lane] = lane < nts ? (((unsigned long long)(unsigned)ts_hi << 32) | (unsigned)ts_lo) : 0ull;
        if (lane == 62) stamps[62] = rt_entry; if (lane == 63) stamps[63] = (unsigned long long)wall_clock64(); }
#undef PG8_STAMP
#undef PG8_SA
#undef PG8_SB
#undef PG8_STAGE
#undef PG8_LDA
#undef PG8_LDB
#undef PG8_MMA
#undef PG8_WAIT_V
#undef PG8_WAIT_L
#undef PG8_BAR
#undef PG8_SCHED
}
}
namespace sel {
#define SEL_HD __host__ __device__ __forceinline__
SEL_HD int imax(int a, int b) { return a > b ? a : b; }
SEL_HD int imin(int a, int b) { return a < b ? a : b; }
SEL_HD int f2key(float f) { int b = __builtin_bit_cast(int, f); return b ^ ((b >> 31) & 0x7fffffff); }
SEL_HD float key2f(int k) { int b = k ^ ((k >> 31) & 0x7fffffff); return __builtin_bit_cast(float, b); }
template <int N> SEL_HD void sort_desc(int (&a)[N]) {
#pragma unroll
    for (int k = 2; k <= N; k <<= 1) {
#pragma unroll
        for (int j = k >> 1; j > 0; j >>= 1) {
#pragma unroll
            for (int i = 0; i < N; ++i) {
                const int l = i ^ j;
                if (l > i) { const bool desc = ((i & k) == 0); const int hi = imax(a[i], a[l]), lo = imin(a[i], a[l]); a[i] = desc ? hi : lo; a[l] = desc ? lo : hi; }
            }
        }
    }
}
SEL_HD void merge_desc16(int (&a)[16]) {
#pragma unroll
    for (int j = 8; j > 0; j >>= 1) {
#pragma unroll
        for (int i = 0; i < 16; ++i) { const int l = i ^ j; if (l > i) { const int hi = imax(a[i], a[l]), lo = imin(a[i], a[l]); a[i] = hi; a[l] = lo; } }
    }
}
SEL_HD void top16_merge(int (&a)[16], const int (&b)[16]) {
#pragma unroll
    for (int i = 0; i < 16; ++i) a[i] = imax(a[i], b[15 - i]);
    merge_desc16(a);
}
SEL_HD void cand_top16(const int (&a)[16], const int (&b)[16], int (&c0)[16]) {
    float av[16], bv[16];
#pragma unroll
    for (int i = 0; i < 16; ++i) { av[i] = key2f(a[i] & ~127); bv[i] = key2f(b[i] & ~127); }
    int c1[16], c2[16], c3[16];
#pragma unroll
    for (int i = 0; i < 16; ++i) { c0[i] = (int)0x80000000; c1[i] = (int)0x80000000; c2[i] = (int)0x80000000; c3[i] = (int)0x80000000; }
    {
        int n = 0;
#pragma unroll
        for (int i = 0; i < 16; ++i) {
#pragma unroll
            for (int j = 0; j < 16; ++j) {
                if ((i + 1) * (j + 1) <= 16) {
                    const int key = (f2key(av[i] + bv[j]) & ~255) | (i << 4) | j;
                    if (n < 16) c0[n & 15] = key; else if (n < 32) c1[n & 15] = key; else if (n < 48) c2[n & 15] = key; else c3[n & 15] = key;
                    ++n;
                }
            }
        }
    }
    sort_desc(c0); sort_desc(c1); sort_desc(c2); sort_desc(c3);
    top16_merge(c0, c1); top16_merge(c2, c3); top16_merge(c0, c2);
}
}
namespace att {
using bf16 = unsigned short;
constexpr int   D = 128, NW = 8, QBLK = 32, KVBLK = 64;
constexpr float SCALE = 0.088388347648318440f;
constexpr float THR = 8.f;
constexpr size_t SHM_V = KVBLK * D * 2, SHM_K = KVBLK * D * 2, SHM_ATTN = 2 * SHM_V + 2 * SHM_K + NW * 64 * 4;
constexpr size_t SHM_NA_BIAS = SHM_ATTN;
using bf16x8 = __attribute__((ext_vector_type(8))) short;
using s16x4  = __attribute__((ext_vector_type(4))) short;
using f32x16 = __attribute__((ext_vector_type(16))) float;
using u32x4  = __attribute__((ext_vector_type(4))) unsigned;
#define KSWZ(row, colB) ((row) * 256 + ((colB) ^ (((row) & 7) << 4)))
#define SBAR() __builtin_amdgcn_sched_barrier(0)
__device__ __forceinline__ int crow(int r, int hi) { return (r & 3) + 8 * (r >> 2) + 4 * hi; }
__device__ __forceinline__ unsigned cvtpk(float lo, float hi) { unsigned r; asm volatile("v_cvt_pk_bf16_f32 %0, %1, %2" : "=v"(r) : "v"(lo), "v"(hi)); return r; }
__device__ __forceinline__ bf16x8 ld8(const bf16* p) { return *reinterpret_cast<const bf16x8*>(p); }

__device__ __forceinline__ void partialSM(f32x16& p0, f32x16& p1, float& m_reg, float& mn, float& alpha) {
  constexpr float C = SCALE * 1.4426950408889634f;
  float pmax = p0[0]; for (int r = 1; r < 16; ++r) pmax = fmaxf(pmax, p0[r]); for (int r = 0; r < 16; ++r) pmax = fmaxf(pmax, p1[r]);
  { auto rr = __builtin_amdgcn_permlane32_swap(__float_as_uint(pmax), __float_as_uint(pmax), false, false);
    pmax = fmaxf(__uint_as_float(rr[0]), __uint_as_float(rr[1])); }
  if (__builtin_expect(__all(pmax - m_reg <= THR / SCALE), 1)) { mn = m_reg; alpha = 1.f; }
  else { mn = fmaxf(m_reg, pmax); alpha = __builtin_amdgcn_exp2f((m_reg - mn) * C); m_reg = mn; }
  float mnC = -mn * C;
  for (int r = 0; r < 16; ++r) p0[r] = fmaf(p0[r], C, mnC); for (int r = 0; r < 16; ++r) p1[r] = fmaf(p1[r], C, mnC);
  for (int r = 0; r < 16; ++r) p0[r] = __builtin_amdgcn_exp2f(p0[r]);
}
__device__ __forceinline__ void partialSM_na(f32x16& p0, f32x16& p1, float& m_reg, float& mn, float& alpha, const float* brow, bool rowok, int c, int cs, int hi) {
  constexpr float C = SCALE * 1.4426950408889634f;
  const float ninf = -__builtin_inff();
#pragma unroll
  for (int r = 0; r < 16; ++r) {
    const int kc0 = crow(r, hi), kc1 = 32 + kc0;
    const bool ok0 = rowok && ((unsigned)(kc0 - cs) < 16u), ok1 = rowok && ((unsigned)(kc1 - cs) < 16u);
    const int d0 = ok0 ? (kc0 - c + 15) : 0, d1 = ok1 ? (kc1 - c + 15) : 0;
    const float b0 = brow[d0], b1 = brow[d1];
    p0[r] = ok0 ? fmaf(p0[r], C, b0) : ninf;
    p1[r] = ok1 ? fmaf(p1[r], C, b1) : ninf;
  }
  float pmax = p0[0]; for (int r = 1; r < 16; ++r) pmax = fmaxf(pmax, p0[r]); for (int r = 0; r < 16; ++r) pmax = fmaxf(pmax, p1[r]);
  { auto rr = __builtin_amdgcn_permlane32_swap(__float_as_uint(pmax), __float_as_uint(pmax), false, false);
    pmax = fmaxf(__uint_as_float(rr[0]), __uint_as_float(rr[1])); }
  if (__all(pmax - m_reg <= THR * 1.4426950408889634f)) { mn = m_reg; alpha = 1.f; }
  else { mn = fmaxf(m_reg, pmax); alpha = __builtin_amdgcn_exp2f(m_reg - mn); m_reg = mn; }
  for (int r = 0; r < 16; ++r) p0[r] = p0[r] - mn; for (int r = 0; r < 16; ++r) p1[r] = p1[r] - mn;
  for (int r = 0; r < 16; ++r) p0[r] = __builtin_amdgcn_exp2f(p0[r]);
}
__device__ __forceinline__ void finishSM(f32x16& p0, f32x16& p1, float alpha, float& l_reg, bf16x8& pa0, bf16x8& pa1, bf16x8& pa2, bf16x8& pa3) {
  for (int r = 0; r < 16; ++r) p1[r] = __builtin_amdgcn_exp2f(p1[r]);
  float ps = 0; for (int r = 0; r < 16; ++r) ps += p0[r]; for (int r = 0; r < 16; ++r) ps += p1[r];
  { auto rr = __builtin_amdgcn_permlane32_swap(__float_as_uint(ps), __float_as_uint(ps), false, false);
    ps = __uint_as_float(rr[0]) + __uint_as_float(rr[1]); }
  l_reg = l_reg * alpha + ps;
#define PK4(P, BASE, OUT) do { unsigned a0 = cvtpk(P[BASE + 0], P[BASE + 1]), a1 = cvtpk(P[BASE + 2], P[BASE + 3]);   \
    unsigned b0 = cvtpk(P[BASE + 4], P[BASE + 5]), b1 = cvtpk(P[BASE + 6], P[BASE + 7]);                              \
    auto r0 = __builtin_amdgcn_permlane32_swap(a0, b0, false, false); auto r1 = __builtin_amdgcn_permlane32_swap(a1, b1, false, false); \
    u32x4 w = {r0[0], r1[0], r0[1], r1[1]}; OUT = *reinterpret_cast<bf16x8*>(&w); } while (0)
  PK4(p0, 0, pa0); PK4(p0, 8, pa1); PK4(p1, 0, pa2); PK4(p1, 8, pa3);
#undef PK4
}
__device__ __forceinline__ void qkt(f32x16& p0, f32x16& p1, const bf16* Ks, const bf16x8* qr, int r32, int hi) {
  p0 = f32x16{}; p1 = f32x16{};
  for (int d0 = 0; d0 < 8; ++d0) { int cb = (d0 * 16 + hi * 8) * 2;
    bf16x8 b0 = *reinterpret_cast<const bf16x8*>((const char*)Ks + KSWZ(r32, cb));
    bf16x8 b1 = *reinterpret_cast<const bf16x8*>((const char*)Ks + KSWZ(32 + r32, cb));
    p0 = __builtin_amdgcn_mfma_f32_32x32x16_bf16(b0, qr[d0], p0, 0, 0, 0);
    p1 = __builtin_amdgcn_mfma_f32_32x32x16_bf16(b1, qr[d0], p1, 0, 0, 0); }
}
__device__ __forceinline__ int v_st(int k, int c) { const int kk = (k & ~0xC) | ((k & 4) << 1) | ((k & 8) >> 1); return ((kk >> 3) * 4 + (c >> 5)) * 512 + ((kk & 7) * 32 + (c & 31)) * 2; }
__device__ __forceinline__ int v_rd_base(int lane) { return ((lane & 3) << 3) | (((lane >> 2) & 3) << 6) | (((lane >> 4) & 1) << 5) | (((lane >> 5) & 1) << 8); }
constexpr int v_rd_off(int d0, int ks, int half) { return d0 * 512 + ks * 4096 + half * 2048; }
template <int OFF> __device__ __forceinline__ s16x4 tr_read(int vb) {
  s16x4 r; asm volatile("ds_read_b64_tr_b16 %0, %1 offset:%2" : "=&v"(r) : "v"(vb), "i"(OFF) : "memory"); return r;
}
template <int D0> __device__ __forceinline__ void pv_one(f32x16& od, int vb, bf16x8 pa0, bf16x8 pa1, bf16x8 pa2, bf16x8 pa3) {
  const s16x4 l0 = tr_read<v_rd_off(D0, 0, 0)>(vb), h0 = tr_read<v_rd_off(D0, 0, 1)>(vb), l1 = tr_read<v_rd_off(D0, 1, 0)>(vb), h1 = tr_read<v_rd_off(D0, 1, 1)>(vb);
  const s16x4 l2 = tr_read<v_rd_off(D0, 2, 0)>(vb), h2 = tr_read<v_rd_off(D0, 2, 1)>(vb), l3 = tr_read<v_rd_off(D0, 3, 0)>(vb), h3 = tr_read<v_rd_off(D0, 3, 1)>(vb);
  asm volatile("s_waitcnt lgkmcnt(0)" ::: "memory"); SBAR();
#define PK(L, H) (bf16x8){L[0], L[1], L[2], L[3], H[0], H[1], H[2], H[3]}
  od = __builtin_amdgcn_mfma_f32_32x32x16_bf16(pa0, PK(l0, h0), od, 0, 0, 0);
  od = __builtin_amdgcn_mfma_f32_32x32x16_bf16(pa1, PK(l1, h1), od, 0, 0, 0);
  od = __builtin_amdgcn_mfma_f32_32x32x16_bf16(pa2, PK(l2, h2), od, 0, 0, 0);
  od = __builtin_amdgcn_mfma_f32_32x32x16_bf16(pa3, PK(l3, h3), od, 0, 0, 0);
#undef PK
}
__device__ __forceinline__ void pv_d0(f32x16* o, int vb, bf16x8 pa0, bf16x8 pa1, bf16x8 pa2, bf16x8 pa3) {
  pv_one<0>(o[0], vb, pa0, pa1, pa2, pa3); pv_one<1>(o[1], vb, pa0, pa1, pa2, pa3); pv_one<2>(o[2], vb, pa0, pa1, pa2, pa3); pv_one<3>(o[3], vb, pa0, pa1, pa2, pa3);
}

template <int MODE, int SDEPTH, int LDQ, int LDK, int LDV, int LDO, bool OBF>
__device__ __forceinline__ void attn_body(const bf16* __restrict__ Qb, const bf16* __restrict__ Kh, const bf16* __restrict__ Vh,
                                          void* __restrict__ Obv, int seq, char* lds, int r0, int kr0) {
  int tid_ = threadIdx.x; asm volatile("" : "+v"(tid_));
  const int tid = tid_, wid = tid >> 6, lane = tid & 63, r32 = lane & 31, hi = lane >> 5;
  bf16* V_lds = (bf16*)lds; bf16* K_lds = (bf16*)(lds + 2 * SHM_V);
  float* ws = (float*)(lds + 2 * SHM_V + 2 * SHM_K) + wid * 64; float* li_l = ws; float* al_l = ws + 32;
  const float* blds = (const float*)(lds + SHM_NA_BIAS);
  float m_reg = -1e30f, l_reg = 0; f32x16 o[4] = {}; bf16x8 qr[8];
  const bf16* Qw = Qb + (long)(wid * QBLK + r32) * LDQ + hi * 8;
#pragma unroll
  for (int d0 = 0; d0 < 8; ++d0) qr[d0] = ld8(Qw + d0 * 16);
  const int qrow = r0 + (wid >> 1), qc = (wid & 1) * 32 + r32;
  const int rs = min(max(qrow - 4, 0), 56), cs = min(max(qc - 8, 0), 48);
  const int sr = tid >> 4, sc = (tid & 15) * 8, vst0 = v_st(sr, sc), vst1 = v_st(32 + sr, sc);
  const int vb0 = (int)(uintptr_t)V_lds + v_rd_base(lane);
  struct { bf16x8 vs0, vs1, ks0, ks1; } sr_[SDEPTH];
  const unsigned koff0 = (unsigned)(sr * LDK + sc) * 2u, koff1 = (unsigned)((32 + sr) * LDK + sc) * 2u, voff0 = (unsigned)(sr * LDV + sc) * 2u, voff1 = (unsigned)((32 + sr) * LDV + sc) * 2u;
#define SLOAD(i, k0) do { const char* kt_ = (const char*)Kh + (size_t)(k0) * (LDK * 2); const char* vt_ = (const char*)Vh + (size_t)(k0) * (LDV * 2); \
    sr_[i].vs0 = *(const bf16x8*)(vt_ + voff0); sr_[i].vs1 = *(const bf16x8*)(vt_ + voff1); \
    sr_[i].ks0 = *(const bf16x8*)(kt_ + koff0); sr_[i].ks1 = *(const bf16x8*)(kt_ + koff1); } while (0)
#define SWRITE(b, i) do { *(bf16x8*)((char*)V_lds + (b) * SHM_V + vst0) = sr_[i].vs0;          \
    *(bf16x8*)((char*)V_lds + (b) * SHM_V + vst1) = sr_[i].vs1; int kc = sc * 2;               \
    *(bf16x8*)((char*)K_lds + (b) * SHM_K + KSWZ(sr, kc)) = sr_[i].ks0;                       \
    *(bf16x8*)((char*)K_lds + (b) * SHM_K + KSWZ(32 + sr, kc)) = sr_[i].ks1; } while (0)
#define SWAIT() do { if constexpr (SDEPTH == 2) asm volatile("s_waitcnt vmcnt(4)" ::: "memory"); else asm volatile("s_waitcnt vmcnt(0)" ::: "memory"); } while (0)
#define RESC(a) do { if (__any((a) < 1.f)) { if (hi == 0) al_l[r32] = (a); asm volatile("s_waitcnt lgkmcnt(0)" ::: "memory"); \
    for (int d = 0; d < 4; ++d) for (int r = 0; r < 16; ++r) o[d][r] *= al_l[crow(r, hi)]; } } while (0)
#define PSM(P0, P1, MN, AL, J) do { if constexpr (MODE == 0) partialSM(P0, P1, m_reg, MN, AL); else { const int kr_ = kr0 + (J); const bool ok_ = (kr_ >= rs) && (kr_ < rs + 8); \
    const int dr_ = ok_ ? (kr_ - qrow + 7) : 0; partialSM_na(P0, P1, m_reg, MN, AL, blds + dr_ * 31, ok_, qc, cs, hi); } } while (0)
  f32x16 pA0, pA1, pB0, pB1; float mnA, mnB, alA, alB; bf16x8 pa0, pa1, pa2, pa3; const int NT = seq / KVBLK;
  if constexpr (MODE == 1) {
    SLOAD(0, 0);
    for (int j = 0; j < NT; ++j) {
      asm volatile("s_waitcnt vmcnt(0)" ::: "memory"); SWRITE(j & 1, 0);
      if (j + 1 < NT) SLOAD(0, (j + 1) * KVBLK);
      __syncthreads();
      SBAR(); qkt(pA0, pA1, (bf16*)((char*)K_lds + (j & 1) * SHM_K), qr, r32, hi);
      PSM(pA0, pA1, mnA, alA, j); RESC(alA);
      finishSM(pA0, pA1, alA, l_reg, pa0, pa1, pa2, pa3); SBAR();
      pv_d0(o, vb0 + (j & 1) * (int)SHM_V, pa0, pa1, pa2, pa3);
    }
  } else {
  constexpr int SE = 0, SO = SDEPTH - 1;
  SLOAD(SE, 0); asm volatile("s_waitcnt vmcnt(0)" ::: "memory"); SWRITE(0, SE); __syncthreads();
  qkt(pA0, pA1, K_lds, qr, r32, hi); PSM(pA0, pA1, mnA, alA, 0);
  SLOAD(SO, KVBLK); if constexpr (SDEPTH == 2) { if (2 < NT) SLOAD(SE, 2 * KVBLK); }
  SWAIT(); SWRITE(1, SO); __syncthreads();
  for (int j = 1; j + 1 < NT; j += 2) {
    SBAR(); qkt(pB0, pB1, (bf16*)((char*)K_lds + SHM_K), qr, r32, hi);
    finishSM(pA0, pA1, alA, l_reg, pa0, pa1, pa2, pa3); SBAR();
    SLOAD(SO, (j + SDEPTH) * KVBLK); SBAR();
    pv_d0(o, vb0, pa0, pa1, pa2, pa3); PSM(pB0, pB1, mnB, alB, j);
    __syncthreads(); SWAIT(); SWRITE(0, SE);
    RESC(alB); __syncthreads();
    SBAR(); qkt(pA0, pA1, K_lds, qr, r32, hi);
    finishSM(pB0, pB1, alB, l_reg, pa0, pa1, pa2, pa3); SBAR();
    if (SDEPTH == 1 || j + 3 < NT) SLOAD(SE, (j + 1 + SDEPTH) * KVBLK); SBAR();
    pv_d0(o, vb0 + (int)SHM_V, pa0, pa1, pa2, pa3); PSM(pA0, pA1, mnA, alA, j + 1);
    __syncthreads(); SWAIT(); SWRITE(1, SO);
    RESC(alA); __syncthreads();
  }
  SBAR(); qkt(pB0, pB1, (bf16*)((char*)K_lds + SHM_K), qr, r32, hi);
  finishSM(pA0, pA1, alA, l_reg, pa0, pa1, pa2, pa3); SBAR();
  pv_d0(o, vb0, pa0, pa1, pa2, pa3); PSM(pB0, pB1, mnB, alB, NT - 1);
  __syncthreads(); RESC(alB);
  finishSM(pB0, pB1, alB, l_reg, pa0, pa1, pa2, pa3); SBAR();
  pv_d0(o, vb0 + (int)SHM_V, pa0, pa1, pa2, pa3);
  }
  if (hi == 0) li_l[r32] = l_reg; asm volatile("s_waitcnt lgkmcnt(0)" ::: "memory");
  float rli[16];
#pragma unroll
  for (int r = 0; r < 16; ++r) rli[r] = __builtin_amdgcn_rcpf(li_l[crow(r, hi)]);
  if constexpr (OBF) {
    bf16* Ow = (bf16*)Obv + (long)(wid * QBLK) * LDO;
#pragma unroll
    for (int r = 0; r < 16; ++r) { int orow = crow(r, hi);
      for (int d0 = 0; d0 < 4; ++d0) Ow[(long)orow * LDO + d0 * 32 + r32] = (bf16)(cvtpk(o[d0][r] * rli[r], 0.f) & 0xffffu); }
  } else {
    float* Ow = (float*)Obv + (long)(wid * QBLK) * LDO;
#pragma unroll
    for (int r = 0; r < 16; ++r) { int orow = crow(r, hi);
      for (int d0 = 0; d0 < 4; ++d0) Ow[(long)orow * LDO + d0 * 32 + r32] = o[d0][r] * rli[r]; }
  }
#undef SLOAD
#undef SWRITE
#undef SWAIT
#undef RESC
#undef PSM
}
#undef KSWZ
}

constexpr int T = 8192, DM = 2048, SEQ = 4096, NB = 2, DEPTH = 4, INW = 5120, MIXW = 2048;
constexpr int OFF_DQ = 0, OFF_DK = 1024, OFF_DV = 2048, OFF_NQ = 3072, OFF_NK = 3584, OFF_NV = 4096, OFF_MQ = 4608;
constexpr int NMEM = 256, NEXP = 16384, KVW = 1024;
constexpr float EPS = 1e-6f;
constexpr int NWAVES = 8;
#ifndef MK_PHMASK
#define MK_PHMASK 0xfff
#endif
#define PHEN(k) (((MK_PHMASK) >> (k)) & 1)
#ifndef MK_ATT
#define MK_ATT 7
#endif
#ifndef MK_ONE_LAUNCH
#define MK_ONE_LAUNCH 0
#endif

constexpr size_t MiB = 1u << 20;
constexpr size_t WS_CTL = 0, CTL_ZERO_BYTES = 1 * MiB;
constexpr size_t WS_ROPE = 1 * MiB;
constexpr size_t WS_MEMN = 2 * MiB;
constexpr size_t WS_MEMKV = 4 * MiB;
constexpr size_t WS_KEYS = 8 * MiB;
constexpr size_t WS_IDS = 10 * MiB;
constexpr size_t WS_GATES = 14 * MiB;
constexpr size_t WS_WTIN = 32 * MiB;
constexpr size_t WS_WTOUT = 112 * MiB;
constexpr size_t WS_WTPQ = 144 * MiB;
constexpr size_t WS_WTKV = 176 * MiB;
constexpr size_t WS_XN = 192 * MiB;
constexpr size_t WS_PROJ = 224 * MiB;
constexpr size_t WS_OD = 304 * MiB;
constexpr size_t WS_MIX = 368 * MiB;
constexpr size_t WS_PQ = 400 * MiB;
constexpr size_t WS_UTAB = 448 * MiB;
constexpr size_t WS_VTAB = 704 * MiB;
constexpr size_t WS_END = 960 * MiB;
constexpr int CW_BAR = 4096;

constexpr int RING_BYTES = 131072;
constexpr int LDSCTL_OFF = RING_BYTES, MISC_OFF = LDSCTL_OFF + 320;
constexpr int LDS_BYTES = 147456;

#define GAS __attribute__((address_space(1)))
#define LAS __attribute__((address_space(3)))
typedef unsigned short bf16;
typedef unsigned v4u __attribute__((ext_vector_type(4)));
typedef unsigned v2u __attribute__((ext_vector_type(2)));
typedef float f32x4 __attribute__((ext_vector_type(4)));
typedef float f32x16 __attribute__((ext_vector_type(16)));
typedef short bf16x8 __attribute__((ext_vector_type(8)));
#define LDS_WAIT() asm volatile("s_waitcnt lgkmcnt(0)" ::: "memory")

__device__ __forceinline__ unsigned f2bf(float f) { unsigned u = __builtin_bit_cast(unsigned, f); return (u + 0x7fffu + ((u >> 16) & 1u)) >> 16; }
__device__ __forceinline__ unsigned pk2(float lo, float hi) { return f2bf(lo) | (f2bf(hi) << 16); }
__device__ __forceinline__ float bflo(unsigned w) { return __builtin_bit_cast(float, w << 16); }
__device__ __forceinline__ float bfhi(unsigned w) { return __builtin_bit_cast(float, w & 0xffff0000u); }
__device__ __forceinline__ float wave_sum(float v) {
#pragma unroll
    for (int o = 1; o < 64; o <<= 1) v += __shfl_xor(v, o);
    return v;
}

#define XB_TMO      128
#define XB_XCNT(j)  (256  + 64 * (j))
#define XB_XSUB(j)  (1280 + 64 * (j))
#define XB_XGEN(j)  (2304 + 64 * (j))
#define XB_TOP      3328
#define XB_TOPGEN   3392
#define XCD_BAR_WORDS 3456
#define XB_SPIN_CAP (1u << 18)
__device__ __forceinline__ unsigned xb_ld(unsigned* p)              { return __hip_atomic_load(p, __ATOMIC_RELAXED, __HIP_MEMORY_SCOPE_AGENT); }
__device__ __forceinline__ unsigned xb_add(unsigned* p, unsigned v) { return __hip_atomic_fetch_add(p, v, __ATOMIC_RELAXED, __HIP_MEMORY_SCOPE_AGENT); }
__device__ __forceinline__ unsigned xb_xcc_id() { return (unsigned)__builtin_amdgcn_s_getreg((3 << 11) | 20) & 0xFu; }
#define XB_SPIN(cond, bar) do { unsigned _sp = 0; while (cond) { __builtin_amdgcn_s_sleep(1); \
    if ((++_sp & 255u) == 0u) { if (xb_ld(&(bar)[XB_TMO])) break; if (_sp > XB_SPIN_CAP) { atomicAdd(&(bar)[XB_TMO], 1u); break; } } } } while (0)
struct XcdBarrier { unsigned* bar; unsigned x; volatile LAS unsigned* st; };
__device__ __forceinline__ XcdBarrier xcd_barrier_post(unsigned* bar, volatile LAS unsigned* st) {
    XcdBarrier b; b.bar = bar; b.x = xb_xcc_id(); b.st = st;
    if (threadIdx.x == 0) (void)xb_add(&bar[XB_XCNT(b.x)], 1u);
    return b;
}
__device__ __forceinline__ void xcd_barrier_complete(unsigned* bar, unsigned x, unsigned& nloc, unsigned& nx) {
    const unsigned G = gridDim.x * gridDim.y * gridDim.z;
    unsigned sum, cnt, mine, sp = 0u;
    for (;;) {
        sum = 0u; cnt = 0u; mine = 0u;
#pragma unroll
        for (unsigned j = 0; j < 16; ++j) { const unsigned c = xb_ld(&bar[XB_XCNT(j)]); sum += c; cnt += (c > 0u) ? 1u : 0u; mine = (j == x) ? c : mine; }
        if (sum == G) break;
        __builtin_amdgcn_s_sleep(1);
        if ((++sp & 255u) == 0u) { if (xb_ld(&bar[XB_TMO])) break; if (sp > XB_SPIN_CAP) { atomicAdd(&bar[XB_TMO], 1u); break; } }
    }
    nloc = mine > 0u ? mine : 1u; nx = cnt > 0u ? cnt : 1u;
}
__device__ __forceinline__ void xcd_barrier(const XcdBarrier& b) {
    asm volatile("s_waitcnt vmcnt(0)" ::: "memory");
    __syncthreads();
    if (threadIdx.x == 0) {
        unsigned* bar = b.bar;
        __builtin_amdgcn_s_waitcnt(0);
        unsigned nloc = b.st[0], nx = b.st[1];
        if (nloc == 0u) { xcd_barrier_complete(bar, b.x, nloc, nx); b.st[0] = nloc; b.st[1] = nx; }
        const unsigned old = xb_add(&bar[XB_XSUB(b.x)], 1u);
        const unsigned gen = old / nloc;
        if (old + 1u == (gen + 1u) * nloc) {
            __builtin_amdgcn_fence(__ATOMIC_RELEASE, "agent");
            asm volatile("s_waitcnt vmcnt(0)" ::: "memory");
            const unsigned og = xb_add(&bar[XB_TOP], 1u);
            const unsigned tg = og / nx;
            if (og + 1u == (tg + 1u) * nx) xb_add(&bar[XB_TOPGEN], 1u);
            else XB_SPIN(xb_ld(&bar[XB_TOPGEN]) == tg, bar);
            __builtin_amdgcn_fence(__ATOMIC_ACQUIRE, "agent");
            xb_add(&bar[XB_XGEN(b.x)], 1u);
            asm volatile("s_waitcnt vmcnt(0)" ::: "memory");
        } else {
            XB_SPIN(xb_ld(&bar[XB_XGEN(b.x)]) == gen, bar);
            __builtin_amdgcn_fence(__ATOMIC_ACQUIRE, "agent");
            asm volatile("s_waitcnt vmcnt(0)" ::: "memory");
        }
    }
    __syncthreads();
}

__device__ __forceinline__ void transpose_item(const float* W, const float* gain, int K, int N, bf16* WT, LAS float* scr, int item, int lane) {
    const int nblk = N / 32, kb = item / nblk, nb = item % nblk, k0 = 64 * kb, n0 = 32 * nb;
#pragma unroll 8
    for (int i = 0; i < 32; ++i) { const int kk = 2 * i + (lane >> 5); const float g = gain ? gain[k0 + kk] : 1.f; scr[kk * 33 + (lane & 31)] = W[(size_t)(k0 + kk) * N + n0 + (lane & 31)] * g; }
    LDS_WAIT(); asm volatile("" ::: "memory");
    const int c = lane & 7;
#pragma unroll
    for (int j = 0; j < 4; ++j) { const int n = (lane >> 3) + 8 * j; const LAS float* s = scr + (8 * c) * 33 + n;
        v4u o; o.x = pk2(s[0 * 33], s[1 * 33]); o.y = pk2(s[2 * 33], s[3 * 33]); o.z = pk2(s[4 * 33], s[5 * 33]); o.w = pk2(s[6 * 33], s[7 * 33]);
        *(v4u*)(WT + (size_t)(n0 + n) * K + k0 + 8 * c) = o; }
    LDS_WAIT(); asm volatile("" ::: "memory");
}
__device__ __forceinline__ void rms_row_to_bf16(const float* xrow, bf16* orow, int lane) {
    const f32x4* xr = (const f32x4*)xrow + lane;
    f32x4 v[8]; float s = 0.f;
#pragma unroll
    for (int j = 0; j < 8; ++j) { v[j] = xr[64 * j]; s += (v[j].x * v[j].x + v[j].y * v[j].y) + (v[j].z * v[j].z + v[j].w * v[j].w); }
    const float r = 1.0f / sqrtf(wave_sum(s) * (1.f / 2048.f) + EPS);
    v2u* o8 = (v2u*)orow + lane;
#pragma unroll
    for (int j = 0; j < 8; ++j) { v2u w; w.x = pk2(v[j].x * r, v[j].y * r); w.y = pk2(v[j].z * r, v[j].w * r); o8[64 * j] = w; }
}
__device__ __forceinline__ void slot_norm(bf16* p, const float* g, bool rope, const float* cs, const float* sn, int sub  ) {
    v4u w = *(v4u*)(p + sub * 8);
    float x[8] = {bflo(w.x), bfhi(w.x), bflo(w.y), bfhi(w.y), bflo(w.z), bfhi(w.z), bflo(w.w), bfhi(w.w)};
    float s = 0.f;
#pragma unroll
    for (int j = 0; j < 8; ++j) s += x[j] * x[j];
    s += __shfl_xor(s, 1); s += __shfl_xor(s, 2); s += __shfl_xor(s, 4); s += __shfl_xor(s, 8);
    const float r = 1.0f / sqrtf(s * (1.f / 128.f) + EPS);
    const f32x4 g0 = *(const f32x4*)(g + sub * 8), g1 = *(const f32x4*)(g + sub * 8 + 4);
    x[0] *= r * g0.x; x[1] *= r * g0.y; x[2] *= r * g0.z; x[3] *= r * g0.w; x[4] *= r * g1.x; x[5] *= r * g1.y; x[6] *= r * g1.z; x[7] *= r * g1.w;
    float y[8];
#pragma unroll
    for (int j = 0; j < 8; ++j) y[j] = __shfl_xor(x[j], 2);
    if (rope && sub < 4) {
        const int i0 = (sub & 1) * 8;
#pragma unroll
        for (int j = 0; j < 8; ++j) { const float c = cs[i0 + j], sn_ = sn[i0 + j]; x[j] = (sub < 2) ? (x[j] * c - y[j] * sn_) : (x[j] * c + y[j] * sn_); }
    }
    v4u o; o.x = pk2(x[0], x[1]); o.y = pk2(x[2], x[3]); o.z = pk2(x[4], x[5]); o.w = pk2(x[6], x[7]);
    *(v4u*)(p + sub * 8) = o;
}

struct EpiResF32 {
    static constexpr bool PERM = false, AFTER_DRAIN = false;
    const float* base; float* C; int ldc;
    __device__ __forceinline__ void operator()(const pg8::f32x4 (&acc)[2][2][4][2], const pg8::Unit& u, int wr, int wc, int fr, int fq) const {
        const int row0 = u.pm * pg8::BM + wr * 64 + fr, col0 = u.pn * pg8::BM + wc * 32 + 4 * fq;
#pragma unroll
        for (int ai = 0; ai < 2; ++ai)
#pragma unroll
            for (int m = 0; m < 4; ++m) { const size_t off = (size_t)(row0 + ai * pg8::HALF + m * 16) * ldc + col0;
#pragma unroll
                for (int bj = 0; bj < 2; ++bj)
#pragma unroll
                    for (int n = 0; n < 2; ++n) { const pg8::f32x4 bs = *(const pg8::f32x4*)(base + off + bj * pg8::HALF + n * 16); *(pg8::f32x4*)(C + off + bj * pg8::HALF + n * 16) = bs + acc[ai][bj][m][n]; }
                asm volatile("" ::: "memory"); }
    }
};

__device__ __forceinline__ void select_task(const bf16* PQ, const bf16* KEYS_l, int* IDS, float* GATES, int tile, int hp, LAS int* lscr, int lane) {
    const int r32 = lane & 31, hi = lane >> 5; const int t = tile * 32 + r32;
    int ab[2][16];
#pragma unroll
    for (int c = 0; c < 2; ++c) {
        const int g = hp * 2 + c;
        bf16x8 qr[8];
#pragma unroll
        for (int ks = 0; ks < 8; ++ks) qr[ks] = *(const bf16x8*)(PQ + (size_t)t * 2048 + g * 128 + ks * 16 + hi * 8);
        const bf16* kb = KEYS_l + (size_t)g * 128 * 128;
        f32x16 p[4];
#pragma unroll
        for (int q = 0; q < 4; ++q) { p[q] = f32x16{};
#pragma unroll
            for (int ks = 0; ks < 8; ++ks) { const bf16x8 af = *(const bf16x8*)(kb + (size_t)(q * 32 + r32) * 128 + ks * 16 + hi * 8); p[q] = __builtin_amdgcn_mfma_f32_32x32x16_bf16(af, qr[ks], p[q], 0, 0, 0); } }
        int g0[16], g1[16], g2[16], g3[16];
#pragma unroll
        for (int r = 0; r < 16; ++r) { const int idx = (r & 3) + 8 * (r >> 2) + 4 * hi;
            g0[r] = (sel::f2key(p[0][r]) & ~127) | idx; g1[r] = (sel::f2key(p[1][r]) & ~127) | (32 + idx);
            g2[r] = (sel::f2key(p[2][r]) & ~127) | (64 + idx); g3[r] = (sel::f2key(p[3][r]) & ~127) | (96 + idx); }
        sel::sort_desc(g0); sel::sort_desc(g1); sel::sort_desc(g2); sel::sort_desc(g3);
        sel::top16_merge(g0, g1); sel::top16_merge(g2, g3); sel::top16_merge(g0, g2);
        int pb[16];
#pragma unroll
        for (int i = 0; i < 16; ++i) pb[i] = __shfl_xor(g0[i], 32);
        sel::top16_merge(g0, pb);
#pragma unroll
        for (int i = 0; i < 16; ++i) ab[c][i] = g0[i];
    }
    int cc[16];
    sel::cand_top16(ab[0], ab[1], cc);
#pragma unroll
    for (int i = 0; i < 16; ++i) { lscr[i * 64 + lane] = ab[0][i] & 127; lscr[(16 + i) * 64 + lane] = ab[1][i] & 127; }
    LDS_WAIT();
    float val[16], e[16]; int eid[16];
#pragma unroll
    for (int k = 0; k < 16; ++k) { const int code = cc[k] & 255; const int i = code >> 4, j = code & 15; val[k] = sel::key2f(cc[k] & ~255);
        eid[k] = lscr[i * 64 + lane] * 128 + lscr[(16 + j) * 64 + lane]; }
    float sum = 0.f;
#pragma unroll
    for (int k = 0; k < 16; ++k) { e[k] = __expf(val[k] - val[0]); sum += e[k]; }
    const float inv = 1.0f / sum;
    int* ip = IDS + (size_t)t * 128 + hp * 16 + hi * 8; float* gp = GATES + (size_t)t * 128 + hp * 16 + hi * 8;
    v4u i0, i1; f32x4 q0, q1;
    i0.x = hi ? eid[8] : eid[0]; i0.y = hi ? eid[9] : eid[1]; i0.z = hi ? eid[10] : eid[2]; i0.w = hi ? eid[11] : eid[3];
    i1.x = hi ? eid[12] : eid[4]; i1.y = hi ? eid[13] : eid[5]; i1.z = hi ? eid[14] : eid[6]; i1.w = hi ? eid[15] : eid[7];
    q0.x = (hi ? e[8] : e[0]) * inv; q0.y = (hi ? e[9] : e[1]) * inv; q0.z = (hi ? e[10] : e[2]) * inv; q0.w = (hi ? e[11] : e[3]) * inv;
    q1.x = (hi ? e[12] : e[4]) * inv; q1.y = (hi ? e[13] : e[5]) * inv; q1.z = (hi ? e[14] : e[6]) * inv; q1.w = (hi ? e[15] : e[7]) * inv;
    *(v4u*)ip = i0; *(v4u*)(ip + 4) = i1; *(f32x4*)gp = q0; *(f32x4*)(gp + 4) = q1;
    LDS_WAIT();
}

__device__ __forceinline__ void gather_token(float* xrow  , const float* fg  , const int* ids, const float* gates, const bf16* UT, const bf16* VT, int lane) {
    float h[4][8], acc[4][8]; float ss = 0.f;
#pragma unroll
    for (int q = 0; q < 4; ++q) { const f32x4 a = *(const f32x4*)(xrow + q * 512 + lane * 8), b = *(const f32x4*)(xrow + q * 512 + lane * 8 + 4);
        h[q][0] = a.x; h[q][1] = a.y; h[q][2] = a.z; h[q][3] = a.w; h[q][4] = b.x; h[q][5] = b.y; h[q][6] = b.z; h[q][7] = b.w;
#pragma unroll
        for (int j = 0; j < 8; ++j) { ss += h[q][j] * h[q][j]; acc[q][j] = h[q][j]; } }
    const float r = 1.0f / sqrtf(wave_sum(ss) * (1.f / 2048.f) + EPS);
#pragma unroll
    for (int q = 0; q < 4; ++q) { const f32x4 a = *(const f32x4*)(fg + q * 512 + lane * 8), b = *(const f32x4*)(fg + q * 512 + lane * 8 + 4);
        h[q][0] *= r * a.x; h[q][1] *= r * a.y; h[q][2] *= r * a.z; h[q][3] *= r * a.w; h[q][4] *= r * b.x; h[q][5] *= r * b.y; h[q][6] *= r * b.z; h[q][7] *= r * b.w; }
    const int id_lo = ids[lane], id_hi = ids[64 + lane]; const float g_lo = gates[lane], g_hi = gates[64 + lane];
    for (int kk = 0; kk < 128; kk += 2) {
        v4u uu[2][4], vv[2][4]; float gt[2];
#pragma unroll
        for (int e = 0; e < 2; ++e) { const int k = kk + e;
            const int id = __builtin_amdgcn_readlane(k < 64 ? id_lo : id_hi, k & 63); gt[e] = __builtin_bit_cast(float, __builtin_amdgcn_readlane(__builtin_bit_cast(int, k < 64 ? g_lo : g_hi), k & 63));
            const bf16* ur = UT + (size_t)id * 2048 + lane * 8; const bf16* vr = VT + (size_t)id * 2048 + lane * 8;
#pragma unroll
            for (int q = 0; q < 4; ++q) { uu[e][q] = *(const v4u*)(ur + q * 512); vv[e][q] = *(const v4u*)(vr + q * 512); } }
#pragma unroll
        for (int e = 0; e < 2; ++e) {
            float d = 0.f;
#pragma unroll
            for (int q = 0; q < 4; ++q) { const v4u w = uu[e][q];
                d += h[q][0] * bflo(w.x) + h[q][1] * bfhi(w.x) + h[q][2] * bflo(w.y) + h[q][3] * bfhi(w.y) + h[q][4] * bflo(w.z) + h[q][5] * bfhi(w.z) + h[q][6] * bflo(w.w) + h[q][7] * bfhi(w.w); }
            d = wave_sum(d);
            const float wgt = gt[e] * 0.5f * d * (1.0f + erff(d * 0.70710678118654752f));
#pragma unroll
            for (int q = 0; q < 4; ++q) { const v4u w = vv[e][q];
                acc[q][0] += wgt * bflo(w.x); acc[q][1] += wgt * bfhi(w.x); acc[q][2] += wgt * bflo(w.y); acc[q][3] += wgt * bfhi(w.y);
                acc[q][4] += wgt * bflo(w.z); acc[q][5] += wgt * bfhi(w.z); acc[q][6] += wgt * bflo(w.w); acc[q][7] += wgt * bfhi(w.w); }
        }
    }
#pragma unroll
    for (int q = 0; q < 4; ++q) { *(f32x4*)(xrow + q * 512 + lane * 8) = (f32x4){acc[q][0], acc[q][1], acc[q][2], acc[q][3]}; *(f32x4*)(xrow + q * 512 + lane * 8 + 4) = (f32x4){acc[q][4], acc[q][5], acc[q][6], acc[q][7]}; }
}

struct Args { const float* in[16]; float* out; unsigned char* ws; int ph_lo, ph_hi; };
constexpr int NPL = 10, NPH = 2 + DEPTH * NPL;

__global__ void __launch_bounds__(NWAVES * 64, 2) mk_fwd(Args args) {
    extern __shared__ __attribute__((aligned(16))) unsigned char lds[];
    LAS unsigned char* ldsl = (LAS unsigned char*)lds;
    volatile LAS unsigned* MISC = (volatile LAS unsigned*)(ldsl + MISC_OFF);
    const int G = gridDim.x; const int bx = blockIdx.x; const int vcu = (G % 8 == 0) ? (bx % 8) * (G / 8) + bx / 8 : bx;
    const int NGW = G * NWAVES;
#define GIN(k) ((const float*)(const GAS float*)args.in[k])
#define PH_BEGIN() \
    int tid = threadIdx.x; asm volatile("" : "+v"(tid)); const int lane = tid & 63, wave = __builtin_amdgcn_readfirstlane(tid >> 6); const int gw = vcu * NWAVES + wave; \
    GAS unsigned char* wsg = (GAS unsigned char*)args.ws; asm volatile("" : "+s"(wsg)); unsigned char* ws = (unsigned char*)wsg; \
    const float* x_in = GIN(0); float* xo = (float*)(GAS float*)args.out; \
    bf16* WTIN = (bf16*)(ws + WS_WTIN); bf16* WTOUT = (bf16*)(ws + WS_WTOUT); bf16* WTPQ = (bf16*)(ws + WS_WTPQ); bf16* WTKV = (bf16*)(ws + WS_WTKV); \
    bf16* XN = (bf16*)(ws + WS_XN); bf16* PROJ = (bf16*)(ws + WS_PROJ); float* OD = (float*)(ws + WS_OD); bf16* MIX = (bf16*)(ws + WS_MIX); bf16* PQ = (bf16*)(ws + WS_PQ); \
    bf16* UTAB = (bf16*)(ws + WS_UTAB); bf16* VTAB = (bf16*)(ws + WS_VTAB); bf16* KEYS = (bf16*)(ws + WS_KEYS); \
    bf16* MEMN = (bf16*)(ws + WS_MEMN); bf16* MEMKV = (bf16*)(ws + WS_MEMKV); \
    float* ROPEC = (float*)(ws + WS_ROPE); float* ROPES = ROPEC + 4096 * 16; \
    int* IDS = (int*)(ws + WS_IDS); float* GATES = (float*)(ws + WS_GATES); \
    const float* xcur = (l == 0) ? x_in : xo; const float* gq = GIN(4) + (size_t)l * 6 * 128; \
    (void)lane; (void)gw; (void)x_in; (void)xo; (void)WTIN; (void)WTOUT; (void)WTPQ; (void)WTKV; (void)XN; (void)PROJ; (void)OD; (void)MIX; (void)PQ; (void)UTAB; (void)VTAB; (void)KEYS; (void)MEMN; (void)MEMKV; (void)ROPEC; (void)ROPES; (void)IDS; (void)GATES; (void)xcur; (void)gq;
    for (int u = threadIdx.x; u < (LDS_BYTES - LDSCTL_OFF) / 4; u += NWAVES * 64) ((LAS unsigned*)(ldsl + LDSCTL_OFF))[u] = 0u;
    __syncthreads();
    const int lo = args.ph_lo, hi = args.ph_hi;
    XcdBarrier bar; bar.bar = (unsigned*)(args.ws + WS_CTL) + CW_BAR; bar.x = 0; bar.st = nullptr;
    if (hi - lo > 1) bar = xcd_barrier_post((unsigned*)(args.ws + WS_CTL) + CW_BAR, MISC + 8);
#define IN(k) (lo <= (k) && (k) < hi)
#define SEAM(k) do { if (IN(k) && IN((k) + 1)) xcd_barrier(bar); } while (0)

    if (PHEN(10) && IN(0)) { const int l = 0; PH_BEGIN();
        LAS float* scr = (LAS float*)(ldsl + wave * 16384);
        constexpr int I_IN = 32 * 160, I_OUT = 32 * 64, I_PQ = 32 * 64, I_KV = 32 * 32, I_L = I_IN + I_OUT + I_PQ + I_KV;
        for (int it = gw; it < DEPTH * I_L; it += NGW) {
            const int l = it / I_L; int r = it % I_L;
            if (r < I_IN) { transpose_item(GIN(3) + (size_t)l * DM * INW, GIN(2) + l * DM, DM, INW, WTIN + (size_t)l * INW * DM, scr, r, lane); continue; } r -= I_IN;
            if (r < I_OUT) { transpose_item(GIN(10) + (size_t)l * MIXW * DM, nullptr, MIXW, DM, WTOUT + (size_t)l * DM * MIXW, scr, r, lane); continue; } r -= I_OUT;
            if (r < I_PQ) { transpose_item(GIN(12) + (size_t)l * DM * DM, GIN(11) + l * DM, DM, DM, WTPQ + (size_t)l * DM * DM, scr, r, lane); continue; } r -= I_PQ;
            transpose_item(GIN(9) + (size_t)l * DM * KVW, GIN(8) + l * DM, DM, KVW, WTKV + (size_t)l * KVW * DM, scr, r, lane);
        }
        {
            const size_t gt = (size_t)vcu * (NWAVES * 64) + tid, NT_ = (size_t)G * NWAVES * 64;
            const size_t nk8 = (size_t)DEPTH * 8 * 2 * 128 * 128 / 8, nu8 = (size_t)DEPTH * NEXP * DM / 8;
            for (size_t i = gt; i < nk8 + 2 * nu8; i += NT_) {
                const float* src; bf16* dst; size_t j = i;
                if (j < nk8) { src = GIN(13); dst = KEYS; } else if (j < nk8 + nu8) { j -= nk8; src = GIN(14); dst = UTAB; } else { j -= nk8 + nu8; src = GIN(15); dst = VTAB; }
                const f32x4 a = *(const f32x4*)(src + j * 8), b = *(const f32x4*)(src + j * 8 + 4);
                v4u o; o.x = pk2(a.x, a.y); o.y = pk2(a.z, a.w); o.z = pk2(b.x, b.y); o.w = pk2(b.z, b.w);
                *(v4u*)(dst + j * 8) = o;
            }
            for (size_t i = gt; i < 4096 * 16; i += NT_) {
                const int pos = (int)(i >> 4), fi = (int)(i & 15);
                const double inv = exp2(-(double)fi * (18.931568569324174 / 16.0));
                const double rev = (double)pos * inv * 0.15915494309189535;
                const float fr = (float)(rev - floor(rev));
                ROPEC[i] = __builtin_amdgcn_cosf(fr); ROPES[i] = __builtin_amdgcn_sinf(fr);
            }
        }
        for (int m = gw; m < NB * NMEM; m += NGW) rms_row_to_bf16(GIN(1) + (size_t)m * DM, MEMN + (size_t)m * DM, lane);
    }
    SEAM(0);
    if (PHEN(11) && IN(1)) { const int l = 0; PH_BEGIN();
        pg8::Gemm g{MEMN, WTKV, NB * NMEM, DEPTH * KVW, DM}; pg8::StaticOrder S; S.init(NB * NMEM, DEPTH * KVW, G, bx);
        pg8::EpiBf16<0> E{MEMKV, DEPTH * KVW, nullptr, 0, 0};
        pg8::gemm_phase<pg8::EpiBf16<0>, pg8::StaticOrder, false>((PG8_LAS unsigned char*)ldsl, g, S, E, nullptr);
    }
    SEAM(1);

    for (int l = 0; l < DEPTH; ++l) {
        const int pb = 2 + l * NPL;
        const float lam_init = 0.8f - 0.6f * expf(-0.3f * (float)l);
        if (PHEN(0) && IN(pb + 0)) { PH_BEGIN();
            if (l == 0) {
                for (int m = gw; m < NB * NMEM; m += NGW) {
                    bf16* row = MEMKV + (size_t)m * (DEPTH * KVW);
#pragma unroll 1
                    for (int sg = 0; sg < 4; ++sg) { const int s = sg * 4 + (lane >> 4); const int ll = s >> 2, h = s & 3;
                        slot_norm(row + ll * KVW + h * 128, GIN(4) + (size_t)ll * 6 * 128 + 5 * 128, false, nullptr, nullptr, lane & 15); }
                }
            }
            for (int m = gw; m < T; m += NGW) rms_row_to_bf16(xcur + (size_t)m * DM, XN + (size_t)m * DM, lane);
        }
        SEAM(pb + 0);
        if (PHEN(1) && IN(pb + 1)) { PH_BEGIN();
            pg8::Gemm g{XN, WTIN + (size_t)l * INW * DM, T, INW, DM}; pg8::StaticOrder S; S.init(T, INW, G, bx);
            pg8::EpiBf16<0> E{PROJ, INW, nullptr, 0, 0};
            pg8::gemm_phase<pg8::EpiBf16<0>, pg8::StaticOrder, false>((PG8_LAS unsigned char*)ldsl, g, S, E, nullptr);
        }
        SEAM(pb + 1);
        if (PHEN(2) && IN(pb + 2)) { PH_BEGIN();
            for (int m = gw; m < T; m += NGW) {
                bf16* row = PROJ + (size_t)m * INW; const int pos = m & (SEQ - 1);
                const float* cs = ROPEC + pos * 16; const float* sn = ROPES + pos * 16;
#pragma unroll 1
                for (int sg = 0; sg < 10; ++sg) {
                    if (sg == 4 || sg == 5 || sg == 8) continue;
                    const int s = sg * 4 + (lane >> 4);
                    const int gi = (sg < 2) ? 0 : (sg < 4) ? 1 : (sg == 6) ? 2 : (sg == 7) ? 3 : 4;
                    slot_norm(row + s * 128, gq + gi * 128, sg < 4, cs, sn, lane & 15);
                }
            }
        }
        SEAM(pb + 2);
        if (PHEN(3) && IN(pb + 3)) { PH_BEGIN();
#if MK_ATT & 1
            for (int u = vcu; u < 512; u += G) {
                const int qb = u & 15, vh = (u >> 4) & 1, c = (u >> 5) & 1, h = (u >> 6) & 3, b = u >> 8;
                __syncthreads();
                att::attn_body<0, 1, INW, INW, INW, 1024, false>(PROJ + (size_t)(b * SEQ + qb * 256) * INW + OFF_DQ + h * 256 + c * 128,
                    PROJ + (size_t)(b * SEQ) * INW + OFF_DK + h * 256 + c * 128, PROJ + (size_t)(b * SEQ) * INW + OFF_DV + h * 256 + vh * 128,
                    OD + ((size_t)c * T + b * SEQ + qb * 256) * 1024 + h * 256 + vh * 128, SEQ, (char*)lds, 0, 0);
            }
#endif
#if MK_ATT & 2
            for (int u = vcu; u < 128; u += G) {
                const int rb = u & 15, h = (u >> 4) & 3, b = u >> 6; const int r0 = rb * 4, kr0 = min(max(r0 - 4, 0), 52);
                __syncthreads();
                if (tid < 465) ((float*)(lds + att::SHM_NA_BIAS))[tid] = GIN(7)[((size_t)l * 4 + h) * 465 + tid] * 1.4426950408889634f;
                att::attn_body<1, 1, INW, INW, INW, MIXW, true>(PROJ + (size_t)(b * SEQ + r0 * 64) * INW + OFF_NQ + h * 128,
                    PROJ + (size_t)(b * SEQ + kr0 * 64) * INW + OFF_NK + h * 128, PROJ + (size_t)(b * SEQ + kr0 * 64) * INW + OFF_NV + h * 128,
                    MIX + (size_t)(b * SEQ + r0 * 64) * MIXW + 1024 + h * 128, 768, (char*)lds, r0, kr0);
            }
#endif
#if MK_ATT & 4
            for (int u = (vcu + G - 128) % G; u < 128; u += G) {
                const int qb = u & 15, h = (u >> 4) & 3, b = u >> 6;
                __syncthreads();
                att::attn_body<0, 2, INW, DEPTH * KVW, DEPTH * KVW, MIXW, true>(PROJ + (size_t)(b * SEQ + qb * 256) * INW + OFF_MQ + h * 128,
                    MEMKV + (size_t)(b * NMEM) * (DEPTH * KVW) + l * KVW + h * 128, MEMKV + (size_t)(b * NMEM) * (DEPTH * KVW) + l * KVW + 512 + h * 128,
                    MIX + (size_t)(b * SEQ + qb * 256) * MIXW + 1536 + h * 128, NMEM, (char*)lds, 0, 0);
            }
#endif
        }
        SEAM(pb + 3);
        if (PHEN(4) && IN(pb + 4)) { PH_BEGIN();
            const float* lq = GIN(5) + (size_t)l * 4 * 128;
            const float d01 = wave_sum(lq[lane] * lq[128 + lane] + lq[64 + lane] * lq[192 + lane]);
            const float d23 = wave_sum(lq[256 + lane] * lq[384 + lane] + lq[320 + lane] * lq[448 + lane]);
            const float lam = expf(d01) - expf(d23) + lam_init;
            const float* sg_ = GIN(6) + (size_t)l * 256; const int sub = lane & 15, h = lane >> 4;
            float gs[16];
#pragma unroll
            for (int j = 0; j < 16; ++j) gs[j] = sg_[sub * 16 + j] * (1.0f - lam_init);
            for (int m = gw; m < T; m += NGW) {
                const float* o0 = OD + (size_t)m * 1024 + h * 256 + sub * 16; const float* o1 = o0 + (size_t)T * 1024;
                float v[16]; float s = 0.f;
#pragma unroll
                for (int q = 0; q < 4; ++q) { const f32x4 a = *(const f32x4*)(o0 + q * 4), b2 = *(const f32x4*)(o1 + q * 4);
                    v[q * 4 + 0] = a.x - lam * b2.x; v[q * 4 + 1] = a.y - lam * b2.y; v[q * 4 + 2] = a.z - lam * b2.z; v[q * 4 + 3] = a.w - lam * b2.w; }
#pragma unroll
                for (int j = 0; j < 16; ++j) s += v[j] * v[j];
                s += __shfl_xor(s, 1); s += __shfl_xor(s, 2); s += __shfl_xor(s, 4); s += __shfl_xor(s, 8);
                const float r = 1.0f / sqrtf(s * (1.f / 256.f) + EPS);
                v4u w0, w1;
                w0.x = pk2(v[0] * r * gs[0], v[1] * r * gs[1]); w0.y = pk2(v[2] * r * gs[2], v[3] * r * gs[3]); w0.z = pk2(v[4] * r * gs[4], v[5] * r * gs[5]); w0.w = pk2(v[6] * r * gs[6], v[7] * r * gs[7]);
                w1.x = pk2(v[8] * r * gs[8], v[9] * r * gs[9]); w1.y = pk2(v[10] * r * gs[10], v[11] * r * gs[11]); w1.z = pk2(v[12] * r * gs[12], v[13] * r * gs[13]); w1.w = pk2(v[14] * r * gs[14], v[15] * r * gs[15]);
                bf16* mp = MIX + (size_t)m * MIXW + h * 256 + sub * 16;
                *(v4u*)mp = w0; *(v4u*)(mp + 8) = w1;
            }
        }
        SEAM(pb + 4);
        if (PHEN(5) && IN(pb + 5)) { PH_BEGIN();
            pg8::Gemm g{MIX, WTOUT + (size_t)l * DM * MIXW, T, DM, MIXW}; pg8::StaticOrder S; S.init(T, DM, G, bx);
            EpiResF32 E{xcur, xo, DM};
            pg8::gemm_phase<EpiResF32, pg8::StaticOrder, false>((PG8_LAS unsigned char*)ldsl, g, S, E, nullptr);
        }
        SEAM(pb + 5);
        if (PHEN(6) && IN(pb + 6)) { PH_BEGIN(); for (int m = gw; m < T; m += NGW) rms_row_to_bf16(xo + (size_t)m * DM, XN + (size_t)m * DM, lane); }
        SEAM(pb + 6);
        if (PHEN(7) && IN(pb + 7)) { PH_BEGIN();
            pg8::Gemm g{XN, WTPQ + (size_t)l * DM * DM, T, DM, DM}; pg8::StaticOrder S; S.init(T, DM, G, bx);
            pg8::EpiBf16<0> E{PQ, DM, nullptr, 0, 0};
            pg8::gemm_phase<pg8::EpiBf16<0>, pg8::StaticOrder, false>((PG8_LAS unsigned char*)ldsl, g, S, E, nullptr);
        }
        SEAM(pb + 7);
        if (PHEN(8) && IN(pb + 8)) { PH_BEGIN();
            LAS int* lscr = (LAS int*)(ldsl + wave * 8192);
            for (int task = gw; task < (T / 32) * 8; task += NGW) select_task(PQ, KEYS + (size_t)l * 8 * 2 * 128 * 128, IDS, GATES, task >> 3, task & 7, lscr, lane);
        }
        SEAM(pb + 8);
        if (PHEN(9) && IN(pb + 9)) { PH_BEGIN();
            for (int m = gw; m < T; m += NGW) gather_token(xo + (size_t)m * DM, GIN(11) + (size_t)l * DM, IDS + (size_t)m * 128, GATES + (size_t)m * 128,
                                                           UTAB + (size_t)l * NEXP * DM, VTAB + (size_t)l * NEXP * DM, lane);
        }
        SEAM(pb + 9);
    }
#undef IN
#undef SEAM
}

extern "C" void kernel_launch(void* const* d_in, const int* in_sizes, int n_in, void* d_out, int out_size, void* d_ws, size_t ws_size, hipStream_t stream) {
    static int grid = 0;
    if (grid == 0) {
        if (n_in != 16 || out_size != T * DM || ws_size < WS_END) { fprintf(stderr, "kernel_launch: unexpected shapes: n_in %d out %d ws %zu (need >= %zu)\n", n_in, out_size, ws_size, (size_t)WS_END); grid = -1; return; }
        int dev = 0, cus = 0, per_cu = 0;
        if (hipGetDevice(&dev) != hipSuccess || hipDeviceGetAttribute(&cus, hipDeviceAttributeMultiprocessorCount, dev) != hipSuccess) { grid = -1; return; }
        if (hipFuncSetAttribute((const void*)mk_fwd, hipFuncAttributeMaxDynamicSharedMemorySize, LDS_BYTES) != hipSuccess) { fprintf(stderr, "kernel_launch: hipFuncSetAttribute failed\n"); grid = -1; return; }
        if (hipOccupancyMaxActiveBlocksPerMultiprocessor(&per_cu, (const void*)mk_fwd, NWAVES * 64, LDS_BYTES) != hipSuccess || per_cu < 1) { fprintf(stderr, "kernel_launch: occupancy query says %d blocks per CU\n", per_cu); }
        (void)hipGetLastError();
        grid = cus;
    }
    if (grid < 0) return;
    if (hipMemsetAsync((char*)d_ws + WS_CTL, 0, CTL_ZERO_BYTES, stream) != hipSuccess) return;
    Args a{};
    for (int i = 0; i < 16; ++i) a.in[i] = (const float*)d_in[i];
    a.out = (float*)d_out; a.ws = (unsigned char*)d_ws;
#if MK_ONE_LAUNCH
    a.ph_lo = 0; a.ph_hi = NPH;
    hipLaunchKernelGGL(mk_fwd, dim3(grid), dim3(NWAVES * 64), LDS_BYTES, stream, a);
#else
    for (int p = 0; p < NPH; ++p) { a.ph_lo = p; a.ph_hi = p + 1; hipLaunchKernelGGL(mk_fwd, dim3(grid), dim3(NWAVES * 64), LDS_BYTES, stream, a); }
#endif
    const hipError_t le = hipPeekAtLastError();
    if (le != hipSuccess) fprintf(stderr, "kernel_launch: launch failed: %s\n", hipGetErrorName(le));
}
```

```cpp
#include <hip/hip_runtime.h>
#include <cstdio>
#include <cstdint>
namespace pg8 {
#define PG8_LAS __attribute__((address_space(3)))
typedef unsigned short bf16_t;
typedef short bf16x8 __attribute__((ext_vector_type(8)));
typedef float f32x4 __attribute__((ext_vector_type(4)));
typedef unsigned u32x4 __attribute__((ext_vector_type(4)));
constexpr int BM = 256, BK = 64, HALF = 128, HTB = HALF * BK * 2  , STAGE_BYTES = 8 * HTB, NXCD = 8, WGM = 8;

__host__ __device__ __forceinline__ int lds_byte(int r, int c) { const int st = (r >> 4) * 2 + (c >> 5), rr = r & 15, cc = c & 31, ob = rr * 64 + cc * 2; return st * 1024 + (ob ^ (((ob >> 9) & 1) << 5)); }
__host__ __device__ __forceinline__ void stage_rc(int b, int& R, int& C) { const int st = b / 1024, sb = b % 1024, swz = sb ^ (((sb >> 9) & 1) << 5); R = (st >> 1) * 16 + swz / 64; C = (st & 1) * 32 + (swz % 64) / 2; }
__host__ __device__ __forceinline__ int perm32(int rho) { const int n = rho >> 4, i = rho & 15; return 8 * (i >> 2) + 4 * n + (i & 3); }

struct Unit { int pm, pn; };
struct Gemm { const bf16_t* A; const bf16_t* Bt; int M, N, K; };

struct StaticOrder {
    int nM, nN, nwg, G, c;
    __host__ __device__ void init(int M, int N, int G_, int c_) { nM = M / BM; nN = N / BM; nwg = nM * nN; G = G_; c = c_; }
    __host__ __device__ bool next(int i, Unit& u) const {
        const long L = (long)i * G + c; if (L >= nwg) return false;
        int wgid = (int)L; { const int q = nwg / NXCD, r = nwg % NXCD, xcd = wgid % NXCD, off = wgid / NXCD; wgid = (xcd < r ? xcd * (q + 1) : r * (q + 1) + (xcd - r) * q) + off; }
        const int nig = WGM * nN, gid = wgid / nig, fm = gid * WGM, gsz = (nM - fm) < WGM ? (nM - fm) : WGM;
        u.pm = fm + ((wgid % nig) % gsz); u.pn = (wgid % nig) / gsz; return true;
    }
    __device__ __forceinline__ void a_ready(const Unit&) const {}
    __device__ __forceinline__ void done(const Unit&) const {}
};
struct CountedOrder : StaticOrder {
    const unsigned* ready; unsigned need; unsigned* tmo;
    __device__ __forceinline__ void a_ready(const Unit& u) const {
        if (threadIdx.x < 64) {
            const unsigned long long t0 = __builtin_amdgcn_s_memrealtime(); unsigned polls = 0;
            while ((unsigned)__builtin_amdgcn_readfirstlane(__hip_atomic_load(ready + 64 * u.pm, __ATOMIC_RELAXED, __HIP_MEMORY_SCOPE_AGENT)) < need) {
                if ((++polls & 255u) == 0u && __builtin_amdgcn_readfirstlane(__hip_atomic_load(tmo, __ATOMIC_RELAXED, __HIP_MEMORY_SCOPE_AGENT)) != 0u) break;
                if (__builtin_amdgcn_s_memrealtime() - t0 > 2000000ull) {
                    if (threadIdx.x == 0) { unsigned expect = 0u; __hip_atomic_compare_exchange_strong(tmo + 1, &expect, 0x600u | (unsigned)(u.pm & 0xff), __ATOMIC_RELAXED, __ATOMIC_RELAXED, __HIP_MEMORY_SCOPE_AGENT); __hip_atomic_store(tmo, 1u, __ATOMIC_RELAXED, __HIP_MEMORY_SCOPE_AGENT); }
                    break; }
                __builtin_amdgcn_s_sleep(2); }
            __builtin_amdgcn_fence(__ATOMIC_ACQUIRE, "agent");
            asm volatile("s_waitcnt vmcnt(0)" ::: "memory");
        }
#if !defined(BROKEN_HOOK_NO_BARRIER)
        asm volatile("" ::: "memory"); __builtin_amdgcn_s_barrier(); asm volatile("" ::: "memory");
#endif
    }
};

__device__ __forceinline__ unsigned cvt_pk_bf16(float lo, float hi) { unsigned r; asm volatile("v_cvt_pk_bf16_f32 %0, %1, %2" : "=v"(r) : "v"(lo), "v"(hi)); return r; }
typedef float f32x2 __attribute__((ext_vector_type(2)));
__device__ __forceinline__ f32x2 gelu_pk(f32x2 v) {
    const f32x2 av = __builtin_elementwise_abs(v), d = av * 0.2316418882f + 1.0f;
    f32x2 t; t.x = __builtin_amdgcn_rcpf(d.x); t.y = __builtin_amdgcn_rcpf(d.y);
    f32x2 q = t * 0.5307027145f + (-0.7265760135f); q = q * t + 0.7107068705f; q = q * t + (-0.142248368f); q = q * t + 0.127414796f; q = q * t;
    const f32x2 s = (v * v) * (-0.72134752044f);
    f32x2 e; e.x = __builtin_amdgcn_exp2f(s.x); e.y = __builtin_amdgcn_exp2f(s.y);
    const f32x2 m = v * (q * e), r = v - m;
    f32x2 o; o.x = v.x < 0.f ? m.x : r.x; o.y = v.y < 0.f ? m.y : r.y; return o;
}

struct EpiF32 {
    static constexpr bool PERM = false, AFTER_DRAIN = false;
    float* C; int ldc; const float* bias;
    __device__ __forceinline__ void operator()(const f32x4 (&acc)[2][2][4][2], const Unit& u, int wr, int wc, int fr, int fq) const {
        const int row0 = u.pm * BM + wr * 64 + fr, col0 = u.pn * BM + wc * 32 + 4 * fq;
        f32x4 bv[2][2];
#pragma unroll
        for (int bj = 0; bj < 2; ++bj)
#pragma unroll
            for (int n = 0; n < 2; ++n) bv[bj][n] = bias ? *(const f32x4*)(bias + col0 + bj * HALF + n * 16) : (f32x4){0.f, 0.f, 0.f, 0.f};
#pragma unroll
        for (int ai = 0; ai < 2; ++ai)
#pragma unroll
            for (int m = 0; m < 4; ++m) { float* rowp = C + (size_t)(row0 + ai * HALF + m * 16) * ldc + col0;
#pragma unroll
                for (int bj = 0; bj < 2; ++bj)
#pragma unroll
                    for (int n = 0; n < 2; ++n) *(f32x4*)(rowp + bj * HALF + n * 16) = acc[ai][bj][m][n] + bv[bj][n]; }
    }
};
template <int ACT  > struct EpiBf16 {
    static constexpr bool PERM = true, AFTER_DRAIN = false;
    bf16_t* O; int ldc; const float* bias; int split_cols; size_t split_stride;
    __device__ __forceinline__ void operator()(const f32x4 (&acc)[2][2][4][2], const Unit& u, int wr, int wc, int fr, int fq) const {
        const int row0 = u.pm * BM + wr * 64 + fr; int colt = u.pn * BM; bf16_t* base = O;
        if (split_cols) { const int t = colt / split_cols; base += (size_t)t * split_stride; colt -= t * split_cols; }
        const int col0 = colt + wc * 32 + 8 * fq, bcol0 = u.pn * BM + wc * 32 + 8 * fq;
        f32x4 bv[2][2];
#pragma unroll
        for (int bj = 0; bj < 2; ++bj)
#pragma unroll
            for (int n = 0; n < 2; ++n) bv[bj][n] = bias ? *(const f32x4*)(bias + bcol0 + bj * HALF + 4 * n) : (f32x4){0.f, 0.f, 0.f, 0.f};
#pragma unroll
        for (int ai = 0; ai < 2; ++ai)
#pragma unroll
            for (int m = 0; m < 4; ++m) { bf16_t* rowp = base + (size_t)(row0 + ai * HALF + m * 16) * ldc + col0;
#pragma unroll
                for (int bj = 0; bj < 2; ++bj) { f32x4 v0 = acc[ai][bj][m][0] + bv[bj][0], v1 = acc[ai][bj][m][1] + bv[bj][1];
                    if (ACT == 1) { f32x2 a = gelu_pk((f32x2){v0[0], v0[1]}), b = gelu_pk((f32x2){v0[2], v0[3]}), c = gelu_pk((f32x2){v1[0], v1[1]}), d = gelu_pk((f32x2){v1[2], v1[3]});
                        v0 = (f32x4){a.x, a.y, b.x, b.y}; v1 = (f32x4){c.x, c.y, d.x, d.y}; }
                    if (ACT == 2) {
#pragma unroll
                        for (int j = 0; j < 4; ++j) { v0[j] = 0.5f * v0[j] * (1.0f + erff(v0[j] * 0.70710678f)); v1[j] = 0.5f * v1[j] * (1.0f + erff(v1[j] * 0.70710678f)); } }
                    u32x4 w; w.x = cvt_pk_bf16(v0[0], v0[1]); w.y = cvt_pk_bf16(v0[2], v0[3]); w.z = cvt_pk_bf16(v1[0], v1[1]); w.w = cvt_pk_bf16(v1[2], v1[3]);
                    *(u32x4*)(rowp + bj * HALF) = w; } }
    }
};

template <class Epi, class Sched, bool STAMP = false>
__device__ __forceinline__ void gemm_phase(PG8_LAS unsigned char* lds, const Gemm g, const Sched& S, const Epi& E, unsigned long long* stamps, int tid_in) {
    int tid_ = tid_in; asm volatile("" : "+v"(tid_));
    const int tid = tid_, wid = __builtin_amdgcn_readfirstlane(tid >> 6), lane = tid & 63, wr = wid >> 2, wc = wid & 3, fr = lane & 15, fq = lane >> 4;
    const int K = g.K, nt = K / BK;
    int ts_lo = 0, ts_hi = 0, nts = 0; const unsigned long long rt_entry = STAMP ? (unsigned long long)wall_clock64() : 0ull;
#define PG8_STAMP() do { if (STAMP && wid == 0 && nts < 64) { const unsigned long long _c = (unsigned long long)clock64(); \
        ts_lo = (lane == nts) ? (int)(unsigned)_c : ts_lo; ts_hi = (lane == nts) ? (int)(unsigned)(_c >> 32) : ts_hi; ++nts; } } while (0)
    PG8_STAMP();
    unsigned voffA[2], voffB[2];
#pragma unroll
    for (int i = 0; i < 2; ++i) { int R, C; stage_rc(tid * 16 + i * 8192, R, C); const int Rb = Epi::PERM ? ((R & ~31) + perm32(R & 31)) : R;
        voffA[i] = (unsigned)(R * K + C) * 2u; voffB[i] = (unsigned)(Rb * K + C) * 2u; }
    const size_t kstep = (size_t)(BK * 2);
    const size_t hstep = (size_t)HALF * K * 2;
    const size_t tstep = 2 * hstep;
    const unsigned ldsw = (unsigned)wid * 1024u;
    const int aoff = lds_byte(wr * 64 + fr, fq * 8), boff = lds_byte(wc * 32 + fr, fq * 8);
#define PG8_SA(b, h) (((b) * 2 + (h)) * HTB)
#define PG8_SB(b, h) ((4 + (b) * 2 + (h)) * HTB)
#define PG8_STAGE(bufoff, gbase, voff) do { _Pragma("unroll") for (int _i = 0; _i < 2; ++_i) \
        __builtin_amdgcn_global_load_lds((const unsigned*)((const char*)(gbase) + (voff)[_i]), (PG8_LAS unsigned*)(lds + (bufoff) + ldsw + _i * 8192), 16, 0, 0); } while (0)
#define PG8_LDA(dst, b, h) do { _Pragma("unroll") for (int m = 0; m < 4; ++m) _Pragma("unroll") for (int k = 0; k < 2; ++k) dst[m][k] = *(const PG8_LAS bf16x8*)(lds + PG8_SA(b, h) + aoff + m * 2048 + k * 1024); } while (0)
#define PG8_LDB(dst, b, h) do { _Pragma("unroll") for (int n = 0; n < 2; ++n) _Pragma("unroll") for (int k = 0; k < 2; ++k) dst[n][k] = *(const PG8_LAS bf16x8*)(lds + PG8_SB(b, h) + boff + n * 2048 + k * 1024); } while (0)
#define PG8_MMA(ai, bj, At, Bt) do { __builtin_amdgcn_s_setprio(1); _Pragma("unroll") for (int m = 0; m < 4; ++m) _Pragma("unroll") for (int n = 0; n < 2; ++n) _Pragma("unroll") for (int k = 0; k < 2; ++k) \
        acc[ai][bj][m][n] = __builtin_amdgcn_mfma_f32_16x16x32_bf16(Bt[n][k], At[m][k], acc[ai][bj][m][n], 0, 0, 0); __builtin_amdgcn_s_setprio(0); } while (0)
#define PG8_WAIT_V(n) asm volatile("s_waitcnt vmcnt(" #n ")" ::: "memory")
#define PG8_WAIT_L(n) asm volatile("s_waitcnt lgkmcnt(" #n ")" ::: "memory")
#define PG8_BAR __builtin_amdgcn_s_barrier()
#define PG8_SCHED __builtin_amdgcn_sched_barrier(0)
    Unit cur, nxt; int ui = 0;
    if (!S.next(0, cur)) return;
    f32x4 acc[2][2][4][2];
#pragma unroll
    for (int a = 0; a < 2; ++a)
#pragma unroll
        for (int b = 0; b < 2; ++b)
#pragma unroll
            for (int m = 0; m < 4; ++m)
#pragma unroll
                for (int n = 0; n < 2; ++n) acc[a][b][m][n] = (f32x4){0.f, 0.f, 0.f, 0.f};
    bf16x8 At[4][2], B0[2][2], B1[2][2];
    const char* cA = (const char*)g.A + (size_t)cur.pm * tstep; const char* cB = (const char*)g.Bt + (size_t)cur.pn * tstep;
    S.a_ready(cur);
    PG8_STAGE(PG8_SB(0, 0), cB, voffB); PG8_STAGE(PG8_SA(0, 0), cA, voffA); PG8_STAGE(PG8_SB(0, 1), cB + hstep, voffB); PG8_STAGE(PG8_SA(0, 1), cA + hstep, voffA);
    if (wr == 1) PG8_BAR;
    PG8_WAIT_V(4); PG8_BAR;
    PG8_STAGE(PG8_SB(1, 0), cB + kstep, voffB); PG8_STAGE(PG8_SA(1, 0), cA + kstep, voffA); PG8_STAGE(PG8_SB(1, 1), cB + hstep + kstep, voffB);
    PG8_WAIT_V(6); PG8_BAR;
    PG8_STAMP();
    for (;;) {
        const bool has_next = S.next(ui + 1, nxt);
        const char* nA = has_next ? (const char*)g.A + (size_t)nxt.pm * tstep : cA; const char* nB = has_next ? (const char*)g.Bt + (size_t)nxt.pn * tstep : cB;
        for (int t = 0; t < nt; t += 2) {
            const bool last = (t == nt - 2);
            const char* a1 = cA + (size_t)(t + 1) * kstep;
            const char* a2 = last ? nA : cA + (size_t)(t + 2) * kstep; const char* b2 = last ? nB : cB + (size_t)(t + 2) * kstep;
            const char* a3 = a2 + kstep; const char* b3 = b2 + kstep;
            if (last && has_next) S.a_ready(nxt);
            PG8_LDB(B0, 0, 0); PG8_SCHED; PG8_LDA(At, 0, 0); PG8_STAGE(PG8_SA(1, 1), a1 + hstep, voffA);
            PG8_WAIT_L(8); PG8_BAR; PG8_WAIT_L(0); PG8_MMA(0, 0, At, B0); PG8_BAR; PG8_SCHED;
            PG8_LDB(B1, 0, 1); PG8_STAGE(PG8_SB(0, 0), b2, voffB);
            PG8_BAR; PG8_WAIT_L(0); PG8_MMA(0, 1, At, B1); PG8_BAR;
            PG8_LDA(At, 0, 1); PG8_STAGE(PG8_SA(0, 0), a2, voffA);
            PG8_BAR; PG8_WAIT_L(0); PG8_MMA(1, 0, At, B0); PG8_BAR; PG8_SCHED;
            PG8_STAGE(PG8_SB(0, 1), b2 + hstep, voffB);
            PG8_WAIT_V(6); PG8_BAR; PG8_MMA(1, 1, At, B1); PG8_BAR;
            PG8_LDB(B0, 1, 0); PG8_SCHED; PG8_LDA(At, 1, 0); PG8_STAGE(PG8_SA(0, 1), a2 + hstep, voffA);
            PG8_WAIT_L(8); PG8_BAR; PG8_WAIT_L(0); PG8_MMA(0, 0, At, B0); PG8_BAR; PG8_SCHED;
            PG8_LDB(B1, 1, 1); PG8_STAGE(PG8_SB(1, 0), b3, voffB);
            PG8_BAR; PG8_WAIT_L(0); PG8_MMA(0, 1, At, B1); PG8_BAR;
            PG8_LDA(At, 1, 1); PG8_STAGE(PG8_SA(1, 0), a3, voffA);
            PG8_BAR; PG8_WAIT_L(0); PG8_MMA(1, 0, At, B0); PG8_BAR; PG8_SCHED;
            PG8_STAGE(PG8_SB(1, 1), b3 + hstep, voffB);
            PG8_WAIT_V(6); PG8_BAR; PG8_MMA(1, 1, At, B1); PG8_BAR;
        }
        PG8_STAMP();
        if constexpr (!Epi::AFTER_DRAIN) { E(acc, cur, wr, wc, fr, fq); S.done(cur); }
        PG8_STAMP();
        if (!has_next) break;
#pragma unroll
        for (int a = 0; a < 2; ++a)
#pragma unroll
            for (int b = 0; b < 2; ++b)
#pragma unroll
                for (int m = 0; m < 4; ++m)
#pragma unroll
                    for (int n = 0; n < 2; ++n) acc[a][b][m][n] = (f32x4){0.f, 0.f, 0.f, 0.f};
        cur = nxt; cA = nA; cB = nB; ++ui;
    }
    PG8_WAIT_V(0);
    if (wr == 0) PG8_BAR;
    PG8_BAR;
    if constexpr (Epi::AFTER_DRAIN) { E.fused(acc, cur, wr, wc, fr, fq, lds, wid, lane); S.done(cur); }
    PG8_STAMP();
    if (STAMP && wid == 0) { stamps[lane] = lane < nts ? (((unsigned long long)(unsigned)ts_hi << 32) | (unsigned)ts_lo) : 0ull;
        if (lane == 62) stamps[62] = rt_entry; if (lane == 63) stamps[63] = (unsigned long long)wall_clock64(); }
#undef PG8_STAMP
#undef PG8_SA
#undef PG8_SB
#undef PG8_STAGE
#undef PG8_LDA
#undef PG8_LDB
#undef PG8_MMA
#undef PG8_WAIT_V
#undef PG8_WAIT_L
#undef PG8_BAR
#undef PG8_SCHED
}
}
namespace sel {
#define SEL_HD __host__ __device__ __forceinline__
#if defined(__HIP_DEVICE_COMPILE__)
SEL_HD int imax(int a, int b) { int r; asm("v_max_f32 %0, %1, %2" : "=v"(r) : "v"(a), "v"(b)); return r; }
SEL_HD int imin(int a, int b) { int r; asm("v_min_f32 %0, %1, %2" : "=v"(r) : "v"(a), "v"(b)); return r; }
#else
SEL_HD int imax(int a, int b) { return __builtin_bit_cast(int, __builtin_fmaxf(__builtin_bit_cast(float, a), __builtin_bit_cast(float, b))); }
SEL_HD int imin(int a, int b) { return __builtin_bit_cast(int, __builtin_fminf(__builtin_bit_cast(float, a), __builtin_bit_cast(float, b))); }
#endif
constexpr int SEL_PAD = (int)0xff800000;
SEL_HD int f2key(float f) { return __builtin_bit_cast(int, f); }
SEL_HD float key2f(int k) { return __builtin_bit_cast(float, k); }
#define SEL_CE(i, j) do { const int hi_ = imax(a[i], a[j]), lo_ = imin(a[i], a[j]); a[i] = hi_; a[j] = lo_; } while (0)
template <int N> SEL_HD void sort_desc(int (&a)[N]) {
    if constexpr (N == 16) {
        SEL_CE(0,13); SEL_CE(1,12); SEL_CE(2,15); SEL_CE(3,14); SEL_CE(4,8); SEL_CE(5,6); SEL_CE(7,11); SEL_CE(9,10);
        SEL_CE(0,5); SEL_CE(1,7); SEL_CE(2,9); SEL_CE(3,4); SEL_CE(6,13); SEL_CE(8,14); SEL_CE(10,15); SEL_CE(11,12);
        SEL_CE(0,1); SEL_CE(2,3); SEL_CE(4,5); SEL_CE(6,8); SEL_CE(7,9); SEL_CE(10,11); SEL_CE(12,13); SEL_CE(14,15);
        SEL_CE(0,2); SEL_CE(1,3); SEL_CE(4,10); SEL_CE(5,11); SEL_CE(6,7); SEL_CE(8,9); SEL_CE(12,14); SEL_CE(13,15);
        SEL_CE(1,2); SEL_CE(3,12); SEL_CE(4,6); SEL_CE(5,7); SEL_CE(8,10); SEL_CE(9,11); SEL_CE(13,14);
        SEL_CE(1,4); SEL_CE(2,6); SEL_CE(5,8); SEL_CE(7,10); SEL_CE(9,13); SEL_CE(11,14);
        SEL_CE(2,4); SEL_CE(3,6); SEL_CE(9,12); SEL_CE(11,13);
        SEL_CE(3,5); SEL_CE(6,8); SEL_CE(7,9); SEL_CE(10,12);
        SEL_CE(3,4); SEL_CE(5,6); SEL_CE(7,8); SEL_CE(9,10); SEL_CE(11,12);
        SEL_CE(6,7); SEL_CE(8,9);
        return;
    }
#pragma unroll
    for (int k = 2; k <= N; k <<= 1) {
#pragma unroll
        for (int j = k >> 1; j > 0; j >>= 1) {
#pragma unroll
            for (int i = 0; i < N; ++i) {
                const int l = i ^ j;
                if (l > i) { const bool desc = ((i & k) == 0); const int hi = imax(a[i], a[l]), lo = imin(a[i], a[l]); a[i] = desc ? hi : lo; a[l] = desc ? lo : hi; }
            }
        }
    }
}
SEL_HD void merge_desc16(int (&a)[16]) {
#pragma unroll
    for (int j = 8; j > 0; j >>= 1) {
#pragma unroll
        for (int i = 0; i < 16; ++i) { const int l = i ^ j; if (l > i) { const int hi = imax(a[i], a[l]), lo = imin(a[i], a[l]); a[i] = hi; a[l] = lo; } }
    }
}
SEL_HD void top16_merge(int (&a)[16], const int (&b)[16]) {
#pragma unroll
    for (int i = 0; i < 16; ++i) a[i] = imax(a[i], b[15 - i]);
    merge_desc16(a);
}
SEL_HD void cand_top16(const int (&a)[16], const int (&b)[16], int (&c0)[16]) {
    float av[16], bv[16];
#pragma unroll
    for (int i = 0; i < 16; ++i) { av[i] = key2f(a[i] & ~127); bv[i] = key2f(b[i] & ~127); }
    int c1[16], c2[16]; int x0 = SEL_PAD, x1 = SEL_PAD;
    {
        int n = 0;
#pragma unroll
        for (int i = 0; i < 16; ++i) {
#pragma unroll
            for (int j = 0; j < 16; ++j) {
                if ((i + 1) * (j + 1) <= 16) {
                    const int key = (f2key(av[i] + bv[j]) & ~255) | (i << 4) | j;
                    if (n < 16) c0[n & 15] = key; else if (n < 32) c1[n & 15] = key; else if (n < 48) c2[n & 15] = key; else if (n == 48) x0 = key; else x1 = key;
                    ++n;
                }
            }
        }
    }
    sort_desc(c0); sort_desc(c1); sort_desc(c2);
    { const int xh = imax(x0, x1), xl = imin(x0, x1);
      c2[14] = imax(c2[14], xl); c2[15] = imax(c2[15], xh); merge_desc16(c2); }
    top16_merge(c0, c1); top16_merge(c0, c2);
}
}
namespace att {
using bf16 = unsigned short;
constexpr int   D = 128, NW = 8, QBLK = 32, KVBLK = 64;
constexpr float SCALE = 0.088388347648318440f;
constexpr float THR = 8.f;
constexpr size_t SHM_V = KVBLK * D * 2, SHM_K = KVBLK * D * 2, SHM_ATTN = 2 * SHM_V + 2 * SHM_K + NW * 64 * 4;
constexpr size_t SHM_NA_BIAS = SHM_ATTN;
using bf16x8 = __attribute__((ext_vector_type(8))) short;
using s16x4  = __attribute__((ext_vector_type(4))) short;
using f32x16 = __attribute__((ext_vector_type(16))) float;
using u32x4  = __attribute__((ext_vector_type(4))) unsigned;
#define KSWZ(row, colB) ((row) * 256 + ((colB) ^ (((row) & 7) << 4)))
#define SBAR() __builtin_amdgcn_sched_barrier(0)
__device__ __forceinline__ int crow(int r, int hi) { return (r & 3) + 8 * (r >> 2) + 4 * hi; }
__device__ __forceinline__ unsigned cvtpk(float lo, float hi) { unsigned r; asm volatile("v_cvt_pk_bf16_f32 %0, %1, %2" : "=v"(r) : "v"(lo), "v"(hi)); return r; }
__device__ __forceinline__ bf16x8 ld8(const bf16* p) { return *reinterpret_cast<const bf16x8*>(p); }

__device__ __forceinline__ void partialSM(f32x16& p0, f32x16& p1, float& m_reg, float& mn, float& alpha) {
  constexpr float C = SCALE * 1.4426950408889634f;
  float pmax = p0[0]; for (int r = 1; r < 16; ++r) pmax = fmaxf(pmax, p0[r]); for (int r = 0; r < 16; ++r) pmax = fmaxf(pmax, p1[r]);
  { auto rr = __builtin_amdgcn_permlane32_swap(__float_as_uint(pmax), __float_as_uint(pmax), false, false);
    pmax = fmaxf(__uint_as_float(rr[0]), __uint_as_float(rr[1])); }
  if (__builtin_expect(__all(pmax - m_reg <= THR / SCALE), 1)) { mn = m_reg; alpha = 1.f; }
  else { mn = fmaxf(m_reg, pmax); alpha = __builtin_amdgcn_exp2f((m_reg - mn) * C); m_reg = mn; }
  float mnC = -mn * C;
  for (int r = 0; r < 16; ++r) p0[r] = fmaf(p0[r], C, mnC); for (int r = 0; r < 16; ++r) p1[r] = fmaf(p1[r], C, mnC);
  for (int r = 0; r < 16; ++r) p0[r] = __builtin_amdgcn_exp2f(p0[r]);
}
__device__ __forceinline__ void partialSM_fix(f32x16& p0, f32x16& p1, float negMC) {
  constexpr float C = SCALE * 1.4426950408889634f;
  for (int r = 0; r < 16; ++r) p0[r] = fmaf(p0[r], C, negMC); for (int r = 0; r < 16; ++r) p1[r] = fmaf(p1[r], C, negMC);
  for (int r = 0; r < 16; ++r) p0[r] = __builtin_amdgcn_exp2f(p0[r]);
}
__device__ __forceinline__ void partialSM_na(f32x16& p0, f32x16& p1, float& m_reg, float& mn, float& alpha, const float* brow, bool rowok, int c, int cs, int hi) {
  constexpr float C = SCALE * 1.4426950408889634f;
  const float ninf = -__builtin_inff();
#pragma unroll
  for (int r = 0; r < 16; ++r) {
    const int kc0 = crow(r, hi), kc1 = 32 + kc0;
    const bool ok0 = rowok && ((unsigned)(kc0 - cs) < 16u), ok1 = rowok && ((unsigned)(kc1 - cs) < 16u);
    const int d0 = ok0 ? (kc0 - c + 15) : 0, d1 = ok1 ? (kc1 - c + 15) : 0;
    const float b0 = brow[d0], b1 = brow[d1];
    p0[r] = ok0 ? fmaf(p0[r], C, b0) : ninf;
    p1[r] = ok1 ? fmaf(p1[r], C, b1) : ninf;
  }
  float pmax = p0[0]; for (int r = 1; r < 16; ++r) pmax = fmaxf(pmax, p0[r]); for (int r = 0; r < 16; ++r) pmax = fmaxf(pmax, p1[r]);
  { auto rr = __builtin_amdgcn_permlane32_swap(__float_as_uint(pmax), __float_as_uint(pmax), false, false);
    pmax = fmaxf(__uint_as_float(rr[0]), __uint_as_float(rr[1])); }
  if (__all(pmax - m_reg <= THR * 1.4426950408889634f)) { mn = m_reg; alpha = 1.f; }
  else { mn = fmaxf(m_reg, pmax); alpha = __builtin_amdgcn_exp2f(m_reg - mn); m_reg = mn; }
  for (int r = 0; r < 16; ++r) p0[r] = p0[r] - mn; for (int r = 0; r < 16; ++r) p1[r] = p1[r] - mn;
  for (int r = 0; r < 16; ++r) p0[r] = __builtin_amdgcn_exp2f(p0[r]);
}
__device__ __forceinline__ void finishSM(f32x16& p0, f32x16& p1, float alpha, float& l_reg, bf16x8& pa0, bf16x8& pa1, bf16x8& pa2, bf16x8& pa3) {
  for (int r = 0; r < 16; ++r) p1[r] = __builtin_amdgcn_exp2f(p1[r]);
  float ps = 0; for (int r = 0; r < 16; ++r) ps += p0[r]; for (int r = 0; r < 16; ++r) ps += p1[r];
  { auto rr = __builtin_amdgcn_permlane32_swap(__float_as_uint(ps), __float_as_uint(ps), false, false);
    ps = __uint_as_float(rr[0]) + __uint_as_float(rr[1]); }
  l_reg = l_reg * alpha + ps;
#define PK4(P, BASE, OUT) do { unsigned a0 = cvtpk(P[BASE + 0], P[BASE + 1]), a1 = cvtpk(P[BASE + 2], P[BASE + 3]);   \
    unsigned b0 = cvtpk(P[BASE + 4], P[BASE + 5]), b1 = cvtpk(P[BASE + 6], P[BASE + 7]);                              \
    auto r0 = __builtin_amdgcn_permlane32_swap(a0, b0, false, false); auto r1 = __builtin_amdgcn_permlane32_swap(a1, b1, false, false); \
    u32x4 w = {r0[0], r1[0], r0[1], r1[1]}; OUT = *reinterpret_cast<bf16x8*>(&w); } while (0)
  PK4(p0, 0, pa0); PK4(p0, 8, pa1); PK4(p1, 0, pa2); PK4(p1, 8, pa3);
#undef PK4
}
__device__ __forceinline__ void qkt(f32x16& p0, f32x16& p1, const bf16* Ks, const bf16x8* qr, int r32, int hi) {
  p0 = f32x16{}; p1 = f32x16{};
  for (int d0 = 0; d0 < 8; ++d0) { int cb = (d0 * 16 + hi * 8) * 2;
    bf16x8 b0 = *reinterpret_cast<const bf16x8*>((const char*)Ks + KSWZ(r32, cb));
    bf16x8 b1 = *reinterpret_cast<const bf16x8*>((const char*)Ks + KSWZ(32 + r32, cb));
    p0 = __builtin_amdgcn_mfma_f32_32x32x16_bf16(b0, qr[d0], p0, 0, 0, 0);
    p1 = __builtin_amdgcn_mfma_f32_32x32x16_bf16(b1, qr[d0], p1, 0, 0, 0); }
}
__device__ __forceinline__ int v_st(int k, int c) { const int kk = (k & ~0xC) | ((k & 4) << 1) | ((k & 8) >> 1); return ((kk >> 3) * 4 + (c >> 5)) * 512 + ((kk & 7) * 32 + (c & 31)) * 2; }
__device__ __forceinline__ int v_rd_base(int lane) { return ((lane & 3) << 3) | (((lane >> 2) & 3) << 6) | (((lane >> 4) & 1) << 5) | (((lane >> 5) & 1) << 8); }
constexpr int v_rd_off(int d0, int ks, int half) { return d0 * 512 + ks * 4096 + half * 2048; }
template <int OFF> __device__ __forceinline__ s16x4 tr_read(int vb) {
  s16x4 r; asm volatile("ds_read_b64_tr_b16 %0, %1 offset:%2" : "=&v"(r) : "v"(vb), "i"(OFF) : "memory"); return r;
}
template <int D0> __device__ __forceinline__ void pv_one(f32x16& od, int vb, bf16x8 pa0, bf16x8 pa1, bf16x8 pa2, bf16x8 pa3) {
  const s16x4 l0 = tr_read<v_rd_off(D0, 0, 0)>(vb), h0 = tr_read<v_rd_off(D0, 0, 1)>(vb), l1 = tr_read<v_rd_off(D0, 1, 0)>(vb), h1 = tr_read<v_rd_off(D0, 1, 1)>(vb);
  const s16x4 l2 = tr_read<v_rd_off(D0, 2, 0)>(vb), h2 = tr_read<v_rd_off(D0, 2, 1)>(vb), l3 = tr_read<v_rd_off(D0, 3, 0)>(vb), h3 = tr_read<v_rd_off(D0, 3, 1)>(vb);
  asm volatile("s_waitcnt lgkmcnt(0)" ::: "memory"); SBAR();
#define PK(L, H) (bf16x8){L[0], L[1], L[2], L[3], H[0], H[1], H[2], H[3]}
  od = __builtin_amdgcn_mfma_f32_32x32x16_bf16(pa0, PK(l0, h0), od, 0, 0, 0);
  od = __builtin_amdgcn_mfma_f32_32x32x16_bf16(pa1, PK(l1, h1), od, 0, 0, 0);
  od = __builtin_amdgcn_mfma_f32_32x32x16_bf16(pa2, PK(l2, h2), od, 0, 0, 0);
  od = __builtin_amdgcn_mfma_f32_32x32x16_bf16(pa3, PK(l3, h3), od, 0, 0, 0);
#undef PK
}
template <int D0, int KS0> __device__ __forceinline__ void pv_half(f32x16& od, int vb, bf16x8 pa, bf16x8 pb) {
  const s16x4 l0 = tr_read<v_rd_off(D0, KS0, 0)>(vb), h0 = tr_read<v_rd_off(D0, KS0, 1)>(vb), l1 = tr_read<v_rd_off(D0, KS0 + 1, 0)>(vb), h1 = tr_read<v_rd_off(D0, KS0 + 1, 1)>(vb);
  asm volatile("s_waitcnt lgkmcnt(0)" ::: "memory"); SBAR();
#define PK(L, H) (bf16x8){L[0], L[1], L[2], L[3], H[0], H[1], H[2], H[3]}
  od = __builtin_amdgcn_mfma_f32_32x32x16_bf16(pa, PK(l0, h0), od, 0, 0, 0);
  od = __builtin_amdgcn_mfma_f32_32x32x16_bf16(pb, PK(l1, h1), od, 0, 0, 0);
#undef PK
}
__device__ __forceinline__ void pv_d0h(f32x16* o, int vb, bf16x8 pa0, bf16x8 pa1, bf16x8 pa2, bf16x8 pa3) {
  pv_half<0, 0>(o[0], vb, pa0, pa1); pv_half<0, 2>(o[0], vb, pa2, pa3); pv_half<1, 0>(o[1], vb, pa0, pa1); pv_half<1, 2>(o[1], vb, pa2, pa3);
  pv_half<2, 0>(o[2], vb, pa0, pa1); pv_half<2, 2>(o[2], vb, pa2, pa3); pv_half<3, 0>(o[3], vb, pa0, pa1); pv_half<3, 2>(o[3], vb, pa2, pa3);
}
constexpr int pvw_off(int n, int dk, int hf) { return (n >> 3) * 16384 + v_rd_off((n >> 1) & 3, (n & 1) * 2 + dk, hf); }
#define PVW_RD(n, L0, H0, L1, H1) do { L0 = tr_read<pvw_off(n, 0, 0)>(vb); H0 = tr_read<pvw_off(n, 0, 1)>(vb); L1 = tr_read<pvw_off(n, 1, 0)>(vb); H1 = tr_read<pvw_off(n, 1, 1)>(vb); } while (0)
#define PVW_PK(L, H) (bf16x8){L[0], L[1], L[2], L[3], H[0], H[1], H[2], H[3]}
#define PVW_MM(n, L0, H0, L1, H1) do { f32x16& od_ = o[((n) >> 3) * 4 + (((n) >> 1) & 3)]; \
    od_ = __builtin_amdgcn_mfma_f32_32x32x16_bf16(((n) & 1) ? pa2 : pa0, PVW_PK(L0, H0), od_, 0, 0, 0); \
    od_ = __builtin_amdgcn_mfma_f32_32x32x16_bf16(((n) & 1) ? pa3 : pa1, PVW_PK(L1, H1), od_, 0, 0, 0); } while (0)
#define PVW_STEP(n, CL0, CH0, CL1, CH1, NL0, NH0, NL1, NH1) do { PVW_RD((n) + 1, NL0, NH0, NL1, NH1); asm volatile("s_waitcnt lgkmcnt(4)" ::: "memory"); SBAR(); PVW_MM(n, CL0, CH0, CL1, CH1); SBAR(); } while (0)
__device__ __forceinline__ void pv_wide(f32x16* o, int vb, bf16x8 pa0, bf16x8 pa1, bf16x8 pa2, bf16x8 pa3) {
  s16x4 a0, a1, a2, a3, b0, b1, b2, b3;
  PVW_RD(0, a0, a1, a2, a3);
  PVW_STEP(0, a0, a1, a2, a3, b0, b1, b2, b3);  PVW_STEP(1, b0, b1, b2, b3, a0, a1, a2, a3);
  PVW_STEP(2, a0, a1, a2, a3, b0, b1, b2, b3);  PVW_STEP(3, b0, b1, b2, b3, a0, a1, a2, a3);
  PVW_STEP(4, a0, a1, a2, a3, b0, b1, b2, b3);  PVW_STEP(5, b0, b1, b2, b3, a0, a1, a2, a3);
  PVW_STEP(6, a0, a1, a2, a3, b0, b1, b2, b3);  PVW_STEP(7, b0, b1, b2, b3, a0, a1, a2, a3);
  PVW_STEP(8, a0, a1, a2, a3, b0, b1, b2, b3);  PVW_STEP(9, b0, b1, b2, b3, a0, a1, a2, a3);
  PVW_STEP(10, a0, a1, a2, a3, b0, b1, b2, b3); PVW_STEP(11, b0, b1, b2, b3, a0, a1, a2, a3);
  PVW_STEP(12, a0, a1, a2, a3, b0, b1, b2, b3); PVW_STEP(13, b0, b1, b2, b3, a0, a1, a2, a3);
  PVW_STEP(14, a0, a1, a2, a3, b0, b1, b2, b3);
  asm volatile("s_waitcnt lgkmcnt(0)" ::: "memory"); SBAR(); PVW_MM(15, b0, b1, b2, b3);
}
__device__ __forceinline__ void pv_d0(f32x16* o, int vb, bf16x8 pa0, bf16x8 pa1, bf16x8 pa2, bf16x8 pa3) {
  pv_one<0>(o[0], vb, pa0, pa1, pa2, pa3); pv_one<1>(o[1], vb, pa0, pa1, pa2, pa3); pv_one<2>(o[2], vb, pa0, pa1, pa2, pa3); pv_one<3>(o[3], vb, pa0, pa1, pa2, pa3);
}

template <int MODE, int SDEPTH, int LDQ, int LDK, int LDV, int LDO, bool OBF>
__device__ __forceinline__ void attn_body(const bf16* __restrict__ Qb, const bf16* __restrict__ Kh, const bf16* __restrict__ Vh,
                                          void* __restrict__ Obv, int seq, char* lds, int r0, int kr0, float negMC, int tid_in) {
  int tid_ = tid_in; asm volatile("" : "+v"(tid_));
  const int tid = tid_, wid = tid >> 6, lane = tid & 63, r32 = lane & 31, hi = lane >> 5;
  bf16* V_lds = (bf16*)lds; bf16* K_lds = (bf16*)(lds + 2 * SHM_V);
  float* ws = (float*)(lds + 2 * SHM_V + 2 * SHM_K) + wid * 64; float* li_l = ws; float* al_l = ws + 32;
  const float* blds = (const float*)(lds + SHM_NA_BIAS);
  float m_reg = -1e30f, l_reg = 0; f32x16 o[4] = {}; bf16x8 qr[8];
  const bf16* Qw = Qb + (long)(wid * QBLK + r32) * LDQ + hi * 8;
#pragma unroll
  for (int d0 = 0; d0 < 8; ++d0) qr[d0] = ld8(Qw + d0 * 16);
  const int qrow = r0 + (wid >> 1), qc = (wid & 1) * 32 + r32;
  const int rs = min(max(qrow - 4, 0), 56), cs = min(max(qc - 8, 0), 48);
  const int sr = tid >> 4, sc = (tid & 15) * 8, vst0 = v_st(sr, sc), vst1 = v_st(32 + sr, sc);
  const int vb0 = (int)(uintptr_t)V_lds + v_rd_base(lane);
  struct { bf16x8 vs0, vs1, ks0, ks1; } sr_[SDEPTH];
  const unsigned koff0 = (unsigned)(sr * LDK + sc) * 2u, koff1 = (unsigned)((32 + sr) * LDK + sc) * 2u, voff0 = (unsigned)(sr * LDV + sc) * 2u, voff1 = (unsigned)((32 + sr) * LDV + sc) * 2u;
#define SLOAD(i, k0) do { const char* kt_ = (const char*)Kh + (size_t)(k0) * (LDK * 2); const char* vt_ = (const char*)Vh + (size_t)(k0) * (LDV * 2); \
    sr_[i].vs0 = *(const bf16x8*)(vt_ + voff0); sr_[i].vs1 = *(const bf16x8*)(vt_ + voff1); \
    sr_[i].ks0 = *(const bf16x8*)(kt_ + koff0); sr_[i].ks1 = *(const bf16x8*)(kt_ + koff1); } while (0)
#define SWRITE(b, i) do { *(bf16x8*)((char*)V_lds + (b) * SHM_V + vst0) = sr_[i].vs0;          \
    *(bf16x8*)((char*)V_lds + (b) * SHM_V + vst1) = sr_[i].vs1; int kc = sc * 2;               \
    *(bf16x8*)((char*)K_lds + (b) * SHM_K + KSWZ(sr, kc)) = sr_[i].ks0;                       \
    *(bf16x8*)((char*)K_lds + (b) * SHM_K + KSWZ(32 + sr, kc)) = sr_[i].ks1; } while (0)
#define SWAIT() do { if constexpr (SDEPTH == 2) asm volatile("s_waitcnt vmcnt(4)" ::: "memory"); else asm volatile("s_waitcnt vmcnt(0)" ::: "memory"); } while (0)
#define RESC(a) do { if constexpr (MODE == 1) if (__any((a) < 1.f)) { if (hi == 0) al_l[r32] = (a); asm volatile("s_waitcnt lgkmcnt(0)" ::: "memory"); \
    for (int d = 0; d < 4; ++d) for (int r = 0; r < 16; ++r) o[d][r] *= al_l[crow(r, hi)]; } } while (0)
#define PSM(P0, P1, MN, AL, J) do { if constexpr (MODE == 0) { partialSM_fix(P0, P1, negMC); AL = 1.f; } else { const int kr_ = kr0 + (J); const bool ok_ = (kr_ >= rs) && (kr_ < rs + 8); \
    const int dr_ = ok_ ? (kr_ - qrow + 7) : 0; partialSM_na(P0, P1, m_reg, MN, AL, blds + dr_ * 31, ok_, qc, cs, hi); } } while (0)
  f32x16 pA0, pA1, pB0, pB1; float mnA, mnB, alA, alB; bf16x8 pa0, pa1, pa2, pa3; const int NT = seq / KVBLK;
  if constexpr (MODE == 1) {
    SLOAD(0, 0);
    for (int j = 0; j < NT; ++j) {
      asm volatile("s_waitcnt vmcnt(0)" ::: "memory"); SWRITE(j & 1, 0);
      if (j + 1 < NT) SLOAD(0, (j + 1) * KVBLK);
      __syncthreads();
      SBAR(); qkt(pA0, pA1, (bf16*)((char*)K_lds + (j & 1) * SHM_K), qr, r32, hi);
      PSM(pA0, pA1, mnA, alA, j); RESC(alA);
      finishSM(pA0, pA1, alA, l_reg, pa0, pa1, pa2, pa3); SBAR();
      pv_d0(o, vb0 + (j & 1) * (int)SHM_V, pa0, pa1, pa2, pa3);
    }
  } else {
  constexpr int SE = 0, SO = SDEPTH - 1;
  SLOAD(SE, 0); asm volatile("s_waitcnt vmcnt(0)" ::: "memory"); SWRITE(0, SE); __syncthreads();
  qkt(pA0, pA1, K_lds, qr, r32, hi); PSM(pA0, pA1, mnA, alA, 0);
  SLOAD(SO, KVBLK); if constexpr (SDEPTH == 2) { if (2 < NT) SLOAD(SE, 2 * KVBLK); }
  SWAIT(); SWRITE(1, SO); __syncthreads();
  for (int j = 1; j + 1 < NT; j += 2) {
    SBAR(); qkt(pB0, pB1, (bf16*)((char*)K_lds + SHM_K), qr, r32, hi);
    finishSM(pA0, pA1, alA, l_reg, pa0, pa1, pa2, pa3); SBAR();
    SLOAD(SO, (j + SDEPTH) * KVBLK); SBAR();
    pv_d0(o, vb0, pa0, pa1, pa2, pa3); PSM(pB0, pB1, mnB, alB, j);
    __syncthreads(); SWAIT(); SWRITE(0, SE);
    RESC(alB); __syncthreads();
    SBAR(); qkt(pA0, pA1, K_lds, qr, r32, hi);
    finishSM(pB0, pB1, alB, l_reg, pa0, pa1, pa2, pa3); SBAR();
    if (SDEPTH == 1 || j + 3 < NT) SLOAD(SE, (j + 1 + SDEPTH) * KVBLK); SBAR();
    pv_d0(o, vb0 + (int)SHM_V, pa0, pa1, pa2, pa3); PSM(pA0, pA1, mnA, alA, j + 1);
    __syncthreads(); SWAIT(); SWRITE(1, SO);
    RESC(alA); __syncthreads();
  }
  SBAR(); qkt(pB0, pB1, (bf16*)((char*)K_lds + SHM_K), qr, r32, hi);
  finishSM(pA0, pA1, alA, l_reg, pa0, pa1, pa2, pa3); SBAR();
  pv_d0(o, vb0, pa0, pa1, pa2, pa3); PSM(pB0, pB1, mnB, alB, NT - 1);
  __syncthreads(); RESC(alB);
  finishSM(pB0, pB1, alB, l_reg, pa0, pa1, pa2, pa3); SBAR();
  pv_d0(o, vb0 + (int)SHM_V, pa0, pa1, pa2, pa3);
  }
  if (hi == 0) li_l[r32] = l_reg; asm volatile("s_waitcnt lgkmcnt(0)" ::: "memory");
  float rli[16];
#pragma unroll
  for (int r = 0; r < 16; ++r) rli[r] = __builtin_amdgcn_rcpf(li_l[crow(r, hi)]);
  if constexpr (OBF) {
    bf16* Ow = (bf16*)Obv + (long)(wid * QBLK) * LDO;
#pragma unroll
    for (int r = 0; r < 16; ++r) { int orow = crow(r, hi);
      for (int d0 = 0; d0 < 4; ++d0) Ow[(long)orow * LDO + d0 * 32 + r32] = (bf16)(cvtpk(o[d0][r] * rli[r], 0.f) & 0xffffu); }
  } else {
    float* Ow = (float*)Obv + (long)(wid * QBLK) * LDO;
#pragma unroll
    for (int r = 0; r < 16; ++r) { int orow = crow(r, hi);
      for (int d0 = 0; d0 < 4; ++d0) Ow[(long)orow * LDO + d0 * 32 + r32] = o[d0][r] * rli[r]; }
  }
#undef SLOAD
#undef SWRITE
#undef SWAIT
#undef RESC
#undef PSM
}

#define ATT_LAS __attribute__((address_space(3)))
constexpr int WIDE_K_OFF = 0, WIDE_V_OFF = 49152, WIDE_RING_BYTES = 147456, WIDE_WS_OFF = 156672, WIDE_LDS_BYTES = WIDE_WS_OFF + NW * 256;
template <int LDQ, int LDK, int LDV, int LDO>
__device__ __forceinline__ void attn_wide_body(const bf16* __restrict__ Qb, const bf16* __restrict__ Kh, const bf16* __restrict__ Vh, bf16* __restrict__ Ob, int seq,
                                               ATT_LAS unsigned char* ldsl, char* lds, float negMC, int tid_in) {
  int tid_ = tid_in; asm volatile("" : "+v"(tid_));
  const int tid = tid_, wid = __builtin_amdgcn_readfirstlane(tid >> 6), lane = tid & 63, r32 = lane & 31, hi = lane >> 5;
  float* li_l = (float*)(lds + WIDE_WS_OFF) + wid * 64;
  float l_reg = 0; f32x16 o[8] = {}; bf16x8 qr[8];
  const bf16* Qw = Qb + (long)(wid * QBLK + r32) * LDQ + hi * 8;
#pragma unroll
  for (int d0 = 0; d0 < 8; ++d0) qr[d0] = ld8(Qw + d0 * 16);
#define WSRC() unsigned ksrc[2], vsrc[4]; { int ln = lane; asm volatile("" : "+v"(ln)); \
  _Pragma("unroll") for (int i = 0; i < 2; ++i) { const int p = wid * 2 + i, row = 4 * p + (ln >> 4), cc = (ln & 15) ^ (row & 7); ksrc[i] = (unsigned)(row * LDK * 2 + cc * 16); } \
  _Pragma("unroll") for (int i = 0; i < 4; ++i) { const int P = wid * 4 + i, hf = P >> 4, p = P & 15, j = p * 64 + ln, st = j >> 5, within = j & 31; \
    const int kk = (st >> 2) * 8 + (within >> 2), c = (st & 3) * 32 + (within & 3) * 8, k = (kk & ~0xC) | ((kk & 4) << 1) | ((kk & 8) >> 1); \
    vsrc[i] = (unsigned)(k * LDV * 2 + (hf * 128 + c) * 2); } }
  const int vb0 = (int)(uintptr_t)(lds + WIDE_V_OFF) + v_rd_base(lane);
#define WDMA(T, B) do { WSRC(); const char* kt_ = (const char*)Kh + (size_t)(T) * (KVBLK * LDK * 2); const char* vt_ = (const char*)Vh + (size_t)(T) * (KVBLK * LDV * 2); \
    _Pragma("unroll") for (int i_ = 0; i_ < 2; ++i_) __builtin_amdgcn_global_load_lds((const unsigned*)(kt_ + ksrc[i_]), (ATT_LAS unsigned*)(ldsl + WIDE_K_OFF + (B) * 16384 + (wid * 2 + i_) * 1024), 16, 0, 0); \
    _Pragma("unroll") for (int i_ = 0; i_ < 4; ++i_) __builtin_amdgcn_global_load_lds((const unsigned*)(vt_ + vsrc[i_]), (ATT_LAS unsigned*)(ldsl + WIDE_V_OFF + (B) * 32768 + (wid * 4 + i_) * 1024), 16, 0, 0); } while (0)
  const int NT = seq / KVBLK;
  f32x16 p0, p1; bf16x8 pa0, pa1, pa2, pa3;
#undef WDMA
#define WDMA(T, SL) do { WSRC(); const char* kt_ = (const char*)Kh + (size_t)(T) * (KVBLK * LDK * 2); const char* vt_ = (const char*)Vh + (size_t)(T) * (KVBLK * LDV * 2); \
    _Pragma("unroll") for (int i_ = 0; i_ < 2; ++i_) __builtin_amdgcn_global_load_lds((const unsigned*)(kt_ + ksrc[i_]), (ATT_LAS unsigned*)(ldsl + WIDE_K_OFF + (SL) * 16384 + (wid * 2 + i_) * 1024), 16, 0, 0); \
    _Pragma("unroll") for (int i_ = 0; i_ < 4; ++i_) __builtin_amdgcn_global_load_lds((const unsigned*)(vt_ + vsrc[i_]), (ATT_LAS unsigned*)(ldsl + WIDE_V_OFF + (SL) * 32768 + (wid * 4 + i_) * 1024), 16, 0, 0); } while (0)
#define WQKSM(SL) do { SBAR(); __builtin_amdgcn_s_setprio(1); qkt(p0, p1, (const bf16*)(lds + WIDE_K_OFF + (SL) * 16384), qr, r32, hi); __builtin_amdgcn_s_setprio(0); partialSM_fix(p0, p1, negMC); finishSM(p0, p1, 1.f, l_reg, pa0, pa1, pa2, pa3); SBAR(); } while (0)
#define WPV(SL) do { __builtin_amdgcn_s_setprio(1); pv_wide(o, vb0 + (SL) * 32768, pa0, pa1, pa2, pa3); __builtin_amdgcn_s_setprio(0); } while (0)
  WDMA(0, 0); WDMA(1, 1);
  int sl = 0;
  for (int j = 0; j < NT; ++j) {
    const int sl2 = (sl == 0) ? 2 : sl - 1;
    if (j + 1 < NT) asm volatile("s_waitcnt vmcnt(6)" ::: "memory"); else asm volatile("s_waitcnt vmcnt(0)" ::: "memory");
    __builtin_amdgcn_s_barrier(); asm volatile("" ::: "memory");
    if (j + 2 < NT) WDMA(j + 2, sl2);
    WQKSM(sl); WPV(sl);
    sl = (sl == 2) ? 0 : sl + 1;
  }
#undef WQKSM
#undef WPV
#undef WDMA
#undef WSRC
  if (hi == 0) li_l[r32] = l_reg; asm volatile("s_waitcnt lgkmcnt(0)" ::: "memory");
  float rli[16];
#pragma unroll
  for (int r = 0; r < 16; ++r) rli[r] = __builtin_amdgcn_rcpf(li_l[crow(r, hi)]);
  bf16* Ow = Ob + (long)(wid * QBLK) * LDO;
#pragma unroll
  for (int r = 0; r < 16; ++r) { const int orow = crow(r, hi);
#pragma unroll
    for (int d0 = 0; d0 < 8; ++d0) Ow[(long)orow * LDO + d0 * 32 + r32] = (bf16)(cvtpk(o[d0][r] * rli[r], 0.f) & 0xffffu); }
}
#undef KSWZ
}

constexpr int T = 8192, DM = 2048, SEQ = 4096, NB = 2, DEPTH = 4, INW = 5120, MIXW = 2048;
constexpr int OFF_DQ = 0, OFF_DK = 1024, OFF_DV = 2048, OFF_NQ = 3072, OFF_NK = 3584, OFF_NV = 4096, OFF_MQ = 4608;
constexpr int NMEM = 256, NEXP = 16384, KVW = 1024;
constexpr float EPS = 1e-6f;
constexpr int NWAVES = 8;
#ifndef MK_PHMASK
#define MK_PHMASK 0xfff
#endif
#define PHEN(k) (((MK_PHMASK) >> (k)) & 1)
#ifndef EPV_ROPE
#define EPV_ROPE 1
#endif
#ifndef PROBE_MASK
#define PROBE_MASK 0
#endif
#define PREP(k) ((((PROBE_MASK) >> (k)) & 1) + 1)
#ifndef U_FP4
#define U_FP4 1
#endif
#ifndef U_I4
#define U_I4 1
#endif
#ifndef GATHER_SPLIT
#define GATHER_SPLIT 1
#endif
#ifndef GATHER_BATCH
#define GATHER_BATCH 8
#endif
#ifndef V_FP4
#define V_FP4 1
#endif
#ifndef V_SLICED
#define V_SLICED 1
#endif
#ifndef V_SLICES
#define V_SLICES 8
#endif
#ifndef PROBE_VL2
#define PROBE_VL2 0
#endif
#ifndef V_I4
#define V_I4 1
#endif
#ifndef MK_ATT
#define MK_ATT 7
#endif
#ifndef MK_ONE_LAUNCH
#define MK_ONE_LAUNCH 1
#endif

constexpr size_t MiB = 1u << 20;
constexpr size_t WS_CTL = 0, CTL_ZERO_BYTES = 1 * MiB;
constexpr size_t WS_ROPE = 1 * MiB;
constexpr size_t WS_MEMN = 2 * MiB;
constexpr size_t WS_MEMKV = 4 * MiB;
constexpr size_t WS_KEYS = 8 * MiB;
constexpr size_t WS_IDS = 10 * MiB;
constexpr size_t WS_GATES = 14 * MiB;
constexpr size_t WS_WTIN = 32 * MiB;
constexpr size_t WS_WTOUT = 112 * MiB;
constexpr size_t WS_WTPQ = 144 * MiB;
constexpr size_t WS_WTKV = 176 * MiB;
constexpr size_t WS_XN = 192 * MiB;
constexpr size_t WS_PROJ = 224 * MiB;
constexpr size_t WS_OD = 304 * MiB;
constexpr size_t WS_MIX = 368 * MiB;
constexpr size_t WS_PQ = 400 * MiB;
constexpr size_t WS_SSP = 20 * MiB;
constexpr size_t WS_RS = 21 * MiB;
constexpr size_t WS_WEXP = 22 * MiB;
constexpr size_t WS_USC = 18 * MiB;
constexpr size_t WS_VSC = 19 * MiB;
constexpr int UROWB = U_FP4 ? 1024 : 1536;
constexpr int VROWB = V_FP4 ? 1024 : 1536;
constexpr int ROWB = 1536;
constexpr size_t WS_UTAB = 448 * MiB;
constexpr size_t WS_VTAB = 576 * MiB;
constexpr size_t WS_END = 704 * MiB;
constexpr int CW_BAR = 4096;

constexpr int RING_BYTES = 147456;
constexpr int LDSCTL_OFF = RING_BYTES, MISC_OFF = LDSCTL_OFF + 320;
constexpr int LDS_BYTES = 163840;
constexpr int EPI_P_OFF = RING_BYTES + 1024;

#define GAS __attribute__((address_space(1)))
#define LAS __attribute__((address_space(3)))
typedef unsigned short bf16;
typedef unsigned v4u __attribute__((ext_vector_type(4)));
typedef unsigned v2u __attribute__((ext_vector_type(2)));
typedef float f32x4 __attribute__((ext_vector_type(4)));
typedef float f32x16 __attribute__((ext_vector_type(16)));
typedef short bf16x8 __attribute__((ext_vector_type(8)));
#define LDS_WAIT() asm volatile("s_waitcnt lgkmcnt(0)" ::: "memory")

__device__ __forceinline__ unsigned f2bf(float f) { unsigned u = __builtin_bit_cast(unsigned, f); return (u + 0x7fffu + ((u >> 16) & 1u)) >> 16; }
__device__ __forceinline__ unsigned pk2(float lo, float hi) { return f2bf(lo) | (f2bf(hi) << 16); }
__device__ __forceinline__ float bflo(unsigned w) { return __builtin_bit_cast(float, w << 16); }
__device__ __forceinline__ float bfhi(unsigned w) { return __builtin_bit_cast(float, w & 0xffff0000u); }
__device__ __forceinline__ float shx_(float v, int o, int lane) { return __builtin_bit_cast(float, __builtin_amdgcn_ds_bpermute((lane ^ o) << 2, __builtin_bit_cast(int, v))); }
__device__ __forceinline__ int shx_(int v, int o, int lane) { return __builtin_amdgcn_ds_bpermute((lane ^ o) << 2, v); }
__device__ __forceinline__ float shi_(float v, int src) { return __builtin_bit_cast(float, __builtin_amdgcn_ds_bpermute(src << 2, __builtin_bit_cast(int, v))); }
#define SHX(v, o) shx_((v), (o), lane)
__device__ __forceinline__ float wave_sum(float v, int lane) {
#pragma unroll
    for (int o = 1; o < 64; o <<= 1) v += SHX(v, o);
    return v;
}

#define XB_TMO      128
#define XB_XCNT(j)  (256  + 64 * (j))
#define XB_XSUB(j)  (1280 + 64 * (j))
#define XB_XGEN(j)  (2304 + 64 * (j))
#define XB_TOP      3328
#define XB_TOPGEN   3392
#define XCD_BAR_WORDS 3456
#define XB_SPIN_CAP (1u << 18)
__device__ __forceinline__ unsigned xb_ld(unsigned* p)              { return __hip_atomic_load(p, __ATOMIC_RELAXED, __HIP_MEMORY_SCOPE_AGENT); }
__device__ __forceinline__ unsigned xb_add(unsigned* p, unsigned v) { return __hip_atomic_fetch_add(p, v, __ATOMIC_RELAXED, __HIP_MEMORY_SCOPE_AGENT); }
__device__ __forceinline__ unsigned xb_xcc_id() { return (unsigned)__builtin_amdgcn_s_getreg((3 << 11) | 20) & 0xFu; }
#define XB_SPIN(cond, bar) do { unsigned _sp = 0; while (cond) { __builtin_amdgcn_s_sleep(1); \
    if ((++_sp & 255u) == 0u) { if (xb_ld(&(bar)[XB_TMO])) break; if (_sp > XB_SPIN_CAP) { atomicAdd(&(bar)[XB_TMO], 1u); break; } } } } while (0)
struct XcdBarrier { unsigned* bar; unsigned x; volatile LAS unsigned* st; };
__device__ __forceinline__ XcdBarrier xcd_barrier_post(unsigned* bar, volatile LAS unsigned* st, bool t0) {
    XcdBarrier b; b.bar = bar; b.x = xb_xcc_id(); b.st = st;
    if (t0) (void)xb_add(&bar[XB_XCNT(b.x)], 1u);
    return b;
}
__device__ __forceinline__ void xcd_barrier_complete(unsigned* bar, unsigned x, unsigned& nloc, unsigned& nx) {
    const unsigned G = gridDim.x * gridDim.y * gridDim.z;
    unsigned sum, cnt, mine, sp = 0u;
    for (;;) {
        sum = 0u; cnt = 0u; mine = 0u;
#pragma unroll 1
        for (unsigned j = 0; j < 16; ++j) { const unsigned c = xb_ld(&bar[XB_XCNT(j)]); sum += c; cnt += (c > 0u) ? 1u : 0u; mine = (j == x) ? c : mine; }
        if (sum == G) break;
        __builtin_amdgcn_s_sleep(1);
        if ((++sp & 255u) == 0u) { if (xb_ld(&bar[XB_TMO])) break; if (sp > XB_SPIN_CAP) { atomicAdd(&bar[XB_TMO], 1u); break; } }
    }
    nloc = mine > 0u ? mine : 1u; nx = cnt > 0u ? cnt : 1u;
}
__device__ __forceinline__ void xcd_barrier(const XcdBarrier& b, bool t0) {
    asm volatile("s_waitcnt vmcnt(0)" ::: "memory");
    __syncthreads();
    if (t0) {
        unsigned* bar = b.bar;
        __builtin_amdgcn_s_waitcnt(0);
        unsigned nloc = b.st[0], nx = b.st[1];
        if (nloc == 0u) { xcd_barrier_complete(bar, b.x, nloc, nx); b.st[0] = nloc; b.st[1] = nx; }
        const unsigned old = xb_add(&bar[XB_XSUB(b.x)], 1u);
        const unsigned gen = old / nloc;
        if (old + 1u == (gen + 1u) * nloc) {
            __builtin_amdgcn_fence(__ATOMIC_RELEASE, "agent");
            asm volatile("s_waitcnt vmcnt(0)" ::: "memory");
            const unsigned og = xb_add(&bar[XB_TOP], 1u);
            const unsigned tg = og / nx;
            if (og + 1u == (tg + 1u) * nx) xb_add(&bar[XB_TOPGEN], 1u);
            else XB_SPIN(xb_ld(&bar[XB_TOPGEN]) == tg, bar);
            __builtin_amdgcn_fence(__ATOMIC_ACQUIRE, "agent");
            xb_add(&bar[XB_XGEN(b.x)], 1u);
            asm volatile("s_waitcnt vmcnt(0)" ::: "memory");
        } else {
            XB_SPIN(xb_ld(&bar[XB_XGEN(b.x)]) == gen, bar);
            __builtin_amdgcn_fence(__ATOMIC_ACQUIRE, "agent");
            asm volatile("s_waitcnt vmcnt(0)" ::: "memory");
        }
    }
    __syncthreads();
}

__device__ __forceinline__ void transpose_item(const float* W, const float* gain, int K, int N, bf16* WT, LAS float* scr, int item, int lane) {
    const int nblk = N / 32, kb = item / nblk, nb = item % nblk, k0 = 64 * kb, n0 = 32 * nb;
    f32x4 v[8];
#pragma unroll
    for (int i = 0; i < 8; ++i) v[i] = *(const f32x4*)(W + (size_t)(k0 + 8 * i + (lane >> 3)) * N + n0 + 4 * (lane & 7));
    if (gain) {
#pragma unroll
        for (int i = 0; i < 8; ++i) v[i] *= gain[k0 + 8 * i + (lane >> 3)];
    }
#pragma unroll
    for (int i = 0; i < 8; ++i) { LAS float* d_ = scr + (8 * i + (lane >> 3)) * 33 + 4 * (lane & 7); d_[0] = v[i].x; d_[1] = v[i].y; d_[2] = v[i].z; d_[3] = v[i].w; }
    LDS_WAIT(); asm volatile("" ::: "memory");
    const int c = lane & 7;
#pragma unroll
    for (int j = 0; j < 4; ++j) { const int n = (lane >> 3) + 8 * j; const LAS float* s = scr + (8 * c) * 33 + n;
        v4u o; o.x = pk2(s[0 * 33], s[1 * 33]); o.y = pk2(s[2 * 33], s[3 * 33]); o.z = pk2(s[4 * 33], s[5 * 33]); o.w = pk2(s[6 * 33], s[7 * 33]);
        *(v4u*)(WT + (size_t)(n0 + n) * K + k0 + 8 * c) = o; }
    LDS_WAIT(); asm volatile("" ::: "memory");
}
__device__ __forceinline__ void rms_row_to_bf16(const float* xrow, bf16* orow, int lane) {
    const f32x4* xr = (const f32x4*)xrow + lane;
    f32x4 v[8]; float s = 0.f;
#pragma unroll
    for (int j = 0; j < 8; ++j) { v[j] = xr[64 * j]; s += (v[j].x * v[j].x + v[j].y * v[j].y) + (v[j].z * v[j].z + v[j].w * v[j].w); }
    const float r = 1.0f / sqrtf(wave_sum(s, lane) * (1.f / 2048.f) + EPS);
    v2u* o8 = (v2u*)orow + lane;
#pragma unroll
    for (int j = 0; j < 8; ++j) { v2u w; w.x = pk2(v[j].x * r, v[j].y * r); w.y = pk2(v[j].z * r, v[j].w * r); o8[64 * j] = w; }
}
__device__ __forceinline__ void row_to_bf16_rs(const float* xrow, bf16* orow, float* rs_out, int lane) {
    const f32x4* xr = (const f32x4*)xrow + lane;
    f32x4 v[8]; float s = 0.f;
#pragma unroll
    for (int j = 0; j < 8; ++j) { v[j] = xr[64 * j]; s += (v[j].x * v[j].x + v[j].y * v[j].y) + (v[j].z * v[j].z + v[j].w * v[j].w); }
    const float st = wave_sum(s, lane);
    if (lane < 8) rs_out[lane] = lane == 0 ? st : 0.f;
    v2u* o8 = (v2u*)orow + lane;
#pragma unroll
    for (int j = 0; j < 8; ++j) { v2u w; w.x = pk2(v[j].x, v[j].y); w.y = pk2(v[j].z, v[j].w); o8[64 * j] = w; }
}
__device__ __forceinline__ void slot_norm(bf16* p, const float* g, bool rope, const float* cs, const float* sn, int sub  , int lane) {
    v4u w = *(v4u*)(p + sub * 8);
    float x[8] = {bflo(w.x), bfhi(w.x), bflo(w.y), bfhi(w.y), bflo(w.z), bfhi(w.z), bflo(w.w), bfhi(w.w)};
    float s = 0.f;
#pragma unroll
    for (int j = 0; j < 8; ++j) s += x[j] * x[j];
    s += SHX(s, 1); s += SHX(s, 2); s += SHX(s, 4); s += SHX(s, 8);
    const float r = 1.0f / sqrtf(s * (1.f / 128.f) + EPS);
    const f32x4 g0 = *(const f32x4*)(g + sub * 8), g1 = *(const f32x4*)(g + sub * 8 + 4);
    x[0] *= r * g0.x; x[1] *= r * g0.y; x[2] *= r * g0.z; x[3] *= r * g0.w; x[4] *= r * g1.x; x[5] *= r * g1.y; x[6] *= r * g1.z; x[7] *= r * g1.w;
    float y[8];
#pragma unroll
    for (int j = 0; j < 8; ++j) y[j] = SHX(x[j], 2);
    if (rope && sub < 4) {
        const int i0 = (sub & 1) * 8;
#pragma unroll
        for (int j = 0; j < 8; ++j) { const float c = cs[i0 + j], sn_ = sn[i0 + j]; x[j] = (sub < 2) ? (x[j] * c - y[j] * sn_) : (x[j] * c + y[j] * sn_); }
    }
    v4u o; o.x = pk2(x[0], x[1]); o.y = pk2(x[2], x[3]); o.z = pk2(x[4], x[5]); o.w = pk2(x[6], x[7]);
    *(v4u*)(p + sub * 8) = o;
}

struct EpiResF32 {
    static constexpr bool PERM = false, AFTER_DRAIN = false;
    bf16* XB; float* SSP; int ldc;
    __device__ __forceinline__ void operator()(const pg8::f32x4 (&acc)[2][2][4][2], const pg8::Unit& u, int wr, int wc, int fr_in, int fq_in) const {
        int fr = fr_in, fq = fq_in; asm volatile("" : "+v"(fr), "+v"(fq));
        const int lane = fq * 16 + fr;
        const int row0 = u.pm * pg8::BM + wr * 64 + fr, col0 = u.pn * pg8::BM + wc * 32 + 4 * fq;
#pragma unroll
        for (int ai = 0; ai < 2; ++ai)
#pragma unroll
            for (int m = 0; m < 4; ++m) { const int row = row0 + ai * pg8::HALF + m * 16; const size_t off = (size_t)row * ldc + col0; float ss = 0.f;
#pragma unroll
                for (int bj = 0; bj < 2; ++bj)
#pragma unroll
                    for (int n = 0; n < 2; ++n) { const v2u bw = *(const v2u*)(XB + off + bj * pg8::HALF + n * 16); const pg8::f32x4 a = acc[ai][bj][m][n];
                        const float v0 = bflo(bw.x) + a[0], v1 = bfhi(bw.x) + a[1], v2 = bflo(bw.y) + a[2], v3 = bfhi(bw.y) + a[3];
                        ss += (v0 * v0 + v1 * v1) + (v2 * v2 + v3 * v3);
                        v2u w; w.x = pk2(v0, v1); w.y = pk2(v2, v3); *(v2u*)(XB + off + bj * pg8::HALF + n * 16) = w; }
                ss += SHX(ss, 16); ss += SHX(ss, 32);
                if (fq == 0) SSP[(size_t)row * 32 + u.pn * 4 + wc] = ss;
                asm volatile("" ::: "memory"); }
    }
};
template <bool MEM> struct EpiProjT {
    static constexpr bool PERM = false, AFTER_DRAIN = false;
    bf16* O; const float* gq; const float* ropec; const float* ropes; LAS float* P; int pn0;
    const float* rs;
    __device__ __forceinline__ void operator()(const pg8::f32x4 (&acc)[2][2][4][2], const pg8::Unit& u, int wr, int wc, int fr_in, int fq_in) const {
        constexpr int LDO_ = MEM ? DEPTH * KVW : INW;
        int fr = fr_in, fq = fq_in; asm volatile("" : "+v"(fr), "+v"(fq));
        const int lane = fq * 16 + fr;
        const int pn = u.pn + pn0; const int row0 = u.pm * pg8::BM + wr * 64 + fr, col0 = pn * pg8::BM + wc * 32 + 4 * fq;
        int gi = -1;
        if (MEM) { gi = ((pn & 3) < 2) ? (pn >> 2) * 6 + 5 : -1; }
        else { if (pn < 4) gi = 0; else if (pn < 8) gi = 1; else if (pn < 12) gi = -1; else if (pn < 14) gi = 2; else if (pn < 16) gi = 3; else if (pn < 18) gi = -1; else gi = 4; }
        const bool rope = !MEM && pn < 8;
        if (gi < 0) {
#pragma unroll
            for (int ai = 0; ai < 2; ++ai)
#pragma unroll
                for (int m = 0; m < 4; ++m) { const int row_ = row0 + ai * pg8::HALF + m * 16; bf16* rowp = O + (size_t)row_ * LDO_ + col0; float rsc = 1.0f; if (rs) { const f32x4 pa_ = *(const f32x4*)(rs + (size_t)row_ * 8), pb_ = *(const f32x4*)(rs + (size_t)row_ * 8 + 4); rsc = 1.0f / sqrtf((((pa_.x + pa_.y) + (pa_.z + pa_.w)) + ((pb_.x + pb_.y) + (pb_.z + pb_.w))) * (1.f / 2048.f) + EPS); }
#pragma unroll
                    for (int bj = 0; bj < 2; ++bj)
#pragma unroll
                        for (int n = 0; n < 2; ++n) { const pg8::f32x4 v = acc[ai][bj][m][n] * rsc; v2u w; w.x = pk2(v[0], v[1]); w.y = pk2(v[2], v[3]); *(v2u*)(rowp + bj * pg8::HALF + n * 16) = w; } }
            return;
        }
#pragma unroll
        for (int ai = 0; ai < 2; ++ai)
#pragma unroll
            for (int m = 0; m < 4; ++m)
#pragma unroll
                for (int bj = 0; bj < 2; ++bj) { float ss = 0.f;
#pragma unroll
                    for (int n = 0; n < 2; ++n) { const pg8::f32x4 v = acc[ai][bj][m][n]; ss += (v[0] * v[0] + v[1] * v[1]) + (v[2] * v[2] + v[3] * v[3]); }
                    ss += SHX(ss, 16); ss += SHX(ss, 32);
                    if (fq == 0) P[((ai * pg8::HALF + wr * 64 + m * 16 + fr) * 2 + bj) * 4 + wc] = ss; __builtin_amdgcn_sched_barrier(0); }
        asm volatile("s_waitcnt lgkmcnt(0)" ::: "memory"); __builtin_amdgcn_s_barrier(); asm volatile("" ::: "memory");
        const f32x4 g0 = *(const f32x4*)(gq + gi * 128 + wc * 32 + 4 * fq), g1 = *(const f32x4*)(gq + gi * 128 + wc * 32 + 16 + 4 * fq);
#pragma unroll
        for (int ai = 0; ai < 2; ++ai)
#pragma unroll
            for (int m = 0; m < 4; ++m) { const int rl = ai * pg8::HALF + wr * 64 + m * 16 + fr, row = u.pm * pg8::BM + rl; bf16* rowp = O + (size_t)row * LDO_ + col0;
                f32x4 cs = (f32x4){1.f, 1.f, 1.f, 1.f}, sn = (f32x4){0.f, 0.f, 0.f, 0.f};
                if (EPV_ROPE && rope && wc == 0) { const int pos = row & (SEQ - 1); cs = *(const f32x4*)(ropec + pos * 16 + 4 * fq); sn = *(const f32x4*)(ropes + pos * 16 + 4 * fq); }
#pragma unroll
                for (int bj = 0; bj < 2; ++bj) { const f32x4 t = *(const LAS f32x4*)(P + (rl * 2 + bj) * 4); const float r = 1.0f / sqrtf(((t.x + t.y) + (t.z + t.w)) * (1.f / 128.f) + EPS);
                    f32x4 y0 = acc[ai][bj][m][0] * r * g0, y1 = acc[ai][bj][m][1] * r * g1;
                    if (EPV_ROPE && rope && wc == 0) { const f32x4 a = y0 * cs - y1 * sn, b = y1 * cs + y0 * sn; y0 = a; y1 = b; }
                    v2u w0, w1; w0.x = pk2(y0[0], y0[1]); w0.y = pk2(y0[2], y0[3]); w1.x = pk2(y1[0], y1[1]); w1.y = pk2(y1[2], y1[3]);
                    *(v2u*)(rowp + bj * pg8::HALF) = w0; *(v2u*)(rowp + bj * pg8::HALF + 16) = w1; }
                asm volatile("" ::: "memory"); __builtin_amdgcn_sched_barrier(0); }
    }
};

typedef EpiProjT<false> EpiProj;

template <bool KLDS> __device__ __forceinline__ void select_task(const bf16* PQ, const float* SSP, const bf16* KEYS_l, int* IDS, float* GATES, int tile, int hp, LAS int* lscr, int lane, const char* klds = nullptr) {
    const int r32 = lane & 31, hi = lane >> 5; const int t = tile * 32 + r32;
    float rs;
    { float tot = 0.f;
#pragma unroll
      for (int j = 0; j < 8; ++j) { const f32x4 v = *(const f32x4*)(SSP + (size_t)t * 32 + j * 4); tot += (v.x + v.y) + (v.z + v.w); }
      rs = 1.0f / sqrtf(tot * (1.f / 2048.f) + EPS); }
    int ab[2][16];
#pragma unroll
    for (int c = 0; c < 2; ++c) {
        const int g = hp * 2 + c;
        bf16x8 qr[8];
#pragma unroll
        for (int ks = 0; ks < 8; ++ks) qr[ks] = *(const bf16x8*)(PQ + (size_t)t * 2048 + g * 128 + ks * 16 + hi * 8);
        const bf16* kb = KEYS_l + (size_t)g * 128 * 128;
        f32x16 p[4];
        if constexpr (KLDS) {
            att::qkt(p[0], p[1], (const att::bf16*)(klds + (2 * c) * 16384), qr, r32, hi);
            att::qkt(p[2], p[3], (const att::bf16*)(klds + (2 * c + 1) * 16384), qr, r32, hi);
        } else {
#pragma unroll
        for (int q = 0; q < 4; ++q) { p[q] = f32x16{};
#pragma unroll
            for (int ks = 0; ks < 8; ++ks) { const bf16x8 af = *(const bf16x8*)(kb + (size_t)(q * 32 + r32) * 128 + ks * 16 + hi * 8); p[q] = __builtin_amdgcn_mfma_f32_32x32x16_bf16(af, qr[ks], p[q], 0, 0, 0); } }
        }
        int g0[16], g1[16], g2[16], g3[16];
#pragma unroll
        for (int r = 0; r < 16; ++r) { const int idx = (r & 3) + 8 * (r >> 2) + 4 * hi;
            g0[r] = (sel::f2key(p[0][r] * rs) & ~127) | idx; g1[r] = (sel::f2key(p[1][r] * rs) & ~127) | (32 + idx);
            g2[r] = (sel::f2key(p[2][r] * rs) & ~127) | (64 + idx); g3[r] = (sel::f2key(p[3][r] * rs) & ~127) | (96 + idx); }
        sel::sort_desc(g0); sel::sort_desc(g1); sel::sort_desc(g2); sel::sort_desc(g3);
        sel::top16_merge(g0, g1); sel::top16_merge(g2, g3); sel::top16_merge(g0, g2);
        int pb[16];
#pragma unroll
        for (int i = 0; i < 16; ++i) pb[i] = SHX(g0[i], 32);
        sel::top16_merge(g0, pb);
#pragma unroll
        for (int i = 0; i < 16; ++i) ab[c][i] = g0[i];
    }
    int cc[16];
    sel::cand_top16(ab[0], ab[1], cc);
#pragma unroll
    for (int i = 0; i < 16; ++i) { lscr[i * 64 + lane] = ab[0][i] & 127; lscr[(16 + i) * 64 + lane] = ab[1][i] & 127; }
    LDS_WAIT();
    float val[16], e[16]; int eid[16];
#pragma unroll
    for (int k = 0; k < 16; ++k) { const int code = cc[k] & 255; const int i = code >> 4, j = code & 15; val[k] = sel::key2f(cc[k] & ~255);
        eid[k] = lscr[i * 64 + lane] * 128 + lscr[(16 + j) * 64 + lane]; }
    float sum = 0.f;
#pragma unroll
    for (int k = 0; k < 16; ++k) { e[k] = __expf(val[k] - val[0]); sum += e[k]; }
    const float inv = 1.0f / sum;
    int* ip = IDS + (size_t)t * 128 + hp * 16 + hi * 8; float* gp = GATES + (size_t)t * 128 + hp * 16 + hi * 8;
    v4u i0, i1; f32x4 q0, q1;
    i0.x = hi ? eid[8] : eid[0]; i0.y = hi ? eid[9] : eid[1]; i0.z = hi ? eid[10] : eid[2]; i0.w = hi ? eid[11] : eid[3];
    i1.x = hi ? eid[12] : eid[4]; i1.y = hi ? eid[13] : eid[5]; i1.z = hi ? eid[14] : eid[6]; i1.w = hi ? eid[15] : eid[7];
    q0.x = (hi ? e[8] : e[0]) * inv; q0.y = (hi ? e[9] : e[1]) * inv; q0.z = (hi ? e[10] : e[2]) * inv; q0.w = (hi ? e[11] : e[3]) * inv;
    q1.x = (hi ? e[12] : e[4]) * inv; q1.y = (hi ? e[13] : e[5]) * inv; q1.z = (hi ? e[14] : e[6]) * inv; q1.w = (hi ? e[15] : e[7]) * inv;
    *(v4u*)ip = i0; *(v4u*)(ip + 4) = i1; *(f32x4*)gp = q0; *(f32x4*)(gp + 4) = q1;
    LDS_WAIT();
}

typedef float f32x2 __attribute__((ext_vector_type(2)));
typedef float v16f __attribute__((ext_vector_type(16)));
typedef float v32f __attribute__((ext_vector_type(32)));
typedef unsigned v6u __attribute__((ext_vector_type(6)));
__device__ __forceinline__ int fp6_order_probe() {
    v16f a, b;
#pragma unroll
    for (int j = 0; j < 16; ++j) { a[j] = 0.25f * (float)(j + 1); b[j] = -0.25f * (float)(j + 1); }
    asm volatile("" : "+v"(a), "+v"(b));
    const v6u w = __builtin_amdgcn_cvt_scalef32_2xpk16_fp6_f32(a, b, 1.0f);
    const v32f d = __builtin_amdgcn_cvt_scalef32_pk32_f32_fp6(w, 1.0f);
    bool okA = true, okB = true;
#pragma unroll
    for (int j = 0; j < 16; ++j) { okA = okA && (d[j] == a[j]) && (d[16 + j] == b[j]); okB = okB && (d[2 * j] == a[j]) && (d[2 * j + 1] == b[j]); }
    return okA ? 0 : (okB ? 1 : -1);
}
__device__ __forceinline__ void row_fp6_load(const float* src, f32x4 (&v)[8], int lane) {
    const f32x4* xr = (const f32x4*)src + lane;
#pragma unroll
    for (int j = 0; j < 8; ++j) v[j] = __builtin_nontemporal_load(xr + 64 * j);
}
__device__ __forceinline__ void row_fp6_finish(const f32x4 (&v)[8], unsigned char* dst  , float* scale_out, int order, int lane) {
    float am = 0.f;
#pragma unroll
    for (int j = 0; j < 8; ++j) am = fmaxf(am, fmaxf(fmaxf(fabsf(v[j].x), fabsf(v[j].y)), fmaxf(fabsf(v[j].z), fabsf(v[j].w))));
#pragma unroll
    for (int o = 1; o < 64; o <<= 1) am = fmaxf(am, SHX(am, o));
    float q = am > 0.f ? 7.5f / am : 0.f;
    if (order < 0) q = __builtin_nanf("");
    if (lane == 0) *scale_out = am * (1.0f / 7.5f);
    float c[32];
#pragma unroll
    for (int j = 0; j < 8; ++j) { c[4 * j] = v[j].x * q; c[4 * j + 1] = v[j].y * q; c[4 * j + 2] = v[j].z * q; c[4 * j + 3] = v[j].w * q; }
    v16f a, b;
#pragma unroll
    for (int i = 0; i < 16; ++i) { a[i] = (order == 1) ? c[2 * i] : c[i]; b[i] = (order == 1) ? c[2 * i + 1] : c[16 + i]; }
    const v6u w = __builtin_amdgcn_cvt_scalef32_2xpk16_fp6_f32(a, b, 1.0f);
    *(v4u*)(dst + lane * 16) = (v4u){w[0], w[1], w[2], w[3]};
    *(v2u*)(dst + 1024 + lane * 8) = (v2u){w[4], w[5]};
}
__device__ __forceinline__ int fp4_order_probe() {
    float a = 1.0f, b = 2.0f; asm volatile("" : "+v"(a), "+v"(b));
    const unsigned w = __builtin_amdgcn_cvt_scalef32_pk_fp4_f32(0u, a, b, 1.0f, 2);
    const f32x2 d = __builtin_amdgcn_cvt_scalef32_pk_f32_fp4(w, 1.0f, 2);
    return (d.x == 1.0f && d.y == 2.0f) ? 0 : ((d.x == 2.0f && d.y == 1.0f) ? 1 : -1);
}
__device__ __forceinline__ void row_fp4_finish(const f32x4 (&v)[8], unsigned char* dst  , float* scale_out, int order, int lane) {
    float am = 0.f;
#pragma unroll
    for (int j = 0; j < 8; ++j) am = fmaxf(am, fmaxf(fmaxf(fabsf(v[j].x), fabsf(v[j].y)), fmaxf(fabsf(v[j].z), fabsf(v[j].w))));
#pragma unroll
    for (int o = 1; o < 64; o <<= 1) am = fmaxf(am, SHX(am, o));
    float q = am > 0.f ? 6.0f / am : 0.f;
    if (order < 0) q = __builtin_nanf("");
    if (lane == 0) *scale_out = am * (1.0f / 6.0f);
    unsigned w[4];
#pragma unroll
    for (int d = 0; d < 4; ++d) { unsigned t = 0u;
        const float e0 = v[2 * d].x * q, e1 = v[2 * d].y * q, e2 = v[2 * d].z * q, e3 = v[2 * d].w * q, e4 = v[2 * d + 1].x * q, e5 = v[2 * d + 1].y * q, e6 = v[2 * d + 1].z * q, e7 = v[2 * d + 1].w * q;
        t = __builtin_amdgcn_cvt_scalef32_pk_fp4_f32(t, order ? e1 : e0, order ? e0 : e1, 1.0f, 0);
        t = __builtin_amdgcn_cvt_scalef32_pk_fp4_f32(t, order ? e3 : e2, order ? e2 : e3, 1.0f, 1);
        t = __builtin_amdgcn_cvt_scalef32_pk_fp4_f32(t, order ? e5 : e4, order ? e4 : e5, 1.0f, 2);
        t = __builtin_amdgcn_cvt_scalef32_pk_fp4_f32(t, order ? e7 : e6, order ? e6 : e7, 1.0f, 3);
        w[d] = t; }
    *(v4u*)(dst + lane * 16) = (v4u){w[0], w[1], w[2], w[3]};
}
__device__ __forceinline__ void row_i4_finish(const f32x4 (&v)[8], unsigned char* dst  , float* scale_out, int lane, bool sliced = false) {
    float ss = 0.f;
#pragma unroll
    for (int j = 0; j < 8; ++j) ss += (v[j].x * v[j].x + v[j].y * v[j].y) + (v[j].z * v[j].z + v[j].w * v[j].w);
    const float sig = sqrtf(wave_sum(ss, lane) * (1.f / 2048.f));
    const float q = sig > 0.f ? 7.0f / (2.5f * sig) : 0.f;
    if (lane == 0) *scale_out = sig * (2.5f / 7.0f);
    unsigned w[4];
    const float MAGIC = 12582912.0f;
#pragma unroll
    for (int d = 0; d < 4; ++d) {
        const float e[8] = {v[2 * d].x, v[2 * d].y, v[2 * d].z, v[2 * d].w, v[2 * d + 1].x, v[2 * d + 1].y, v[2 * d + 1].z, v[2 * d + 1].w};
        unsigned b[8];
#pragma unroll
        for (int n = 0; n < 8; ++n) b[n] = __builtin_bit_cast(unsigned, __builtin_amdgcn_fmed3f(__builtin_fmaf(e[n], q, MAGIC), MAGIC - 8.0f, MAGIC + 7.0f));
        const unsigned p02 = __builtin_amdgcn_perm(b[2], b[0], 0x0c0c0400u), p46 = __builtin_amdgcn_perm(b[6], b[4], 0x0c0c0400u), p13 = __builtin_amdgcn_perm(b[3], b[1], 0x0c0c0400u), p57 = __builtin_amdgcn_perm(b[7], b[5], 0x0c0c0400u);
        const unsigned E = (p46 << 16) | p02, O = (p57 << 16) | p13;
        w[d] = (E & 0x0F0F0F0Fu) | ((O << 4) & 0xF0F0F0F0u); }
    *(v4u*)(dst + (sliced ? (size_t)(lane / (64 / V_SLICES)) * ((size_t)NEXP * (1024 / V_SLICES)) + (lane & (64 / V_SLICES - 1)) * 16 : (size_t)lane * 16)) = (v4u){w[0], w[1], w[2], w[3]};
}
__device__ __forceinline__ void gather_token(const bf16* xin  , float* xrow  , const float* fg  , const int* ids, const float* gates,
                                             const unsigned char* UT, const unsigned char* VT, const float* USC, const float* VSC, bf16* xn_out  , float* rs_out  , int lane,
                                             const float* cv_src = nullptr  , size_t cv_vofs = 0, unsigned char* cv_du = nullptr, unsigned char* cv_dv = nullptr, float* cv_su = nullptr, float* cv_sv = nullptr, int cv_r0 = 0, int f4ord = 0, int f6ord = 0, LAS unsigned char* cv_lds = nullptr  ) {
    f32x2 h[16], acc[16]; float ss = 0.f;
#pragma unroll
    for (int j = 0; j < 8; ++j) { const v2u bw = *(const v2u*)(xin + j * 256 + lane * 4); const f32x4 a = (f32x4){bflo(bw.x), bfhi(bw.x), bflo(bw.y), bfhi(bw.y)};
        h[2 * j] = (f32x2){a.x, a.y}; h[2 * j + 1] = (f32x2){a.z, a.w}; acc[2 * j] = h[2 * j]; acc[2 * j + 1] = h[2 * j + 1];
        ss += (a.x * a.x + a.y * a.y) + (a.z * a.z + a.w * a.w); }
    const float r = 1.0f / sqrtf(wave_sum(ss, lane) * (1.f / 2048.f) + EPS);
#pragma unroll
    for (int j = 0; j < 8; ++j) { const f32x4 a = *(const f32x4*)(fg + j * 256 + lane * 4);
        h[2 * j] *= (f32x2){a.x * r, a.y * r}; h[2 * j + 1] *= (f32x2){a.z * r, a.w * r}; }
    typedef _Float16 h2_t __attribute__((ext_vector_type(2)));
    h2_t h16[16];
#pragma unroll
    for (int j = 0; j < 16; ++j) { h16[j].x = (_Float16)h[j].x; h16[j].y = (_Float16)h[j].y; }
    const int id_lo = ids[lane], id_hi = ids[64 + lane];
    const float ua_lo = USC[id_lo], ua_hi = USC[id_hi];
    const float gb_lo = gates[lane] * VSC[id_lo], gb_hi = gates[64 + lane] * VSC[id_hi];
    constexpr int GB = GATHER_BATCH;
#define CV_SRC(r) ((r) >= NEXP ? cv_src + cv_vofs + (size_t)((r) - NEXP) * DM : cv_src + (size_t)(r) * DM)
#define CV_LOAD(r) do { const float* sp_ = CV_SRC(r); _Pragma("unroll") for (int j_ = 0; j_ < 8; ++j_) __builtin_amdgcn_global_load_lds((const unsigned*)(sp_ + j_ * 256 + lane * 4), (LAS unsigned*)(cv_lds + j_ * 1024), 16, 0, 2); } while (0)
#define CV_FIN(r) do { asm volatile("s_waitcnt vmcnt(0)" ::: "memory"); f32x4 cvr[8]; _Pragma("unroll") for (int j_ = 0; j_ < 8; ++j_) cvr[j_] = *(const LAS f32x4*)(cv_lds + j_ * 1024 + lane * 16); \
        const bool isv_ = (r) >= NEXP; const int rr_ = isv_ ? (r) - NEXP : (r); \
        if ((isv_ && V_FP4) || (!isv_ && U_FP4)) row_fp4_finish(cvr, (isv_ ? cv_dv + (size_t)rr_ * VROWB : cv_du + (size_t)rr_ * UROWB), (isv_ ? cv_sv : cv_su) + rr_, f4ord, lane); \
        else row_fp6_finish(cvr, (isv_ ? cv_dv + (size_t)rr_ * VROWB : cv_du + (size_t)rr_ * UROWB), (isv_ ? cv_sv : cv_su) + rr_, f6ord, lane); asm volatile("s_waitcnt lgkmcnt(0)" ::: "memory"); } while (0)
    if (cv_src) CV_LOAD(cv_r0);
    for (int kk = 0; kk < 128; kk += GB) {
        if (cv_src && kk > 0 && (kk & 31) == 0) { const int rdone = cv_r0 + (kk >> 5) - 1; CV_FIN(rdone); CV_LOAD(rdone + 1); }
        v4u ua[GB], va[GB]; v2u ub[GB], vb[GB];
#pragma unroll
        for (int e = 0; e < GB; ++e) { const int k = kk + e;
            const int id = __builtin_amdgcn_readlane(kk < 64 ? id_lo : id_hi, k & 63);
            const unsigned char* ur = UT + (size_t)id * UROWB; const unsigned char* vr = VT + (size_t)id * VROWB;
            ua[e] = *(const v4u*)(ur + lane * 16); if (!U_FP4) ub[e] = *(const v2u*)(ur + 1024 + lane * 8); va[e] = *(const v4u*)(vr + lane * 16); if (!V_FP4) vb[e] = *(const v2u*)(vr + 1024 + lane * 8); }
        float d[GB];
#pragma unroll
        for (int e = 0; e < GB; ++e) { f32x2 dd = (f32x2){0.f, 0.f};
            if (U_FP4) {
                const unsigned uw[4] = {ua[e].x, ua[e].y, ua[e].z, ua[e].w}; float da = 0.f;
#pragma unroll
                for (int dq = 0; dq < 4; ++dq) { da = __builtin_amdgcn_fdot2(h16[4 * dq], __builtin_amdgcn_cvt_scalef32_pk_f16_fp4(uw[dq], 1.0f, 0), da, false); da = __builtin_amdgcn_fdot2(h16[4 * dq + 1], __builtin_amdgcn_cvt_scalef32_pk_f16_fp4(uw[dq], 1.0f, 1), da, false);
                    da = __builtin_amdgcn_fdot2(h16[4 * dq + 2], __builtin_amdgcn_cvt_scalef32_pk_f16_fp4(uw[dq], 1.0f, 2), da, false); da = __builtin_amdgcn_fdot2(h16[4 * dq + 3], __builtin_amdgcn_cvt_scalef32_pk_f16_fp4(uw[dq], 1.0f, 3), da, false); }
                dd.x = da;
            } else {
                const v32f u = __builtin_amdgcn_cvt_scalef32_pk32_f32_fp6((v6u){ua[e].x, ua[e].y, ua[e].z, ua[e].w, ub[e].x, ub[e].y}, 1.0f);
#pragma unroll
                for (int j = 0; j < 16; ++j) dd += h[j] * (f32x2){u[2 * j], u[2 * j + 1]};
            }
            d[e] = dd.x + dd.y; __builtin_amdgcn_sched_barrier(0); }
#pragma unroll
        for (int step = 1, n = GB; n > 1; step <<= 1, n >>= 1) {
            const bool bb = (lane & step) != 0;
#pragma unroll
            for (int i = 0; i < n / 2; ++i) { const float keep = bb ? d[2 * i + 1] : d[2 * i], send = bb ? d[2 * i] : d[2 * i + 1]; d[i] = keep + SHX(send, step); }
        }
        float s = d[0];
#pragma unroll
        for (int step = GB; step < 64; step <<= 1) s += SHX(s, step);
        const int src = (kk & 63) + (lane & (GB - 1));
        const float a = s * shi_(kk < 64 ? ua_lo : ua_hi, src);
        const float wv = shi_(kk < 64 ? gb_lo : gb_hi, src) * 0.5f * a * (1.0f + erff(a * 0.70710678118654752f));
#pragma unroll
        for (int e = 0; e < GB; ++e) { const float we = __builtin_bit_cast(float, __builtin_amdgcn_readlane(__builtin_bit_cast(int, wv), e)); const f32x2 w2 = (f32x2){we, we};
            if (V_FP4) {
                const unsigned vw[4] = {va[e].x, va[e].y, va[e].z, va[e].w};
#pragma unroll
                for (int dq = 0; dq < 4; ++dq) { acc[4 * dq] += w2 * __builtin_amdgcn_cvt_scalef32_pk_f32_fp4(vw[dq], 1.0f, 0); acc[4 * dq + 1] += w2 * __builtin_amdgcn_cvt_scalef32_pk_f32_fp4(vw[dq], 1.0f, 1);
                    acc[4 * dq + 2] += w2 * __builtin_amdgcn_cvt_scalef32_pk_f32_fp4(vw[dq], 1.0f, 2); acc[4 * dq + 3] += w2 * __builtin_amdgcn_cvt_scalef32_pk_f32_fp4(vw[dq], 1.0f, 3); }
            } else {
                const v32f vv = __builtin_amdgcn_cvt_scalef32_pk32_f32_fp6((v6u){va[e].x, va[e].y, va[e].z, va[e].w, vb[e].x, vb[e].y}, 1.0f);
#pragma unroll
                for (int j = 0; j < 16; ++j) acc[j] += w2 * (f32x2){vv[2 * j], vv[2 * j + 1]};
            }
            __builtin_amdgcn_sched_barrier(0); }
    }
    if (cv_src) { CV_FIN(cv_r0 + 3); }
#undef CV_SRC
#undef CV_FIN
#undef CV_LOAD
    int ln2 = lane; asm volatile("" : "+v"(ln2));
    if (xrow) {
#pragma unroll
        for (int j = 0; j < 8; ++j) *(f32x4*)(xrow + j * 256 + ln2 * 4) = (f32x4){acc[2 * j].x, acc[2 * j].y, acc[2 * j + 1].x, acc[2 * j + 1].y};
    }
    if (xn_out) {
        float s2 = 0.f;
#pragma unroll
        for (int j = 0; j < 16; ++j) s2 += acc[j].x * acc[j].x + acc[j].y * acc[j].y;
        const float r2 = 1.0f / sqrtf(wave_sum(s2, lane) * (1.f / 2048.f) + EPS);
        if (ln2 == 0) *rs_out = r2;
#pragma unroll
        for (int j = 0; j < 8; ++j) { v2u w0; w0.x = pk2(acc[2 * j].x, acc[2 * j].y); w0.y = pk2(acc[2 * j + 1].x, acc[2 * j + 1].y);
            *(v2u*)(xn_out + j * 256 + ln2 * 4) = w0; }
    }
}

__device__ __forceinline__ void gather_u(const bf16* xin, const float* fg, const int* ids, const float* gates, const unsigned char* UT, const float* USC, const float* VSC, float* wexp, int lane, int idmask = 0x7fffffff  , int* wpl = nullptr  , float* swi = nullptr  ) {
    static_assert(U_I4 && V_FP4, "split gather: int4 u rows, fp4 v rows");
    float wk_lo = 0.f, wk_hi = 0.f;
    float hx[32]; float ss = 0.f;
#pragma unroll
    for (int j = 0; j < 8; ++j) { const v2u bw = *(const v2u*)(xin + j * 256 + lane * 4); hx[4 * j] = bflo(bw.x); hx[4 * j + 1] = bfhi(bw.x); hx[4 * j + 2] = bflo(bw.y); hx[4 * j + 3] = bfhi(bw.y);
        ss += (hx[4 * j] * hx[4 * j] + hx[4 * j + 1] * hx[4 * j + 1]) + (hx[4 * j + 2] * hx[4 * j + 2] + hx[4 * j + 3] * hx[4 * j + 3]); }
    const float r = 1.0f / sqrtf(wave_sum(ss, lane) * (1.f / 2048.f) + EPS);
    float hm = 0.f;
#pragma unroll
    for (int j = 0; j < 8; ++j) { const f32x4 a = *(const f32x4*)(fg + j * 256 + lane * 4);
        hx[4 * j] *= a.x * r; hx[4 * j + 1] *= a.y * r; hx[4 * j + 2] *= a.z * r; hx[4 * j + 3] *= a.w * r;
        hm = fmaxf(hm, fmaxf(fmaxf(fabsf(hx[4 * j]), fabsf(hx[4 * j + 1])), fmaxf(fabsf(hx[4 * j + 2]), fabsf(hx[4 * j + 3])))); }
#pragma unroll
    for (int o = 1; o < 64; o <<= 1) hm = fmaxf(hm, SHX(hm, o));
    const float sh = hm > 0.f ? 119.0f / hm : 0.f, shinv = hm * (1.0f / 119.0f);
    unsigned hiP[4], loP[4];
#pragma unroll
    for (int d = 0; d < 4; ++d) { unsigned th = 0u, tl = 0u;
#pragma unroll
        for (int n = 0; n < 8; ++n) { const int hq = (int)rintf(hx[8 * d + n] * sh); const int hi_ = (hq + 8) >> 4, lo_ = hq - 16 * hi_; th |= ((unsigned)hi_ & 15u) << (4 * n); tl |= ((unsigned)lo_ & 15u) << (4 * n); }
        hiP[d] = th; loP[d] = tl; }
    const int id_lo = ids[lane] & idmask, id_hi = ids[64 + lane] & idmask;
    const float ua_lo = USC[id_lo] * shinv, ua_hi = USC[id_hi] * shinv;
    const float gb_lo = gates[lane] * VSC[id_lo], gb_hi = gates[64 + lane] * VSC[id_hi];
    constexpr int GB = 16;
    for (int kk = 0; kk < 128; kk += GB) {
        v4u ua[GB];
#pragma unroll
        for (int e = 0; e < GB; ++e) { const int id = __builtin_amdgcn_readlane(kk < 64 ? id_lo : id_hi, (kk + e) & 63); ua[e] = *(const v4u*)(UT + (size_t)id * UROWB + lane * 16); }
        float d[GB];
#pragma unroll
        for (int e = 0; e < GB; ++e) {
            int ah = __builtin_amdgcn_sdot8((int)ua[e].x, (int)hiP[0], 0, false), al = __builtin_amdgcn_sdot8((int)ua[e].x, (int)loP[0], 0, false);
            ah = __builtin_amdgcn_sdot8((int)ua[e].y, (int)hiP[1], ah, false); al = __builtin_amdgcn_sdot8((int)ua[e].y, (int)loP[1], al, false);
            ah = __builtin_amdgcn_sdot8((int)ua[e].z, (int)hiP[2], ah, false); al = __builtin_amdgcn_sdot8((int)ua[e].z, (int)loP[2], al, false);
            ah = __builtin_amdgcn_sdot8((int)ua[e].w, (int)hiP[3], ah, false); al = __builtin_amdgcn_sdot8((int)ua[e].w, (int)loP[3], al, false);
            d[e] = (float)(16 * ah + al); }
#pragma unroll
        for (int step = 1, n = GB; n > 1; step <<= 1, n >>= 1) {
            const bool bb = (lane & step) != 0;
#pragma unroll
            for (int i = 0; i < n / 2; ++i) { const float keep = bb ? d[2 * i + 1] : d[2 * i], send = bb ? d[2 * i] : d[2 * i + 1]; d[i] = keep + SHX(send, step); }
        }
        float s = d[0];
        s += SHX(s, 16); s += SHX(s, 32);
        const int src = (kk & 63) + (lane & 15);
        const float a = s * shi_(kk < 64 ? ua_lo : ua_hi, src);
        const float wv = shi_(kk < 64 ? gb_lo : gb_hi, src) * 0.5f * a * (1.0f + erff(a * 0.70710678118654752f));
#if V_SLICED
        if ((lane >> 4) == ((kk >> 4) & 3)) { if (kk < 64) wk_lo = wv; else wk_hi = wv; }
#else
        if (lane < 16) wexp[kk + lane] = wv;
#endif
    }
#if V_SLICED
    {
        float wm = fmaxf(fabsf(wk_lo), fabsf(wk_hi));
#pragma unroll
        for (int o = 1; o < 64; o <<= 1) wm = fmaxf(wm, SHX(wm, o));
        const float sw = wm > 0.f ? 119.0f / wm : 0.f;
        const int sh4 = 4 * (lane & 7);
        const int q0 = (int)rintf(wk_lo * sw), q1 = (int)rintf(wk_hi * sw);
        const int h0 = (q0 + 8) >> 4, l0 = q0 - 16 * h0, h1 = (q1 + 8) >> 4, l1 = q1 - 16 * h1;
        int PHlo = (int)(((unsigned)h0 & 15u) << sh4), PLlo = (int)(((unsigned)l0 & 15u) << sh4), PHhi = (int)(((unsigned)h1 & 15u) << sh4), PLhi = (int)(((unsigned)l1 & 15u) << sh4);
#pragma unroll
        for (int o = 1; o < 8; o <<= 1) { PHlo |= SHX(PHlo, o); PLlo |= SHX(PLlo, o); PHhi |= SHX(PHhi, o); PLhi |= SHX(PLhi, o); }
        if ((lane & 7) == 0) { *(v2u*)(wpl + 2 * (lane >> 3)) = (v2u){(unsigned)PHlo, (unsigned)PLlo}; *(v2u*)(wpl + 16 + 2 * (lane >> 3)) = (v2u){(unsigned)PHhi, (unsigned)PLhi}; }
        if (lane == 0) *swi = wm * (1.0f / 119.0f);
    }
#endif
}
__device__ __forceinline__ void gather_v(const bf16* xin, float* xrow, const float* wexp, const int* ids, const unsigned char* VT, bf16* xn_out, float* rs_out, int lane,
                                         const float* cv_src, size_t cv_vofs, unsigned char* cv_du, unsigned char* cv_dv, float* cv_su, float* cv_sv, int cv_r0, int f4ord, int f6ord, LAS unsigned char* cv_lds, int idmask = 0x7fffffff  ) {
#if V_I4
    int accH[32], accL[32];
#pragma unroll
    for (int j = 0; j < 32; ++j) { accH[j] = 0; accL[j] = 0; }
    const int id_lo = ids[lane] & idmask, id_hi = ids[64 + lane] & idmask;
    const float w_lo = wexp[lane], w_hi = wexp[64 + lane];
    float wm = fmaxf(fabsf(w_lo), fabsf(w_hi));
#pragma unroll
    for (int o = 1; o < 64; o <<= 1) wm = fmaxf(wm, SHX(wm, o));
    const float sw = wm > 0.f ? 119.0f / wm : 0.f, swinv = wm * (1.0f / 119.0f);
    int PHlo, PLlo, PHhi, PLhi;
    { const int sh4 = 4 * (lane & 7);
      const int q0 = (int)rintf(w_lo * sw), q1 = (int)rintf(w_hi * sw);
      const int h0 = (q0 + 8) >> 4, l0 = q0 - 16 * h0, h1 = (q1 + 8) >> 4, l1 = q1 - 16 * h1;
      PHlo = (int)(((unsigned)h0 & 15u) << sh4); PLlo = (int)(((unsigned)l0 & 15u) << sh4); PHhi = (int)(((unsigned)h1 & 15u) << sh4); PLhi = (int)(((unsigned)l1 & 15u) << sh4);
#pragma unroll
      for (int o = 1; o < 8; o <<= 1) { PHlo |= SHX(PHlo, o); PLlo |= SHX(PLlo, o); PHhi |= SHX(PHhi, o); PLhi |= SHX(PLhi, o); } }
#else
    typedef _Float16 h2_t __attribute__((ext_vector_type(2)));
    h2_t dacc[16];
#pragma unroll
    for (int j = 0; j < 16; ++j) dacc[j] = (h2_t){(_Float16)0.f, (_Float16)0.f};
    const int id_lo = ids[lane], id_hi = ids[64 + lane];
    const float w_lo = wexp[lane], w_hi = wexp[64 + lane];
#endif
#define CV_SRC(r) ((r) >= NEXP ? cv_src + cv_vofs + (size_t)((r) - NEXP) * DM : cv_src + (size_t)(r) * DM)
#define CV_LOAD(r) do { const float* sp_ = CV_SRC(r); _Pragma("unroll") for (int j_ = 0; j_ < 8; ++j_) __builtin_amdgcn_global_load_lds((const unsigned*)(sp_ + j_ * 256 + lane * 4), (LAS unsigned*)(cv_lds + j_ * 1024), 16, 0, 2); } while (0)
#define CV_FIN(r) do { asm volatile("s_waitcnt vmcnt(0)" ::: "memory"); f32x4 cvr[8]; _Pragma("unroll") for (int j_ = 0; j_ < 8; ++j_) cvr[j_] = *(const LAS f32x4*)(cv_lds + j_ * 1024 + lane * 16); \
        const bool isv_ = (r) >= NEXP; const int rr_ = isv_ ? (r) - NEXP : (r); \
        if ((U_I4 && !isv_) || (V_I4 && isv_)) row_i4_finish(cvr, (isv_ ? cv_dv + (size_t)rr_ * VROWB : cv_du + (size_t)rr_ * UROWB), (isv_ ? cv_sv : cv_su) + rr_, lane); else row_fp4_finish(cvr, (isv_ ? cv_dv + (size_t)rr_ * VROWB : cv_du + (size_t)rr_ * UROWB), (isv_ ? cv_sv : cv_su) + rr_, f4ord, lane); asm volatile("s_waitcnt lgkmcnt(0)" ::: "memory"); } while (0)
    if (cv_src) CV_LOAD(cv_r0);
    constexpr int GB = 16;
    for (int kk = 0; kk < 128; kk += GB) {
        if (cv_src && kk > 0 && (kk & 31) == 0) { const int rdone = cv_r0 + (kk >> 5) - 1; CV_FIN(rdone); CV_LOAD(rdone + 1); }
        v4u va[GB];
#pragma unroll
        for (int e = 0; e < GB; ++e) { const int id = __builtin_amdgcn_readlane(kk < 64 ? id_lo : id_hi, (kk + e) & 63); va[e] = *(const v4u*)(VT + (size_t)id * VROWB + lane * 16); }
#if V_I4
#pragma unroll
        for (int g = 0; g < GB / 8; ++g) {
            const int ph = __builtin_amdgcn_readlane(kk < 64 ? PHlo : PHhi, (kk & 63) + 8 * g), pl = __builtin_amdgcn_readlane(kk < 64 ? PLlo : PLhi, (kk & 63) + 8 * g);
#pragma unroll
            for (int d = 0; d < 4; ++d) {
                unsigned a[8], s1[8], s2[8];
#pragma unroll
                for (int k = 0; k < 8; ++k) a[k] = d == 0 ? va[8 * g + k].x : (d == 1 ? va[8 * g + k].y : (d == 2 ? va[8 * g + k].z : va[8 * g + k].w));
#pragma unroll
                for (int m = 0; m < 4; ++m) { const unsigned x = a[2 * m], y = a[2 * m + 1];
                    s1[2 * m] = (x & 0x0F0F0F0Fu) | ((y << 4) & 0xF0F0F0F0u); s1[2 * m + 1] = ((x >> 4) & 0x0F0F0F0Fu) | (y & 0xF0F0F0F0u); }
#pragma unroll
                for (int r = 0; r < 8; ++r) if (!(r & 2)) { s2[r] = __builtin_amdgcn_perm(s1[r | 2], s1[r], 0x06020400u); s2[r | 2] = __builtin_amdgcn_perm(s1[r | 2], s1[r], 0x07030501u); }
#pragma unroll
                for (int r = 0; r < 8; ++r) if (!(r & 4)) { const unsigned t0 = __builtin_amdgcn_perm(s2[r | 4], s2[r], 0x05040100u), t1 = __builtin_amdgcn_perm(s2[r | 4], s2[r], 0x07060302u);
                    accH[8 * d + r] = __builtin_amdgcn_sdot8((int)t0, ph, accH[8 * d + r], false); accL[8 * d + r] = __builtin_amdgcn_sdot8((int)t0, pl, accL[8 * d + r], false);
                    accH[8 * d + (r | 4)] = __builtin_amdgcn_sdot8((int)t1, ph, accH[8 * d + (r | 4)], false); accL[8 * d + (r | 4)] = __builtin_amdgcn_sdot8((int)t1, pl, accL[8 * d + (r | 4)], false); }
            }
            __builtin_amdgcn_sched_barrier(0);
        }
#else
#pragma unroll
        for (int e = 0; e < GB; ++e) { const float we = __builtin_bit_cast(float, __builtin_amdgcn_readlane(__builtin_bit_cast(int, kk < 64 ? w_lo : w_hi), (kk + e) & 63)); const h2_t w2 = (h2_t){(_Float16)we, (_Float16)we};
            const unsigned vw[4] = {va[e].x, va[e].y, va[e].z, va[e].w};
#pragma unroll
            for (int dq = 0; dq < 4; ++dq) { dacc[4 * dq] = __builtin_elementwise_fma(w2, __builtin_bit_cast(h2_t, __builtin_amdgcn_cvt_scalef32_pk_f16_fp4(vw[dq], 1.0f, 0)), dacc[4 * dq]); dacc[4 * dq + 1] = __builtin_elementwise_fma(w2, __builtin_bit_cast(h2_t, __builtin_amdgcn_cvt_scalef32_pk_f16_fp4(vw[dq], 1.0f, 1)), dacc[4 * dq + 1]);
                dacc[4 * dq + 2] = __builtin_elementwise_fma(w2, __builtin_bit_cast(h2_t, __builtin_amdgcn_cvt_scalef32_pk_f16_fp4(vw[dq], 1.0f, 2)), dacc[4 * dq + 2]); dacc[4 * dq + 3] = __builtin_elementwise_fma(w2, __builtin_bit_cast(h2_t, __builtin_amdgcn_cvt_scalef32_pk_f16_fp4(vw[dq], 1.0f, 3)), dacc[4 * dq + 3]); }
            __builtin_amdgcn_sched_barrier(0); }
#endif
    }
    if (cv_src) { CV_FIN(cv_r0 + 3); }
#undef CV_SRC
#undef CV_FIN
#undef CV_LOAD
    (void)f6ord;
    int ln2 = lane; asm volatile("" : "+v"(ln2));
    f32x2 acc[16];
#pragma unroll
    for (int j = 0; j < 8; ++j) { const v2u bw = *(const v2u*)(xin + j * 256 + ln2 * 4);
#if V_I4
        acc[2 * j] = (f32x2){bflo(bw.x) + (float)(16 * accH[4 * j] + accL[4 * j]) * swinv, bfhi(bw.x) + (float)(16 * accH[4 * j + 1] + accL[4 * j + 1]) * swinv};
        acc[2 * j + 1] = (f32x2){bflo(bw.y) + (float)(16 * accH[4 * j + 2] + accL[4 * j + 2]) * swinv, bfhi(bw.y) + (float)(16 * accH[4 * j + 3] + accL[4 * j + 3]) * swinv}; }
#else
        acc[2 * j] = (f32x2){bflo(bw.x) + (float)dacc[2 * j].x, bfhi(bw.x) + (float)dacc[2 * j].y}; acc[2 * j + 1] = (f32x2){bflo(bw.y) + (float)dacc[2 * j + 1].x, bfhi(bw.y) + (float)dacc[2 * j + 1].y}; }
#endif
    if (xrow) {
#pragma unroll
        for (int j = 0; j < 8; ++j) *(f32x4*)(xrow + j * 256 + ln2 * 4) = (f32x4){acc[2 * j].x, acc[2 * j].y, acc[2 * j + 1].x, acc[2 * j + 1].y};
    }
    if (xn_out) {
        float s2 = 0.f;
#pragma unroll
        for (int j = 0; j < 16; ++j) s2 += acc[j].x * acc[j].x + acc[j].y * acc[j].y;
        const float st2 = wave_sum(s2, lane);
        if (ln2 < 8) rs_out[ln2] = ln2 == 0 ? st2 : 0.f;
#pragma unroll
        for (int j = 0; j < 8; ++j) { v2u w0; w0.x = pk2(acc[2 * j].x, acc[2 * j].y); w0.y = pk2(acc[2 * j + 1].x, acc[2 * j + 1].y);
            *(v2u*)(xn_out + j * 256 + ln2 * 4) = w0; }
    }
}

#if V_SLICED
__device__ __forceinline__ void gather_v_sliced(bf16* xrows  , float* xout  , const int* WPL, const float* SWI, const int* IDS, const unsigned char* VT,
                                                float* ssq  , int uidx, int x, int lane,
                                                const float* cv_src, size_t cv_vofs, unsigned char* cv_du, unsigned char* cv_dv, float* cv_su, float* cv_sv, int cv_r0, int f4ord, LAS unsigned char* cv_lds) {
    static_assert(V_I4 && U_I4, "sliced v sub-pass: int4 tables");
    constexpr int LPT = 64 / V_SLICES, TPW = V_SLICES, SROW = 1024 / V_SLICES;
    const int c = lane & (LPT - 1), L = LPT * x + c, m = TPW * uidx + lane / LPT;
    int accH[32], accL[32];
#pragma unroll
    for (int j = 0; j < 32; ++j) { accH[j] = 0; accL[j] = 0; }
    const int* idp = IDS + (size_t)m * 128; const int* wp = WPL + (size_t)m * 32;
    const unsigned lofs = (unsigned)c * 16u;
#define CV_SRC(r) ((r) >= NEXP ? cv_src + cv_vofs + (size_t)((r) - NEXP) * DM : cv_src + (size_t)(r) * DM)
#define CV_LOAD(r, slot) do { const float* sp_ = CV_SRC(r); _Pragma("unroll") for (int j_ = 0; j_ < 8; ++j_) __builtin_amdgcn_global_load_lds((const unsigned*)(sp_ + j_ * 256 + lane * 4), (LAS unsigned*)(cv_lds + (slot) * 8192 + j_ * 1024), 16, 0, 2); } while (0)
#define CV_FIN(r, slot) do { asm volatile("s_waitcnt vmcnt(0)" ::: "memory"); f32x4 cvr[8]; _Pragma("unroll") for (int j_ = 0; j_ < 8; ++j_) cvr[j_] = *(const LAS f32x4*)(cv_lds + (slot) * 8192 + j_ * 1024 + lane * 16); \
        const bool isv_ = (r) >= NEXP; const int rr_ = isv_ ? (r) - NEXP : (r); \
        row_i4_finish(cvr, (isv_ ? cv_dv + (size_t)rr_ * SROW : cv_du + (size_t)rr_ * UROWB), (isv_ ? cv_sv : cv_su) + rr_, lane, isv_); asm volatile("s_waitcnt lgkmcnt(0)" ::: "memory"); } while (0)
    typedef int v4i_ __attribute__((ext_vector_type(4)));
    v4i_ idn[4], pln;
#pragma unroll
    for (int q = 0; q < 4; ++q) idn[q] = *(const v4i_*)(idp + 4 * q);
    pln = *(const v4i_*)wp;
    constexpr int GB = 16;
    for (int kk = 0; kk < 128; kk += GB) {
        const int idc[16] = {idn[0].x, idn[0].y, idn[0].z, idn[0].w, idn[1].x, idn[1].y, idn[1].z, idn[1].w, idn[2].x, idn[2].y, idn[2].z, idn[2].w, idn[3].x, idn[3].y, idn[3].z, idn[3].w};
        const int plc[4] = {pln.x, pln.y, pln.z, pln.w};
        v4u va[GB];
#pragma unroll
        for (int e = 0; e < GB; ++e) va[e] = *(const v4u*)(VT + (size_t)((unsigned)idc[e] * (unsigned)SROW + lofs));
        { const int kn = kk + GB < 128 ? kk + GB : kk;
#pragma unroll
          for (int q = 0; q < 4; ++q) idn[q] = *(const v4i_*)(idp + kn + 4 * q);
          pln = *(const v4i_*)(wp + (kn >> 2)); }
#pragma unroll
        for (int g = 0; g < GB / 8; ++g) {
            const int ph = plc[2 * g], pl = plc[2 * g + 1];
#pragma unroll
            for (int d = 0; d < 4; ++d) {
                unsigned a[8], s1[8], s2[8];
#pragma unroll
                for (int k = 0; k < 8; ++k) a[k] = d == 0 ? va[8 * g + k].x : (d == 1 ? va[8 * g + k].y : (d == 2 ? va[8 * g + k].z : va[8 * g + k].w));
#pragma unroll
                for (int mm = 0; mm < 4; ++mm) { const unsigned xx = a[2 * mm], yy = a[2 * mm + 1];
                    s1[2 * mm] = (xx & 0x0F0F0F0Fu) | ((yy << 4) & 0xF0F0F0F0u); s1[2 * mm + 1] = ((xx >> 4) & 0x0F0F0F0Fu) | (yy & 0xF0F0F0F0u); }
#pragma unroll
                for (int r = 0; r < 8; ++r) if (!(r & 2)) { s2[r] = __builtin_amdgcn_perm(s1[r | 2], s1[r], 0x06020400u); s2[r | 2] = __builtin_amdgcn_perm(s1[r | 2], s1[r], 0x07030501u); }
#pragma unroll
                for (int r = 0; r < 8; ++r) if (!(r & 4)) { const unsigned t0 = __builtin_amdgcn_perm(s2[r | 4], s2[r], 0x05040100u), t1 = __builtin_amdgcn_perm(s2[r | 4], s2[r], 0x07060302u);
                    accH[8 * d + r] = __builtin_amdgcn_sdot8((int)t0, ph, accH[8 * d + r], false); accL[8 * d + r] = __builtin_amdgcn_sdot8((int)t0, pl, accL[8 * d + r], false);
                    accH[8 * d + (r | 4)] = __builtin_amdgcn_sdot8((int)t1, ph, accH[8 * d + (r | 4)], false); accL[8 * d + (r | 4)] = __builtin_amdgcn_sdot8((int)t1, pl, accL[8 * d + (r | 4)], false); }
            }
            __builtin_amdgcn_sched_barrier(0);
        }
    }
#undef CV_FIN
#undef CV_LOAD
    (void)f4ord;
    int L2_ = L, m2_ = m; asm volatile("" : "+v"(L2_), "+v"(m2_));
    f32x4 cra[8], crb[8], crc[8], crd[8];
    if (cv_src) { int ln_ = lane; asm volatile("" : "+v"(ln_)); row_fp6_load(CV_SRC(cv_r0), cra, ln_); row_fp6_load(CV_SRC(cv_r0 + 1), crb, ln_); row_fp6_load(CV_SRC(cv_r0 + 2), crc, ln_); row_fp6_load(CV_SRC(cv_r0 + 3), crd, ln_); }
    const float swinv = SWI[m2_];
    bf16* xr = xrows + (size_t)m2_ * DM + 4 * L2_;
    f32x2 acc[16];
#pragma unroll
    for (int j = 0; j < 8; ++j) { const v2u bw = *(const v2u*)(xr + j * 256);
        acc[2 * j] = (f32x2){bflo(bw.x) + (float)(16 * accH[4 * j] + accL[4 * j]) * swinv, bfhi(bw.x) + (float)(16 * accH[4 * j + 1] + accL[4 * j + 1]) * swinv};
        acc[2 * j + 1] = (f32x2){bflo(bw.y) + (float)(16 * accH[4 * j + 2] + accL[4 * j + 2]) * swinv, bfhi(bw.y) + (float)(16 * accH[4 * j + 3] + accL[4 * j + 3]) * swinv}; }
    if (xout) {
        float* xo_ = xout + (size_t)m2_ * DM + 4 * L2_;
#pragma unroll
        for (int j = 0; j < 8; ++j) *(f32x4*)(xo_ + j * 256) = (f32x4){acc[2 * j].x, acc[2 * j].y, acc[2 * j + 1].x, acc[2 * j + 1].y};
    } else {
        float sq = 0.f;
#pragma unroll
        for (int j = 0; j < 16; ++j) sq += acc[j].x * acc[j].x + acc[j].y * acc[j].y;
#pragma unroll
        for (int o = 1; o < LPT; o <<= 1) sq += SHX(sq, o);
        if ((L2_ & (LPT - 1)) == 0) {
#pragma unroll
            for (int q = 0; q < 8 / V_SLICES; ++q) ssq[(size_t)m2_ * 8 + L2_ / LPT + q * V_SLICES] = q == 0 ? sq : 0.f; }
#pragma unroll
        for (int j = 0; j < 8; ++j) { v2u w0; w0.x = pk2(acc[2 * j].x, acc[2 * j].y); w0.y = pk2(acc[2 * j + 1].x, acc[2 * j + 1].y); *(v2u*)(xr + j * 256) = w0; }
    }
    if (cv_src) {
#define CV_FINR(V, r) do { const bool isv_ = (r) >= NEXP; const int rr_ = isv_ ? (r) - NEXP : (r); \
        row_i4_finish(V, (isv_ ? cv_dv + (size_t)rr_ * SROW : cv_du + (size_t)rr_ * UROWB), (isv_ ? cv_sv : cv_su) + rr_, lane, isv_); } while (0)
        CV_FINR(cra, cv_r0); CV_FINR(crb, cv_r0 + 1); CV_FINR(crc, cv_r0 + 2); CV_FINR(crd, cv_r0 + 3);
#undef CV_FINR
#undef CV_SRC
    }
}
#endif

__device__ __forceinline__ int lane_id_volatile() { int l_; asm volatile("v_mbcnt_lo_u32_b32 %0, -1, 0\n\tv_mbcnt_hi_u32_b32 %0, -1, %0" : "=v"(l_)); return l_; }
struct Args { const float* in[16]; float* out; unsigned char* ws; int ph_lo, ph_hi; };
constexpr int NPL = 7 + V_SLICED, NPH = 2 + DEPTH * NPL;

__global__ void __launch_bounds__(NWAVES * 64, 2) mk_fwd(Args args) {
    extern __shared__ __attribute__((aligned(16))) unsigned char lds[];
    LAS unsigned char* ldsl = (LAS unsigned char*)lds;
    volatile LAS unsigned* MISC = (volatile LAS unsigned*)(ldsl + MISC_OFF);
    const int G = gridDim.x; const int bx = blockIdx.x; const int vcu = (G % 8 == 0) ? (bx % 8) * (G / 8) + bx / 8 : bx;
    const int NGW = G * NWAVES;
    const int wave_s = __builtin_amdgcn_readfirstlane((int)threadIdx.x >> 6);
#define CAS __attribute__((address_space(4)))
#define GIN(k) ((const float*)(const GAS float*)ap->in[k])
#define PH_BEGIN() \
    int lane_; asm volatile("v_mbcnt_lo_u32_b32 %0, -1, 0\n\tv_mbcnt_hi_u32_b32 %0, -1, %0" : "=v"(lane_)); const int lane = lane_, wave = wave_s, tid = wave_s * 64 + lane_; const int gw = vcu * NWAVES + wave; \
    const CAS Args* ap = (const CAS Args*)__builtin_amdgcn_kernarg_segment_ptr(); asm volatile("" : "+s"(ap)); \
    GAS unsigned char* wsg = (GAS unsigned char*)ap->ws; unsigned char* ws = (unsigned char*)wsg; \
    const float* x_in = GIN(0); float* xo = (float*)(GAS float*)ap->out; \
    bf16* WTIN = (bf16*)(ws + WS_WTIN); bf16* WTOUT = (bf16*)(ws + WS_WTOUT); bf16* WTPQ = (bf16*)(ws + WS_WTPQ); bf16* WTKV = (bf16*)(ws + WS_WTKV); \
    bf16* XN = (bf16*)(ws + WS_XN); bf16* PROJ = (bf16*)(ws + WS_PROJ); bf16* OD = (bf16*)(ws + WS_OD); bf16* MIX = (bf16*)(ws + WS_MIX); bf16* PQ = (bf16*)(ws + WS_PQ); \
    unsigned char* UTAB = ws + WS_UTAB; unsigned char* VTAB = ws + WS_VTAB; float* USC = (float*)(ws + WS_USC); float* VSC = (float*)(ws + WS_VSC); bf16* KEYS = (bf16*)(ws + WS_KEYS); \
    bf16* MEMN = (bf16*)(ws + WS_MEMN); bf16* MEMKV = (bf16*)(ws + WS_MEMKV); \
    float* ROPEC = (float*)(ws + WS_ROPE); float* ROPES = ROPEC + 4096 * 16; \
    int* IDS = (int*)(ws + WS_IDS); float* GATES = (float*)(ws + WS_GATES); float* SSP = (float*)(ws + WS_SSP); float* RS = (float*)(ws + WS_RS); float* WEXP = (float*)(ws + WS_WEXP); \
    const float* xcur = (l == 0) ? x_in : xo; const float* gq = GIN(4) + (size_t)l * 6 * 128; \
    (void)lane; (void)gw; (void)x_in; (void)xo; (void)WTIN; (void)WTOUT; (void)WTPQ; (void)WTKV; (void)XN; (void)PROJ; (void)OD; (void)MIX; (void)PQ; (void)UTAB; (void)VTAB; (void)USC; (void)VSC; (void)KEYS; (void)MEMN; (void)MEMKV; (void)ROPEC; (void)ROPES; (void)IDS; (void)GATES; (void)SSP; (void)RS; (void)WEXP; (void)xcur; (void)gq;
    for (int u = (int)threadIdx.x; u < (LDS_BYTES - LDSCTL_OFF) / 4; u += NWAVES * 64) ((LAS unsigned*)(ldsl + LDSCTL_OFF))[u] = 0u;
    __syncthreads();
    const int lo = args.ph_lo, hi = args.ph_hi;
    XcdBarrier bar; bar.bar = (unsigned*)(args.ws + WS_CTL) + CW_BAR; bar.x = 0; bar.st = nullptr;
    if (hi - lo > 1) bar = xcd_barrier_post((unsigned*)(args.ws + WS_CTL) + CW_BAR, MISC + 8, threadIdx.x == 0);
#define IN(k) (lo <= (k) && (k) < hi)
#define T0() (wave_s == 0 && lane_id_volatile() == 0)
#define SEAM(k) do { if (IN(k) && IN((k) + 1)) xcd_barrier(bar, T0()); } while (0)

    if (PHEN(10) && IN(0)) for (int rep_ = 0; rep_ < PREP(10); ++rep_) { const int l = 0; PH_BEGIN();
        LAS float* scr = (LAS float*)(ldsl + wave * 16384);
        constexpr int I_IN = 32 * 160, I_OUT = 32 * 64, I_PQ = 32 * 64, I_KV = 32 * 32, I_L = I_IN + I_OUT + I_PQ + I_KV;
        for (int rep2_ = 0; rep2_ < PREP(12); ++rep2_)
        for (int it = gw; it < DEPTH * I_L; it += NGW) {
            const int l = it / I_L; int r = it % I_L;
            if (r < I_IN) { transpose_item(GIN(3) + (size_t)l * DM * INW, GIN(2) + l * DM, DM, INW, WTIN + (size_t)l * INW * DM, scr, r, lane); continue; } r -= I_IN;
            if (r < I_OUT) { transpose_item(GIN(10) + (size_t)l * MIXW * DM, nullptr, MIXW, DM, WTOUT + (size_t)l * DM * MIXW, scr, r, lane); continue; } r -= I_OUT;
            if (r < I_PQ) { transpose_item(GIN(12) + (size_t)l * DM * DM, GIN(11) + l * DM, DM, DM, WTPQ + (size_t)l * DM * DM, scr, r, lane); continue; } r -= I_PQ;
            transpose_item(GIN(9) + (size_t)l * DM * KVW, GIN(8) + l * DM, DM, KVW, WTKV + (size_t)l * KVW * DM, scr, r, lane);
        }
        for (int m = gw; m < NB * NMEM; m += NGW) rms_row_to_bf16(GIN(1) + (size_t)m * DM, MEMN + (size_t)m * DM, lane);
    }
    SEAM(0);
    if (PHEN(11) && IN(1)) { const int l = 0; PH_BEGIN();
        constexpr int NGEMM_ = (NB * NMEM / 256) * (DEPTH * KVW / 256);
        const int Gall = gridDim.x; const bool split_ = Gall > NGEMM_;
        if (!split_ || bx >= NGEMM_) {
            const int vcu = split_ ? bx - NGEMM_ : bx, G = split_ ? Gall - NGEMM_ : Gall; const int gw = vcu * NWAVES + wave, NGW = G * NWAVES;
        const int f6ord = fp6_order_probe(); const int f4ord = fp4_order_probe(); (void)f4ord;
        if (vcu == 0 && tid == 0) { ((int*)ws)[64] = f6ord; ((int*)ws)[65] = f4ord; }
        for (int rep3_ = 0; rep3_ < PREP(13); ++rep3_)
        for (int rw = gw; rw < 2 * NEXP; rw += 4 * NGW) {
            f32x4 va[8], vb[8], vc[8], vd[8];
            const int r1 = rw + NGW, r2 = rw + 2 * NGW, r3 = rw + 3 * NGW; const int NR = 2 * NEXP;
#define TSRC(r) (((r) >= NEXP ? GIN(15) + (size_t)((r) - NEXP) * DM : GIN(14) + (size_t)(r) * DM))
#define TDST(r) (((r) >= NEXP ? VTAB + (size_t)((r) - NEXP) * (V_SLICED ? 1024 / V_SLICES : VROWB) : UTAB + (size_t)(r) * UROWB))
#define TSCL(r) (((r) >= NEXP ? VSC + ((r) - NEXP) : USC + (r)))
            row_fp6_load(TSRC(rw), va, lane); if (r1 < NR) row_fp6_load(TSRC(r1), vb, lane); if (r2 < NR) row_fp6_load(TSRC(r2), vc, lane); if (r3 < NR) row_fp6_load(TSRC(r3), vd, lane);
#define TFIN(V, r) do { if ((U_I4 && (r) < NEXP) || (V_I4 && (r) >= NEXP)) row_i4_finish(V, TDST(r), TSCL(r), lane, V_SLICED && (r) >= NEXP); else if ((U_FP4 && (r) < NEXP) || (V_FP4 && (r) >= NEXP)) row_fp4_finish(V, TDST(r), TSCL(r), f4ord, lane); else row_fp6_finish(V, TDST(r), TSCL(r), f6ord, lane); } while (0)
            TFIN(va, rw); if (r1 < NR) TFIN(vb, r1); if (r2 < NR) TFIN(vc, r2); if (r3 < NR) TFIN(vd, r3);
#undef TFIN
#undef TSRC
#undef TDST
#undef TSCL
        }
        {
            const size_t gt = (size_t)vcu * (NWAVES * 64) + tid, NT_ = (size_t)G * NWAVES * 64;
            const size_t nk8 = (size_t)DEPTH * 8 * 2 * 128 * 128 / 8;
            for (size_t i = gt; i < nk8; i += NT_) {
                const float* src = GIN(13);
                const f32x4 a = *(const f32x4*)(src + i * 8), b = *(const f32x4*)(src + i * 8 + 4);
                v4u o; o.x = pk2(a.x, a.y); o.y = pk2(a.z, a.w); o.z = pk2(b.x, b.y); o.w = pk2(b.z, b.w);
                *(v4u*)(KEYS + i * 8) = o;
            }
            for (size_t i = gt; i < 4096 * 16; i += NT_) {
                const int pos = (int)(i >> 4), fi = (int)(i & 15);
                const double inv = exp2(-(double)fi * (18.931568569324174 / 16.0));
                const double rev = (double)pos * inv * 0.15915494309189535;
                const float fr = (float)(rev - floor(rev));
                ROPEC[i] = __builtin_amdgcn_cosf(fr); ROPES[i] = __builtin_amdgcn_sinf(fr);
            }
        }
        for (int m = gw; m < T; m += NGW) row_to_bf16_rs(x_in + (size_t)m * DM, XN + (size_t)m * DM, RS + (size_t)m * 8, lane);
        }
        pg8::Gemm g{MEMN, WTKV, NB * NMEM, DEPTH * KVW, DM}; pg8::StaticOrder S; S.init(NB * NMEM, DEPTH * KVW, Gall, bx);
        EpiProjT<true> E{MEMKV, GIN(4), nullptr, nullptr, (LAS float*)(ldsl + EPI_P_OFF), 0, nullptr};
        pg8::gemm_phase<EpiProjT<true>, pg8::StaticOrder, false>((PG8_LAS unsigned char*)ldsl, g, S, E, nullptr, tid);
    }
    SEAM(1);

    for (int l = 0; l < DEPTH; ++l) {
        const int pb = 2 + l * NPL;
        const float lam_init = 0.8f - 0.6f * expf(-0.3f * (float)l);
        if (PHEN(0) && IN(pb + 0)) { PH_BEGIN();
            for (int rep_ = 0; rep_ < PREP(0); ++rep_) {
            pg8::Gemm g{XN, WTIN + (size_t)l * INW * DM + (size_t)OFF_NQ * DM, T, INW - OFF_NQ, DM}; pg8::StaticOrder S; S.init(T, INW - OFF_NQ, G, bx);
            EpiProj E{PROJ, gq, ROPEC, ROPES, (LAS float*)(ldsl + EPI_P_OFF), OFF_NQ / 256, RS};
            pg8::gemm_phase<EpiProj, pg8::StaticOrder, false>((PG8_LAS unsigned char*)ldsl, g, S, E, nullptr, tid); }
        }
        SEAM(pb + 0);
        if (PHEN(3) && IN(pb + 1)) for (int rep_ = 0; rep_ < PREP(3); ++rep_) { PH_BEGIN();
            {
            pg8::Gemm g{XN, WTIN + (size_t)l * INW * DM, T, OFF_NQ, DM}; pg8::StaticOrder S; S.init(T, OFF_NQ, G, bx);
            EpiProj E{PROJ, gq, ROPEC, ROPES, (LAS float*)(ldsl + EPI_P_OFF), 0, RS};
            pg8::gemm_phase<EpiProj, pg8::StaticOrder, false>((PG8_LAS unsigned char*)ldsl, g, S, E, nullptr, tid);
            }
            float negm;
            { float a4 = fmaxf(fabsf(gq[512 + lane]), fabsf(gq[576 + lane])), a5 = fmaxf(fabsf(gq[640 + lane]), fabsf(gq[704 + lane]));
#pragma unroll
              for (int o = 1; o < 64; o <<= 1) { a4 = fmaxf(a4, SHX(a4, o)); a5 = fmaxf(a5, SHX(a5, o)); }
              negm = -11.313708498984761f * a4 * a5 * 1.4426950408889634f; }
            const int nshort = (G > 128) ? 128 : 0;
            for (int u = (nshort ? bx - (G - 128) : bx); u >= 0 && u < 128; u += (nshort ? 128 : G)) {
                const int rb = u & 15, h = (u >> 4) & 3, b = u >> 6; const int r0 = rb * 4, kr0 = min(max(r0 - 4, 0), 52);
                __syncthreads();
                if (tid < 465) ((float*)(lds + att::SHM_NA_BIAS))[tid] = GIN(7)[((size_t)l * 4 + h) * 465 + tid] * 1.4426950408889634f;
                att::attn_body<1, 1, INW, INW, INW, MIXW, true>(PROJ + (size_t)(b * SEQ + r0 * 64) * INW + OFF_NQ + h * 128,
                    PROJ + (size_t)(b * SEQ + kr0 * 64) * INW + OFF_NK + h * 128, PROJ + (size_t)(b * SEQ + kr0 * 64) * INW + OFF_NV + h * 128,
                    MIX + (size_t)(b * SEQ + r0 * 64) * MIXW + 1024 + h * 128, 768, (char*)lds, r0, kr0, 0.f, tid);
            }
            for (int u = (nshort ? bx - (G - 128) : bx); u >= 0 && u < 128; u += (nshort ? 128 : G)) {
                const int qb = u & 15, h = (u >> 4) & 3, b = u >> 6;
                __syncthreads();
                att::attn_body<0, 2, INW, DEPTH * KVW, DEPTH * KVW, MIXW, true>(PROJ + (size_t)(b * SEQ + qb * 256) * INW + OFF_MQ + h * 128,
                    MEMKV + (size_t)(b * NMEM) * (DEPTH * KVW) + l * KVW + h * 128, MEMKV + (size_t)(b * NMEM) * (DEPTH * KVW) + l * KVW + 512 + h * 128,
                    MIX + (size_t)(b * SEQ + qb * 256) * MIXW + 1536 + h * 128, NMEM, (char*)lds, 0, 0, negm, tid);
            }
            __syncthreads();
        }
        SEAM(pb + 1);
        if (PHEN(4) && IN(pb + 2)) for (int rep_ = 0; rep_ < PREP(4); ++rep_) { PH_BEGIN();
            float negd;
            { float a0 = fmaxf(fabsf(gq[lane]), fabsf(gq[64 + lane])), a1 = fmaxf(fabsf(gq[128 + lane]), fabsf(gq[192 + lane]));
#pragma unroll
              for (int o = 1; o < 64; o <<= 1) { a0 = fmaxf(a0, SHX(a0, o)); a1 = fmaxf(a1, SHX(a1, o)); }
              negd = -11.313708498984761f * a0 * a1 * 1.4426950408889634f; }
            for (int u = vcu; u < 256; u += G) {
                const int qb = u & 15, c = (u >> 4) & 1, h = (u >> 5) & 3, b = u >> 7;
                __syncthreads();
                att::attn_wide_body<INW, INW, INW, 1024>(PROJ + (size_t)(b * SEQ + qb * 256) * INW + OFF_DQ + h * 256 + c * 128,
                    PROJ + (size_t)(b * SEQ) * INW + OFF_DK + h * 256 + c * 128, PROJ + (size_t)(b * SEQ) * INW + OFF_DV + h * 256,
                    OD + ((size_t)c * T + b * SEQ + qb * 256) * 1024 + h * 256, SEQ, ldsl, (char*)lds, negd, tid);
            }
            __syncthreads();
        }
        SEAM(pb + 2);
        if (PHEN(6) && IN(pb + 3)) { PH_BEGIN();
            const float* lq = GIN(5) + (size_t)l * 4 * 128;
            const float d01 = wave_sum(lq[lane] * lq[128 + lane] + lq[64 + lane] * lq[192 + lane], lane);
            const float d23 = wave_sum(lq[256 + lane] * lq[384 + lane] + lq[320 + lane] * lq[448 + lane], lane);
            const float lam = expf(d01) - expf(d23) + lam_init;
            const float* sg_ = GIN(6) + (size_t)l * 256; const int sub = lane & 15, h = lane >> 4;
            float gs[16];
#pragma unroll
            for (int j = 0; j < 16; ++j) gs[j] = sg_[sub * 16 + j] * (1.0f - lam_init);
            for (int m = gw; m < T; m += NGW) {
                const bf16* o0 = OD + (size_t)m * 1024 + h * 256 + sub * 16; const bf16* o1 = o0 + (size_t)T * 1024;
                float v[16]; float s = 0.f;
#pragma unroll
                for (int q = 0; q < 2; ++q) { const v4u a = *(const v4u*)(o0 + q * 8), b2 = *(const v4u*)(o1 + q * 8);
                    v[q * 8 + 0] = bflo(a.x) - lam * bflo(b2.x); v[q * 8 + 1] = bfhi(a.x) - lam * bfhi(b2.x); v[q * 8 + 2] = bflo(a.y) - lam * bflo(b2.y); v[q * 8 + 3] = bfhi(a.y) - lam * bfhi(b2.y);
                    v[q * 8 + 4] = bflo(a.z) - lam * bflo(b2.z); v[q * 8 + 5] = bfhi(a.z) - lam * bfhi(b2.z); v[q * 8 + 6] = bflo(a.w) - lam * bflo(b2.w); v[q * 8 + 7] = bfhi(a.w) - lam * bfhi(b2.w); }
#pragma unroll
                for (int j = 0; j < 16; ++j) s += v[j] * v[j];
                s += SHX(s, 1); s += SHX(s, 2); s += SHX(s, 4); s += SHX(s, 8);
                const float r = 1.0f / sqrtf(s * (1.f / 256.f) + EPS);
                v4u w0, w1;
                w0.x = pk2(v[0] * r * gs[0], v[1] * r * gs[1]); w0.y = pk2(v[2] * r * gs[2], v[3] * r * gs[3]); w0.z = pk2(v[4] * r * gs[4], v[5] * r * gs[5]); w0.w = pk2(v[6] * r * gs[6], v[7] * r * gs[7]);
                w1.x = pk2(v[8] * r * gs[8], v[9] * r * gs[9]); w1.y = pk2(v[10] * r * gs[10], v[11] * r * gs[11]); w1.z = pk2(v[12] * r * gs[12], v[13] * r * gs[13]); w1.w = pk2(v[14] * r * gs[14], v[15] * r * gs[15]);
                bf16* mp = MIX + (size_t)m * MIXW + h * 256 + sub * 16;
                *(v4u*)mp = w0; *(v4u*)(mp + 8) = w1;
            }
        }
        SEAM(pb + 3);
        if (PHEN(5) && IN(pb + 4)) { PH_BEGIN();
            pg8::Gemm g{MIX, WTOUT + (size_t)l * DM * MIXW, T, DM, MIXW}; pg8::StaticOrder S; S.init(T, DM, G, bx);
            EpiResF32 E{XN, SSP, DM};
            pg8::gemm_phase<EpiResF32, pg8::StaticOrder, false>((PG8_LAS unsigned char*)ldsl, g, S, E, nullptr, tid);
        }
        SEAM(pb + 4);
        if (PHEN(7) && IN(pb + 5)) for (int rep_ = 0; rep_ < PREP(7); ++rep_) { PH_BEGIN();
            pg8::Gemm g{XN, WTPQ + (size_t)l * DM * DM, T, DM, DM}; pg8::StaticOrder S; S.init(T, DM, G, bx);
            pg8::EpiBf16<0> E{PQ, DM, nullptr, 0, 0};
            pg8::gemm_phase<pg8::EpiBf16<0>, pg8::StaticOrder, false>((PG8_LAS unsigned char*)ldsl, g, S, E, nullptr, tid);
            LAS int* lscr = (LAS int*)(ldsl + 65536 + wave * 8192);
            if (G == (T / 256) * (DM / 256)) {
                pg8::Unit u; S.next(0, u);
                asm volatile("s_waitcnt vmcnt(0)" ::: "memory"); __syncthreads();
                {
                    const bf16* ksrc_ = KEYS + ((size_t)l * 8 + u.pn) * 2 * 128 * 128;
#pragma unroll
                    for (int i = 0; i < 8; ++i) { const int ch = i * 512 + tid; const int row = ch >> 4, cc = ch & 15;
                        const v4u kv = *(const v4u*)(ksrc_ + (size_t)row * 128 + cc * 8);
                        *(v4u*)(lds + (row >> 6) * 16384 + (row & 63) * 256 + ((cc * 16) ^ ((row & 7) << 4))) = kv; }
                }
                __syncthreads();
                select_task<true>(PQ, SSP, KEYS + (size_t)l * 8 * 2 * 128 * 128, IDS, GATES, u.pm * 8 + wave, u.pn, lscr, lane, (const char*)lds);
            } else if (hi - lo > 1) {
                xcd_barrier(bar, T0());
                for (int task = gw; task < (T / 32) * 8; task += NGW) select_task<false>(PQ, SSP, KEYS + (size_t)l * 8 * 2 * 128 * 128, IDS, GATES, task >> 3, task & 7, lscr, lane);
            }
        }
        SEAM(pb + 5);
        if (PHEN(9) && IN(pb + 6)) { PH_BEGIN();
            const int f6g = ((const int*)ws)[64], f4g = ((const int*)ws)[65];
#if GATHER_SPLIT
#if V_SLICED
            for (int m = gw; m < T; m += NGW) gather_u(XN + (size_t)m * DM, GIN(11) + (size_t)l * DM, IDS + (size_t)m * 128, GATES + (size_t)m * 128, UTAB + (size_t)l * NEXP * UROWB, USC + l * NEXP, VSC + l * NEXP, nullptr, lane, 0x7fffffff,
                                                       (int*)WEXP + (size_t)m * 32, WEXP + (size_t)T * 32 + m);
        }
        SEAM(pb + 6);
        if (PHEN(9) && IN(pb + 7)) { PH_BEGIN();
            const int f4g = ((const int*)ws)[65];
            const int NSW = NGW / V_SLICES;
            const int xs = gw / NSW;
#if PROBE_VL2
            for (int uidx = gw - xs * NSW; uidx < T / V_SLICES; uidx += NSW)
                gather_v_sliced(XN, (float*)PROJ, (const int*)WEXP, WEXP + (size_t)T * 32, IDS, VTAB + (size_t)l * NEXP * VROWB + (size_t)xs * NEXP * (1024 / V_SLICES), RS, uidx, xs, lane, nullptr, 0, nullptr, nullptr, nullptr, nullptr, 0, f4g, ldsl + wave * 8192);
#endif
            for (int uidx = gw - xs * NSW; uidx < T / V_SLICES; uidx += NSW)
                gather_v_sliced(XN, (l + 1 == DEPTH) ? xo : nullptr, (const int*)WEXP, WEXP + (size_t)T * 32, IDS, VTAB + (size_t)l * NEXP * VROWB + (size_t)xs * NEXP * (1024 / V_SLICES), RS, uidx, xs, lane,
                                (l + 1 < DEPTH) ? GIN(14) + (size_t)(l + 1) * NEXP * DM : nullptr, (size_t)(GIN(15) - GIN(14)), UTAB + (size_t)(l + 1) * NEXP * UROWB, VTAB + (size_t)(l + 1) * NEXP * VROWB, USC + (l + 1) * NEXP, VSC + (l + 1) * NEXP,
                                4 * (xs * (T / V_SLICES) + uidx), f4g, ldsl + wave * 16384);
#else
            for (int m = gw; m < T; m += NGW) gather_u(XN + (size_t)m * DM, GIN(11) + (size_t)l * DM, IDS + (size_t)m * 128, GATES + (size_t)m * 128, UTAB + (size_t)l * NEXP * UROWB, USC + l * NEXP, VSC + l * NEXP, WEXP + (size_t)m * 128, lane);
            asm volatile("s_waitcnt vmcnt(0)" ::: "memory");
#if PROBE_VL2
            for (int m = gw; m < T; m += NGW) gather_v(XN + (size_t)m * DM, (float*)PROJ + (size_t)m * DM, WEXP + (size_t)m * 128, IDS + (size_t)m * 128, VTAB + (size_t)l * NEXP * VROWB, nullptr, RS + m, lane,
                                                       nullptr, 0, nullptr, nullptr, nullptr, nullptr, 0, f4g, f6g, ldsl + wave * 8192, PROBE_VL2 == 1 ? 0x7ff : 0x7fffffff);
#endif
            for (int m = gw; m < T; m += NGW) gather_v(XN + (size_t)m * DM, (l + 1 == DEPTH) ? xo + (size_t)m * DM : nullptr, WEXP + (size_t)m * 128, IDS + (size_t)m * 128, VTAB + (size_t)l * NEXP * VROWB,
                                                       (l + 1 < DEPTH) ? XN + (size_t)m * DM : nullptr, RS + (size_t)m * 8, lane,
                                                       (l + 1 < DEPTH) ? GIN(14) + (size_t)(l + 1) * NEXP * DM : nullptr, (size_t)(GIN(15) - GIN(14)), UTAB + (size_t)(l + 1) * NEXP * UROWB, VTAB + (size_t)(l + 1) * NEXP * VROWB, USC + (l + 1) * NEXP, VSC + (l + 1) * NEXP, 4 * m, f4g, f6g, ldsl + wave * 8192);
#endif
#else
            for (int rep_ = PREP(9) - 1; rep_ >= 0; --rep_)
            for (int m = gw; m < T; m += NGW) gather_token(XN + (size_t)m * DM, rep_ ? (float*)PROJ + (size_t)m * DM : ((l + 1 == DEPTH) ? xo + (size_t)m * DM : nullptr), GIN(11) + (size_t)l * DM, IDS + (size_t)m * 128, GATES + (size_t)m * 128,
                                                           UTAB + (size_t)l * NEXP * UROWB, VTAB + (size_t)l * NEXP * VROWB, USC + l * NEXP, VSC + l * NEXP, (l + 1 < DEPTH && !rep_) ? XN + (size_t)m * DM : nullptr, RS + m, lane,
                                                           (l + 1 < DEPTH && !rep_) ? GIN(14) + (size_t)(l + 1) * NEXP * DM : nullptr, (size_t)(GIN(15) - GIN(14)), UTAB + (size_t)(l + 1) * NEXP * UROWB, VTAB + (size_t)(l + 1) * NEXP * VROWB, USC + (l + 1) * NEXP, VSC + (l + 1) * NEXP, 4 * m, f4g, f6g, ldsl + wave * 8192);
#endif
        }
        SEAM(pb + 6 + V_SLICED);
        if (hi - lo > 1) for (int xb_ = 0; xb_ < (PREP(14) - 1) * 16; ++xb_) xcd_barrier(bar, T0());
    }
#undef IN
#undef SEAM
}

extern "C" void kernel_launch(void* const* d_in, const int* in_sizes, int n_in, void* d_out, int out_size, void* d_ws, size_t ws_size, hipStream_t stream) {
    static int grid = 0;
    if (grid == 0) {
        if (n_in != 16 || out_size != T * DM || ws_size < WS_END) { fprintf(stderr, "kernel_launch: unexpected shapes: n_in %d out %d ws %zu (need >= %zu)\n", n_in, out_size, ws_size, (size_t)WS_END); grid = -1; return; }
        int dev = 0, cus = 0, per_cu = 0;
        if (hipGetDevice(&dev) != hipSuccess || hipDeviceGetAttribute(&cus, hipDeviceAttributeMultiprocessorCount, dev) != hipSuccess) { grid = -1; return; }
        if (hipFuncSetAttribute((const void*)mk_fwd, hipFuncAttributeMaxDynamicSharedMemorySize, LDS_BYTES) != hipSuccess) { fprintf(stderr, "kernel_launch: hipFuncSetAttribute failed\n"); grid = -1; return; }
        if (hipOccupancyMaxActiveBlocksPerMultiprocessor(&per_cu, (const void*)mk_fwd, NWAVES * 64, LDS_BYTES) != hipSuccess || per_cu < 1) { fprintf(stderr, "kernel_launch: occupancy query says %d blocks per CU\n", per_cu); }
        (void)hipGetLastError();
        grid = cus;
    }
    if (grid < 0) return;
    if (hipMemsetAsync((char*)d_ws + WS_CTL, 0, CTL_ZERO_BYTES, stream) != hipSuccess) return;
    Args a{};
    for (int i = 0; i < 16; ++i) a.in[i] = (const float*)d_in[i];
    a.out = (float*)d_out; a.ws = (unsigned char*)d_ws;
#if MK_ONE_LAUNCH
    a.ph_lo = 0; a.ph_hi = NPH;
    hipLaunchKernelGGL(mk_fwd, dim3(grid), dim3(NWAVES * 64), LDS_BYTES, stream, a);
#else
    for (int p = 0; p < NPH; ++p) { a.ph_lo = p; a.ph_hi = p + 1; hipLaunchKernelGGL(mk_fwd, dim3(grid), dim3(NWAVES * 64), LDS_BYTES, stream, a); }
#endif
    const hipError_t le = hipPeekAtLastError();
    if (le != hipSuccess) fprintf(stderr, "kernel_launch: launch failed: %s\n", hipGetErrorName(le));
}
```

```cpp
#include <hip/hip_runtime.h>
#include <cstdio>
#include <cstdint>
namespace pg8 {
#define PG8_LAS __attribute__((address_space(3)))
typedef unsigned short bf16_t;
typedef short bf16x8 __attribute__((ext_vector_type(8)));
typedef float f32x4 __attribute__((ext_vector_type(4)));
typedef unsigned u32x4 __attribute__((ext_vector_type(4)));
constexpr int BM = 256, BK = 64, HALF = 128, HTB = HALF * BK * 2  , STAGE_BYTES = 8 * HTB, NXCD = 8, WGM = 8;

__host__ __device__ __forceinline__ int lds_byte(int r, int c) { const int st = (r >> 4) * 2 + (c >> 5), rr = r & 15, cc = c & 31, ob = rr * 64 + cc * 2; return st * 1024 + (ob ^ (((ob >> 9) & 1) << 5)); }
__host__ __device__ __forceinline__ void stage_rc(int b, int& R, int& C) { const int st = b / 1024, sb = b % 1024, swz = sb ^ (((sb >> 9) & 1) << 5); R = (st >> 1) * 16 + swz / 64; C = (st & 1) * 32 + (swz % 64) / 2; }
__host__ __device__ __forceinline__ int perm32(int rho) { const int n = rho >> 4, i = rho & 15; return 8 * (i >> 2) + 4 * n + (i & 3); }

struct Unit { int pm, pn; };
struct Gemm { const bf16_t* A; const bf16_t* Bt; int M, N, K; };

struct StaticOrder {
    int nM, nN, nwg, G, c;
    __host__ __device__ void init(int M, int N, int G_, int c_) { nM = M / BM; nN = N / BM; nwg = nM * nN; G = G_; c = c_; }
    __host__ __device__ bool next(int i, Unit& u) const {
        const long L = (long)i * G + c; if (L >= nwg) return false;
        int wgid = (int)L; { const int q = nwg / NXCD, r = nwg % NXCD, xcd = wgid % NXCD, off = wgid / NXCD; wgid = (xcd < r ? xcd * (q + 1) : r * (q + 1) + (xcd - r) * q) + off; }
        const int nig = WGM * nN, gid = wgid / nig, fm = gid * WGM, gsz = (nM - fm) < WGM ? (nM - fm) : WGM;
        u.pm = fm + ((wgid % nig) % gsz); u.pn = (wgid % nig) / gsz; return true;
    }
    __device__ __forceinline__ void a_ready(const Unit&) const {}
    __device__ __forceinline__ void done(const Unit&) const {}
};
struct CountedOrder : StaticOrder {
    const unsigned* ready; unsigned need; unsigned* tmo;
    __device__ __forceinline__ void a_ready(const Unit& u) const {
        if (threadIdx.x < 64) {
            const unsigned long long t0 = __builtin_amdgcn_s_memrealtime(); unsigned polls = 0;
            while ((unsigned)__builtin_amdgcn_readfirstlane(__hip_atomic_load(ready + 64 * u.pm, __ATOMIC_RELAXED, __HIP_MEMORY_SCOPE_AGENT)) < need) {
                if ((++polls & 255u) == 0u && __builtin_amdgcn_readfirstlane(__hip_atomic_load(tmo, __ATOMIC_RELAXED, __HIP_MEMORY_SCOPE_AGENT)) != 0u) break;
                if (__builtin_amdgcn_s_memrealtime() - t0 > 2000000ull) {
                    if (threadIdx.x == 0) { unsigned expect = 0u; __hip_atomic_compare_exchange_strong(tmo + 1, &expect, 0x600u | (unsigned)(u.pm & 0xff), __ATOMIC_RELAXED, __ATOMIC_RELAXED, __HIP_MEMORY_SCOPE_AGENT); __hip_atomic_store(tmo, 1u, __ATOMIC_RELAXED, __HIP_MEMORY_SCOPE_AGENT); }
                    break; }
                __builtin_amdgcn_s_sleep(2); }
            __builtin_amdgcn_fence(__ATOMIC_ACQUIRE, "agent");
            asm volatile("s_waitcnt vmcnt(0)" ::: "memory");
        }
#if !defined(BROKEN_HOOK_NO_BARRIER)
        asm volatile("" ::: "memory"); __builtin_amdgcn_s_barrier(); asm volatile("" ::: "memory");
#endif
    }
};

__device__ __forceinline__ unsigned cvt_pk_bf16(float lo, float hi) { unsigned r; asm volatile("v_cvt_pk_bf16_f32 %0, %1, %2" : "=v"(r) : "v"(lo), "v"(hi)); return r; }
typedef float f32x2 __attribute__((ext_vector_type(2)));
__device__ __forceinline__ f32x2 gelu_pk(f32x2 v) {
    const f32x2 av = __builtin_elementwise_abs(v), d = av * 0.2316418882f + 1.0f;
    f32x2 t; t.x = __builtin_amdgcn_rcpf(d.x); t.y = __builtin_amdgcn_rcpf(d.y);
    f32x2 q = t * 0.5307027145f + (-0.7265760135f); q = q * t + 0.7107068705f; q = q * t + (-0.142248368f); q = q * t + 0.127414796f; q = q * t;
    const f32x2 s = (v * v) * (-0.72134752044f);
    f32x2 e; e.x = __builtin_amdgcn_exp2f(s.x); e.y = __builtin_amdgcn_exp2f(s.y);
    const f32x2 m = v * (q * e), r = v - m;
    f32x2 o; o.x = v.x < 0.f ? m.x : r.x; o.y = v.y < 0.f ? m.y : r.y; return o;
}

struct EpiF32 {
    static constexpr bool PERM = false, AFTER_DRAIN = false;
    float* C; int ldc; const float* bias;
    __device__ __forceinline__ void operator()(const f32x4 (&acc)[2][2][4][2], const Unit& u, int wr, int wc, int fr, int fq) const {
        const int row0 = u.pm * BM + wr * 64 + fr, col0 = u.pn * BM + wc * 32 + 4 * fq;
        f32x4 bv[2][2];
#pragma unroll
        for (int bj = 0; bj < 2; ++bj)
#pragma unroll
            for (int n = 0; n < 2; ++n) bv[bj][n] = bias ? *(const f32x4*)(bias + col0 + bj * HALF + n * 16) : (f32x4){0.f, 0.f, 0.f, 0.f};
#pragma unroll
        for (int ai = 0; ai < 2; ++ai)
#pragma unroll
            for (int m = 0; m < 4; ++m) { float* rowp = C + (size_t)(row0 + ai * HALF + m * 16) * ldc + col0;
#pragma unroll
                for (int bj = 0; bj < 2; ++bj)
#pragma unroll
                    for (int n = 0; n < 2; ++n) *(f32x4*)(rowp + bj * HALF + n * 16) = acc[ai][bj][m][n] + bv[bj][n]; }
    }
};
template <int ACT  > struct EpiBf16 {
    static constexpr bool PERM = true, AFTER_DRAIN = false;
    bf16_t* O; int ldc; const float* bias; int split_cols; size_t split_stride;
    __device__ __forceinline__ void operator()(const f32x4 (&acc)[2][2][4][2], const Unit& u, int wr, int wc, int fr, int fq) const {
        const int row0 = u.pm * BM + wr * 64 + fr; int colt = u.pn * BM; bf16_t* base = O;
        if (split_cols) { const int t = colt / split_cols; base += (size_t)t * split_stride; colt -= t * split_cols; }
        const int col0 = colt + wc * 32 + 8 * fq, bcol0 = u.pn * BM + wc * 32 + 8 * fq;
        f32x4 bv[2][2];
#pragma unroll
        for (int bj = 0; bj < 2; ++bj)
#pragma unroll
            for (int n = 0; n < 2; ++n) bv[bj][n] = bias ? *(const f32x4*)(bias + bcol0 + bj * HALF + 4 * n) : (f32x4){0.f, 0.f, 0.f, 0.f};
#pragma unroll
        for (int ai = 0; ai < 2; ++ai)
#pragma unroll
            for (int m = 0; m < 4; ++m) { bf16_t* rowp = base + (size_t)(row0 + ai * HALF + m * 16) * ldc + col0;
#pragma unroll
                for (int bj = 0; bj < 2; ++bj) { f32x4 v0 = acc[ai][bj][m][0] + bv[bj][0], v1 = acc[ai][bj][m][1] + bv[bj][1];
                    if (ACT == 1) { f32x2 a = gelu_pk((f32x2){v0[0], v0[1]}), b = gelu_pk((f32x2){v0[2], v0[3]}), c = gelu_pk((f32x2){v1[0], v1[1]}), d = gelu_pk((f32x2){v1[2], v1[3]});
                        v0 = (f32x4){a.x, a.y, b.x, b.y}; v1 = (f32x4){c.x, c.y, d.x, d.y}; }
                    if (ACT == 2) {
#pragma unroll
                        for (int j = 0; j < 4; ++j) { v0[j] = 0.5f * v0[j] * (1.0f + erff(v0[j] * 0.70710678f)); v1[j] = 0.5f * v1[j] * (1.0f + erff(v1[j] * 0.70710678f)); } }
                    u32x4 w; w.x = cvt_pk_bf16(v0[0], v0[1]); w.y = cvt_pk_bf16(v0[2], v0[3]); w.z = cvt_pk_bf16(v1[0], v1[1]); w.w = cvt_pk_bf16(v1[2], v1[3]);
                    *(u32x4*)(rowp + bj * HALF) = w; } }
    }
};

template <class Epi, class Sched, bool STAMP = false>
__device__ __forceinline__ void gemm_phase(PG8_LAS unsigned char* lds, const Gemm g, const Sched& S, const Epi& E, unsigned long long* stamps, int tid_in) {
    int tid_ = tid_in; asm volatile("" : "+v"(tid_));
    const int tid = tid_, wid = __builtin_amdgcn_readfirstlane(tid >> 6), lane = tid & 63, wr = wid >> 2, wc = wid & 3, fr = lane & 15, fq = lane >> 4;
    const int K = g.K, nt = K / BK;
    int ts_lo = 0, ts_hi = 0, nts = 0; const unsigned long long rt_entry = STAMP ? (unsigned long long)wall_clock64() : 0ull;
#define PG8_STAMP() do { if (STAMP && wid == 0 && nts < 64) { const unsigned long long _c = (unsigned long long)clock64(); \
        ts_lo = (lane == nts) ? (int)(unsigned)_c : ts_lo; ts_hi = (lane == nts) ? (int)(unsigned)(_c >> 32) : ts_hi; ++nts; } } while (0)
    PG8_STAMP();
    unsigned voffA[2], voffB[2];
#pragma unroll
    for (int i = 0; i < 2; ++i) { int R, C; stage_rc(tid * 16 + i * 8192, R, C); const int Rb = Epi::PERM ? ((R & ~31) + perm32(R & 31)) : R;
        voffA[i] = (unsigned)(R * K + C) * 2u; voffB[i] = (unsigned)(Rb * K + C) * 2u; }
    const size_t kstep = (size_t)(BK * 2);
    const size_t hstep = (size_t)HALF * K * 2;
    const size_t tstep = 2 * hstep;
    const unsigned ldsw = (unsigned)wid * 1024u;
    const int aoff = lds_byte(wr * 64 + fr, fq * 8), boff = lds_byte(wc * 32 + fr, fq * 8);
#define PG8_SA(b, h) (((b) * 2 + (h)) * HTB)
#define PG8_SB(b, h) ((4 + (b) * 2 + (h)) * HTB)
#define PG8_STAGE(bufoff, gbase, voff) do { _Pragma("unroll") for (int _i = 0; _i < 2; ++_i) \
        __builtin_amdgcn_global_load_lds((const unsigned*)((const char*)(gbase) + (voff)[_i]), (PG8_LAS unsigned*)(lds + (bufoff) + ldsw + _i * 8192), 16, 0, 0); } while (0)
#define PG8_LDA(dst, b, h) do { _Pragma("unroll") for (int m = 0; m < 4; ++m) _Pragma("unroll") for (int k = 0; k < 2; ++k) dst[m][k] = *(const PG8_LAS bf16x8*)(lds + PG8_SA(b, h) + aoff + m * 2048 + k * 1024); } while (0)
#define PG8_LDB(dst, b, h) do { _Pragma("unroll") for (int n = 0; n < 2; ++n) _Pragma("unroll") for (int k = 0; k < 2; ++k) dst[n][k] = *(const PG8_LAS bf16x8*)(lds + PG8_SB(b, h) + boff + n * 2048 + k * 1024); } while (0)
#define PG8_MMA(ai, bj, At, Bt) do { __builtin_amdgcn_s_setprio(1); _Pragma("unroll") for (int m = 0; m < 4; ++m) _Pragma("unroll") for (int n = 0; n < 2; ++n) _Pragma("unroll") for (int k = 0; k < 2; ++k) \
        acc[ai][bj][m][n] = __builtin_amdgcn_mfma_f32_16x16x32_bf16(Bt[n][k], At[m][k], acc[ai][bj][m][n], 0, 0, 0); __builtin_amdgcn_s_setprio(0); } while (0)
#define PG8_WAIT_V(n) asm volatile("s_waitcnt vmcnt(" #n ")" ::: "memory")
#define PG8_WAIT_L(n) asm volatile("s_waitcnt lgkmcnt(" #n ")" ::: "memory")
#define PG8_BAR __builtin_amdgcn_s_barrier()
#define PG8_SCHED __builtin_amdgcn_sched_barrier(0)
    Unit cur, nxt; int ui = 0;
    if (!S.next(0, cur)) return;
    f32x4 acc[2][2][4][2];
#pragma unroll
    for (int a = 0; a < 2; ++a)
#pragma unroll
        for (int b = 0; b < 2; ++b)
#pragma unroll
            for (int m = 0; m < 4; ++m)
#pragma unroll
                for (int n = 0; n < 2; ++n) acc[a][b][m][n] = (f32x4){0.f, 0.f, 0.f, 0.f};
    bf16x8 At[4][2], B0[2][2], B1[2][2];
    const char* cA = (const char*)g.A + (size_t)cur.pm * tstep; const char* cB = (const char*)g.Bt + (size_t)cur.pn * tstep;
    S.a_ready(cur);
    PG8_STAGE(PG8_SB(0, 0), cB, voffB); PG8_STAGE(PG8_SA(0, 0), cA, voffA); PG8_STAGE(PG8_SB(0, 1), cB + hstep, voffB); PG8_STAGE(PG8_SA(0, 1), cA + hstep, voffA);
    if (wr == 1) PG8_BAR;
    PG8_WAIT_V(4); PG8_BAR;
    PG8_STAGE(PG8_SB(1, 0), cB + kstep, voffB); PG8_STAGE(PG8_SA(1, 0), cA + kstep, voffA); PG8_STAGE(PG8_SB(1, 1), cB + hstep + kstep, voffB);
    PG8_WAIT_V(6); PG8_BAR;
    PG8_STAMP();
    for (;;) {
        const bool has_next = S.next(ui + 1, nxt);
        const char* nA = has_next ? (const char*)g.A + (size_t)nxt.pm * tstep : cA; const char* nB = has_next ? (const char*)g.Bt + (size_t)nxt.pn * tstep : cB;
        for (int t = 0; t < nt; t += 2) {
            const bool last = (t == nt - 2);
            const char* a1 = cA + (size_t)(t + 1) * kstep;
            const char* a2 = last ? nA : cA + (size_t)(t + 2) * kstep; const char* b2 = last ? nB : cB + (size_t)(t + 2) * kstep;
            const char* a3 = a2 + kstep; const char* b3 = b2 + kstep;
            if (last && has_next) S.a_ready(nxt);
            PG8_LDB(B0, 0, 0); PG8_SCHED; PG8_LDA(At, 0, 0); PG8_STAGE(PG8_SA(1, 1), a1 + hstep, voffA);
            PG8_WAIT_L(8); PG8_BAR; PG8_WAIT_L(0); PG8_MMA(0, 0, At, B0); PG8_BAR; PG8_SCHED;
            PG8_LDB(B1, 0, 1); PG8_STAGE(PG8_SB(0, 0), b2, voffB);
            PG8_BAR; PG8_WAIT_L(0); PG8_MMA(0, 1, At, B1); PG8_BAR;
            PG8_LDA(At, 0, 1); PG8_STAGE(PG8_SA(0, 0), a2, voffA);
            PG8_BAR; PG8_WAIT_L(0); PG8_MMA(1, 0, At, B0); PG8_BAR; PG8_SCHED;
            PG8_STAGE(PG8_SB(0, 1), b2 + hstep, voffB);
            PG8_WAIT_V(6); PG8_BAR; PG8_MMA(1, 1, At, B1); PG8_BAR;
            PG8_LDB(B0, 1, 0); PG8_SCHED; PG8_LDA(At, 1, 0); PG8_STAGE(PG8_SA(0, 1), a2 + hstep, voffA);
            PG8_WAIT_L(8); PG8_BAR; PG8_WAIT_L(0); PG8_MMA(0, 0, At, B0); PG8_BAR; PG8_SCHED;
            PG8_LDB(B1, 1, 1); PG8_STAGE(PG8_SB(1, 0), b3, voffB);
            PG8_BAR; PG8_WAIT_L(0); PG8_MMA(0, 1, At, B1); PG8_BAR;
            PG8_LDA(At, 1, 1); PG8_STAGE(PG8_SA(1, 0), a3, voffA);
            PG8_BAR; PG8_WAIT_L(0); PG8_MMA(1, 0, At, B0); PG8_BAR; PG8_SCHED;
            PG8_STAGE(PG8_SB(1, 1), b3 + hstep, voffB);
            PG8_WAIT_V(6); PG8_BAR; PG8_MMA(1, 1, At, B1); PG8_BAR;
        }
        PG8_STAMP();
        if constexpr (!Epi::AFTER_DRAIN) { E(acc, cur, wr, wc, fr, fq); S.done(cur); }
        PG8_STAMP();
        if (!has_next) break;
#pragma unroll
        for (int a = 0; a < 2; ++a)
#pragma unroll
            for (int b = 0; b < 2; ++b)
#pragma unroll
                for (int m = 0; m < 4; ++m)
#pragma unroll
                    for (int n = 0; n < 2; ++n) acc[a][b][m][n] = (f32x4){0.f, 0.f, 0.f, 0.f};
        cur = nxt; cA = nA; cB = nB; ++ui;
    }
    PG8_WAIT_V(0);
    if (wr == 0) PG8_BAR;
    PG8_BAR;
    if constexpr (Epi::AFTER_DRAIN) { E.fused(acc, cur, wr, wc, fr, fq, lds, wid, lane); S.done(cur); }
    PG8_STAMP();
    if (STAMP && wid == 0) { stamps[lane] = lane < nts ? (((unsigned long long)(unsigned)ts_hi << 32) | (unsigned)ts_lo) : 0ull;
        if (lane == 62) stamps[62] = rt_entry; if (lane == 63) stamps[63] = (unsigned long long)wall_clock64(); }
#undef PG8_STAMP
#undef PG8_SA
#undef PG8_SB
#undef PG8_STAGE
#undef PG8_LDA
#undef PG8_LDB
#undef PG8_MMA
#undef PG8_WAIT_V
#undef PG8_WAIT_L
#undef PG8_BAR
#undef PG8_SCHED
}
}
namespace sel {
#define SEL_HD __host__ __device__ __forceinline__
#if defined(__HIP_DEVICE_COMPILE__)
SEL_HD int imax(int a, int b) { int r; asm("v_max_f32 %0, %1, %2" : "=v"(r) : "v"(a), "v"(b)); return r; }
SEL_HD int imin(int a, int b) { int r; asm("v_min_f32 %0, %1, %2" : "=v"(r) : "v"(a), "v"(b)); return r; }
#else
SEL_HD int imax(int a, int b) { return __builtin_bit_cast(int, __builtin_fmaxf(__builtin_bit_cast(float, a), __builtin_bit_cast(float, b))); }
SEL_HD int imin(int a, int b) { return __builtin_bit_cast(int, __builtin_fminf(__builtin_bit_cast(float, a), __builtin_bit_cast(float, b))); }
#endif
constexpr int SEL_PAD = (int)0xff800000;
SEL_HD int f2key(float f) { return __builtin_bit_cast(int, f); }
SEL_HD float key2f(int k) { return __builtin_bit_cast(float, k); }
#define SEL_CE(i, j) do { const int hi_ = imax(a[i], a[j]), lo_ = imin(a[i], a[j]); a[i] = hi_; a[j] = lo_; } while (0)
template <int N> SEL_HD void sort_desc(int (&a)[N]) {
    if constexpr (N == 16) {
        SEL_CE(0,13); SEL_CE(1,12); SEL_CE(2,15); SEL_CE(3,14); SEL_CE(4,8); SEL_CE(5,6); SEL_CE(7,11); SEL_CE(9,10);
        SEL_CE(0,5); SEL_CE(1,7); SEL_CE(2,9); SEL_CE(3,4); SEL_CE(6,13); SEL_CE(8,14); SEL_CE(10,15); SEL_CE(11,12);
        SEL_CE(0,1); SEL_CE(2,3); SEL_CE(4,5); SEL_CE(6,8); SEL_CE(7,9); SEL_CE(10,11); SEL_CE(12,13); SEL_CE(14,15);
        SEL_CE(0,2); SEL_CE(1,3); SEL_CE(4,10); SEL_CE(5,11); SEL_CE(6,7); SEL_CE(8,9); SEL_CE(12,14); SEL_CE(13,15);
        SEL_CE(1,2); SEL_CE(3,12); SEL_CE(4,6); SEL_CE(5,7); SEL_CE(8,10); SEL_CE(9,11); SEL_CE(13,14);
        SEL_CE(1,4); SEL_CE(2,6); SEL_CE(5,8); SEL_CE(7,10); SEL_CE(9,13); SEL_CE(11,14);
        SEL_CE(2,4); SEL_CE(3,6); SEL_CE(9,12); SEL_CE(11,13);
        SEL_CE(3,5); SEL_CE(6,8); SEL_CE(7,9); SEL_CE(10,12);
        SEL_CE(3,4); SEL_CE(5,6); SEL_CE(7,8); SEL_CE(9,10); SEL_CE(11,12);
        SEL_CE(6,7); SEL_CE(8,9);
        return;
    }
#pragma unroll
    for (int k = 2; k <= N; k <<= 1) {
#pragma unroll
        for (int j = k >> 1; j > 0; j >>= 1) {
#pragma unroll
            for (int i = 0; i < N; ++i) {
                const int l = i ^ j;
                if (l > i) { const bool desc = ((i & k) == 0); const int hi = imax(a[i], a[l]), lo = imin(a[i], a[l]); a[i] = desc ? hi : lo; a[l] = desc ? lo : hi; }
            }
        }
    }
}
SEL_HD void merge_desc16(int (&a)[16]) {
#pragma unroll
    for (int j = 8; j > 0; j >>= 1) {
#pragma unroll
        for (int i = 0; i < 16; ++i) { const int l = i ^ j; if (l > i) { const int hi = imax(a[i], a[l]), lo = imin(a[i], a[l]); a[i] = hi; a[l] = lo; } }
    }
}
SEL_HD void top16_merge(int (&a)[16], const int (&b)[16]) {
#pragma unroll
    for (int i = 0; i < 16; ++i) a[i] = imax(a[i], b[15 - i]);
    merge_desc16(a);
}
SEL_HD void cand_top16(const int (&a)[16], const int (&b)[16], int (&c0)[16], float scale = 1.0f  ) {
    float av[16], bv[16];
#pragma unroll
    for (int i = 0; i < 16; ++i) { av[i] = key2f(a[i] & ~127) * scale; bv[i] = key2f(b[i] & ~127) * scale; }
    int c1[16], c2[16]; int x0 = SEL_PAD, x1 = SEL_PAD;
    {
        int n = 0;
#pragma unroll
        for (int i = 0; i < 16; ++i) {
#pragma unroll
            for (int j = 0; j < 16; ++j) {
                if ((i + 1) * (j + 1) <= 16) {
                    const int key = (f2key(av[i] + bv[j]) & ~255) | (i << 4) | j;
                    if (n < 16) c0[n & 15] = key; else if (n < 32) c1[n & 15] = key; else if (n < 48) c2[n & 15] = key; else if (n == 48) x0 = key; else x1 = key;
                    ++n;
                }
            }
        }
    }
    sort_desc(c0); sort_desc(c1); sort_desc(c2);
    { const int xh = imax(x0, x1), xl = imin(x0, x1);
      c2[14] = imax(c2[14], xl); c2[15] = imax(c2[15], xh); merge_desc16(c2); }
    top16_merge(c0, c1); top16_merge(c0, c2);
}
}
namespace att {
using bf16 = unsigned short;
constexpr int   D = 128, NW = 8, QBLK = 32, KVBLK = 64;
constexpr float SCALE = 0.088388347648318440f;
constexpr float THR = 8.f;
constexpr size_t SHM_V = KVBLK * D * 2, SHM_K = KVBLK * D * 2, SHM_ATTN = 2 * SHM_V + 2 * SHM_K + NW * 64 * 4;
constexpr size_t SHM_NA_BIAS = SHM_ATTN;
using bf16x8 = __attribute__((ext_vector_type(8))) short;
using s16x4  = __attribute__((ext_vector_type(4))) short;
using f32x16 = __attribute__((ext_vector_type(16))) float;
using u32x4  = __attribute__((ext_vector_type(4))) unsigned;
#define KSWZ(row, colB) ((row) * 256 + ((colB) ^ (((row) & 7) << 4)))
#define SBAR() __builtin_amdgcn_sched_barrier(0)
__device__ __forceinline__ int crow(int r, int hi) { return (r & 3) + 8 * (r >> 2) + 4 * hi; }
__device__ __forceinline__ unsigned cvtpk(float lo, float hi) { unsigned r; asm volatile("v_cvt_pk_bf16_f32 %0, %1, %2" : "=v"(r) : "v"(lo), "v"(hi)); return r; }
__device__ __forceinline__ bf16x8 ld8(const bf16* p) { return *reinterpret_cast<const bf16x8*>(p); }

__device__ __forceinline__ void partialSM(f32x16& p0, f32x16& p1, float& m_reg, float& mn, float& alpha) {
  constexpr float C = SCALE * 1.4426950408889634f;
  float pmax = p0[0]; for (int r = 1; r < 16; ++r) pmax = fmaxf(pmax, p0[r]); for (int r = 0; r < 16; ++r) pmax = fmaxf(pmax, p1[r]);
  { auto rr = __builtin_amdgcn_permlane32_swap(__float_as_uint(pmax), __float_as_uint(pmax), false, false);
    pmax = fmaxf(__uint_as_float(rr[0]), __uint_as_float(rr[1])); }
  if (__builtin_expect(__all(pmax - m_reg <= THR / SCALE), 1)) { mn = m_reg; alpha = 1.f; }
  else { mn = fmaxf(m_reg, pmax); alpha = __builtin_amdgcn_exp2f((m_reg - mn) * C); m_reg = mn; }
  float mnC = -mn * C;
  for (int r = 0; r < 16; ++r) p0[r] = fmaf(p0[r], C, mnC); for (int r = 0; r < 16; ++r) p1[r] = fmaf(p1[r], C, mnC);
  for (int r = 0; r < 16; ++r) p0[r] = __builtin_amdgcn_exp2f(p0[r]);
}
__device__ __forceinline__ void partialSM_fix(f32x16& p0, f32x16& p1, float negMC) {
  constexpr float C = SCALE * 1.4426950408889634f;
  for (int r = 0; r < 16; ++r) p0[r] = fmaf(p0[r], C, negMC); for (int r = 0; r < 16; ++r) p1[r] = fmaf(p1[r], C, negMC);
  for (int r = 0; r < 16; ++r) p0[r] = __builtin_amdgcn_exp2f(p0[r]);
}
__device__ __forceinline__ void partialSM_na(f32x16& p0, f32x16& p1, float& m_reg, float& mn, float& alpha, const float* brow, bool rowok, int c, int cs, int hi) {
  constexpr float C = SCALE * 1.4426950408889634f;
  const float ninf = -__builtin_inff();
#pragma unroll
  for (int r = 0; r < 16; ++r) {
    const int kc0 = crow(r, hi), kc1 = 32 + kc0;
    const bool ok0 = rowok && ((unsigned)(kc0 - cs) < 16u), ok1 = rowok && ((unsigned)(kc1 - cs) < 16u);
    const int d0 = ok0 ? (kc0 - c + 15) : 0, d1 = ok1 ? (kc1 - c + 15) : 0;
    const float b0 = brow[d0], b1 = brow[d1];
    p0[r] = ok0 ? fmaf(p0[r], C, b0) : ninf;
    p1[r] = ok1 ? fmaf(p1[r], C, b1) : ninf;
  }
  float pmax = p0[0]; for (int r = 1; r < 16; ++r) pmax = fmaxf(pmax, p0[r]); for (int r = 0; r < 16; ++r) pmax = fmaxf(pmax, p1[r]);
  { auto rr = __builtin_amdgcn_permlane32_swap(__float_as_uint(pmax), __float_as_uint(pmax), false, false);
    pmax = fmaxf(__uint_as_float(rr[0]), __uint_as_float(rr[1])); }
  if (__all(pmax - m_reg <= THR * 1.4426950408889634f)) { mn = m_reg; alpha = 1.f; }
  else { mn = fmaxf(m_reg, pmax); alpha = __builtin_amdgcn_exp2f(m_reg - mn); m_reg = mn; }
  for (int r = 0; r < 16; ++r) p0[r] = p0[r] - mn; for (int r = 0; r < 16; ++r) p1[r] = p1[r] - mn;
  for (int r = 0; r < 16; ++r) p0[r] = __builtin_amdgcn_exp2f(p0[r]);
}
__device__ __forceinline__ void finishSM(f32x16& p0, f32x16& p1, float alpha, float& l_reg, bf16x8& pa0, bf16x8& pa1, bf16x8& pa2, bf16x8& pa3) {
  for (int r = 0; r < 16; ++r) p1[r] = __builtin_amdgcn_exp2f(p1[r]);
  float ps = 0; for (int r = 0; r < 16; ++r) ps += p0[r]; for (int r = 0; r < 16; ++r) ps += p1[r];
  { auto rr = __builtin_amdgcn_permlane32_swap(__float_as_uint(ps), __float_as_uint(ps), false, false);
    ps = __uint_as_float(rr[0]) + __uint_as_float(rr[1]); }
  l_reg = l_reg * alpha + ps;
#define PK4(P, BASE, OUT) do { unsigned a0 = cvtpk(P[BASE + 0], P[BASE + 1]), a1 = cvtpk(P[BASE + 2], P[BASE + 3]);   \
    unsigned b0 = cvtpk(P[BASE + 4], P[BASE + 5]), b1 = cvtpk(P[BASE + 6], P[BASE + 7]);                              \
    auto r0 = __builtin_amdgcn_permlane32_swap(a0, b0, false, false); auto r1 = __builtin_amdgcn_permlane32_swap(a1, b1, false, false); \
    u32x4 w = {r0[0], r1[0], r0[1], r1[1]}; OUT = *reinterpret_cast<bf16x8*>(&w); } while (0)
  PK4(p0, 0, pa0); PK4(p0, 8, pa1); PK4(p1, 0, pa2); PK4(p1, 8, pa3);
#undef PK4
}
__device__ __forceinline__ void qkt(f32x16& p0, f32x16& p1, const bf16* Ks, const bf16x8* qr, int r32, int hi) {
  p0 = f32x16{}; p1 = f32x16{};
  for (int d0 = 0; d0 < 8; ++d0) { int cb = (d0 * 16 + hi * 8) * 2;
    bf16x8 b0 = *reinterpret_cast<const bf16x8*>((const char*)Ks + KSWZ(r32, cb));
    bf16x8 b1 = *reinterpret_cast<const bf16x8*>((const char*)Ks + KSWZ(32 + r32, cb));
    p0 = __builtin_amdgcn_mfma_f32_32x32x16_bf16(b0, qr[d0], p0, 0, 0, 0);
    p1 = __builtin_amdgcn_mfma_f32_32x32x16_bf16(b1, qr[d0], p1, 0, 0, 0); }
}
__device__ __forceinline__ int v_st(int k, int c) { const int kk = (k & ~0xC) | ((k & 4) << 1) | ((k & 8) >> 1); return ((kk >> 3) * 4 + (c >> 5)) * 512 + ((kk & 7) * 32 + (c & 31)) * 2; }
__device__ __forceinline__ int v_rd_base(int lane) { return ((lane & 3) << 3) | (((lane >> 2) & 3) << 6) | (((lane >> 4) & 1) << 5) | (((lane >> 5) & 1) << 8); }
constexpr int v_rd_off(int d0, int ks, int half) { return d0 * 512 + ks * 4096 + half * 2048; }
template <int OFF> __device__ __forceinline__ s16x4 tr_read(int vb) {
  s16x4 r; asm volatile("ds_read_b64_tr_b16 %0, %1 offset:%2" : "=&v"(r) : "v"(vb), "i"(OFF) : "memory"); return r;
}
template <int D0> __device__ __forceinline__ void pv_one(f32x16& od, int vb, bf16x8 pa0, bf16x8 pa1, bf16x8 pa2, bf16x8 pa3) {
  const s16x4 l0 = tr_read<v_rd_off(D0, 0, 0)>(vb), h0 = tr_read<v_rd_off(D0, 0, 1)>(vb), l1 = tr_read<v_rd_off(D0, 1, 0)>(vb), h1 = tr_read<v_rd_off(D0, 1, 1)>(vb);
  const s16x4 l2 = tr_read<v_rd_off(D0, 2, 0)>(vb), h2 = tr_read<v_rd_off(D0, 2, 1)>(vb), l3 = tr_read<v_rd_off(D0, 3, 0)>(vb), h3 = tr_read<v_rd_off(D0, 3, 1)>(vb);
  asm volatile("s_waitcnt lgkmcnt(0)" ::: "memory"); SBAR();
#define PK(L, H) (bf16x8){L[0], L[1], L[2], L[3], H[0], H[1], H[2], H[3]}
  od = __builtin_amdgcn_mfma_f32_32x32x16_bf16(pa0, PK(l0, h0), od, 0, 0, 0);
  od = __builtin_amdgcn_mfma_f32_32x32x16_bf16(pa1, PK(l1, h1), od, 0, 0, 0);
  od = __builtin_amdgcn_mfma_f32_32x32x16_bf16(pa2, PK(l2, h2), od, 0, 0, 0);
  od = __builtin_amdgcn_mfma_f32_32x32x16_bf16(pa3, PK(l3, h3), od, 0, 0, 0);
#undef PK
}
template <int D0, int KS0> __device__ __forceinline__ void pv_half(f32x16& od, int vb, bf16x8 pa, bf16x8 pb) {
  const s16x4 l0 = tr_read<v_rd_off(D0, KS0, 0)>(vb), h0 = tr_read<v_rd_off(D0, KS0, 1)>(vb), l1 = tr_read<v_rd_off(D0, KS0 + 1, 0)>(vb), h1 = tr_read<v_rd_off(D0, KS0 + 1, 1)>(vb);
  asm volatile("s_waitcnt lgkmcnt(0)" ::: "memory"); SBAR();
#define PK(L, H) (bf16x8){L[0], L[1], L[2], L[3], H[0], H[1], H[2], H[3]}
  od = __builtin_amdgcn_mfma_f32_32x32x16_bf16(pa, PK(l0, h0), od, 0, 0, 0);
  od = __builtin_amdgcn_mfma_f32_32x32x16_bf16(pb, PK(l1, h1), od, 0, 0, 0);
#undef PK
}
__device__ __forceinline__ void pv_d0h(f32x16* o, int vb, bf16x8 pa0, bf16x8 pa1, bf16x8 pa2, bf16x8 pa3) {
  pv_half<0, 0>(o[0], vb, pa0, pa1); pv_half<0, 2>(o[0], vb, pa2, pa3); pv_half<1, 0>(o[1], vb, pa0, pa1); pv_half<1, 2>(o[1], vb, pa2, pa3);
  pv_half<2, 0>(o[2], vb, pa0, pa1); pv_half<2, 2>(o[2], vb, pa2, pa3); pv_half<3, 0>(o[3], vb, pa0, pa1); pv_half<3, 2>(o[3], vb, pa2, pa3);
}
constexpr int pvw_off(int n, int dk, int hf) { return (n >> 3) * 16384 + v_rd_off((n >> 1) & 3, (n & 1) * 2 + dk, hf); }
#define PVW_RD(n, L0, H0, L1, H1) do { L0 = tr_read<pvw_off(n, 0, 0)>(vb); H0 = tr_read<pvw_off(n, 0, 1)>(vb); L1 = tr_read<pvw_off(n, 1, 0)>(vb); H1 = tr_read<pvw_off(n, 1, 1)>(vb); } while (0)
#define PVW_PK(L, H) (bf16x8){L[0], L[1], L[2], L[3], H[0], H[1], H[2], H[3]}
#define PVW_MM(n, L0, H0, L1, H1) do { f32x16& od_ = o[((n) >> 3) * 4 + (((n) >> 1) & 3)]; \
    od_ = __builtin_amdgcn_mfma_f32_32x32x16_bf16(((n) & 1) ? pa2 : pa0, PVW_PK(L0, H0), od_, 0, 0, 0); \
    od_ = __builtin_amdgcn_mfma_f32_32x32x16_bf16(((n) & 1) ? pa3 : pa1, PVW_PK(L1, H1), od_, 0, 0, 0); } while (0)
#define PVW_STEP(n, CL0, CH0, CL1, CH1, NL0, NH0, NL1, NH1) do { PVW_RD((n) + 1, NL0, NH0, NL1, NH1); asm volatile("s_waitcnt lgkmcnt(4)" ::: "memory"); SBAR(); PVW_MM(n, CL0, CH0, CL1, CH1); SBAR(); } while (0)
__device__ __forceinline__ void pv_wide(f32x16* o, int vb, bf16x8 pa0, bf16x8 pa1, bf16x8 pa2, bf16x8 pa3) {
  s16x4 a0, a1, a2, a3, b0, b1, b2, b3;
  PVW_RD(0, a0, a1, a2, a3);
  PVW_STEP(0, a0, a1, a2, a3, b0, b1, b2, b3);  PVW_STEP(1, b0, b1, b2, b3, a0, a1, a2, a3);
  PVW_STEP(2, a0, a1, a2, a3, b0, b1, b2, b3);  PVW_STEP(3, b0, b1, b2, b3, a0, a1, a2, a3);
  PVW_STEP(4, a0, a1, a2, a3, b0, b1, b2, b3);  PVW_STEP(5, b0, b1, b2, b3, a0, a1, a2, a3);
  PVW_STEP(6, a0, a1, a2, a3, b0, b1, b2, b3);  PVW_STEP(7, b0, b1, b2, b3, a0, a1, a2, a3);
  PVW_STEP(8, a0, a1, a2, a3, b0, b1, b2, b3);  PVW_STEP(9, b0, b1, b2, b3, a0, a1, a2, a3);
  PVW_STEP(10, a0, a1, a2, a3, b0, b1, b2, b3); PVW_STEP(11, b0, b1, b2, b3, a0, a1, a2, a3);
  PVW_STEP(12, a0, a1, a2, a3, b0, b1, b2, b3); PVW_STEP(13, b0, b1, b2, b3, a0, a1, a2, a3);
  PVW_STEP(14, a0, a1, a2, a3, b0, b1, b2, b3);
  asm volatile("s_waitcnt lgkmcnt(0)" ::: "memory"); SBAR(); PVW_MM(15, b0, b1, b2, b3);
}
__device__ __forceinline__ void pv_d0(f32x16* o, int vb, bf16x8 pa0, bf16x8 pa1, bf16x8 pa2, bf16x8 pa3) {
  pv_one<0>(o[0], vb, pa0, pa1, pa2, pa3); pv_one<1>(o[1], vb, pa0, pa1, pa2, pa3); pv_one<2>(o[2], vb, pa0, pa1, pa2, pa3); pv_one<3>(o[3], vb, pa0, pa1, pa2, pa3);
}

template <int MODE, int SDEPTH, int LDQ, int LDK, int LDV, int LDO, bool OBF>
__device__ __forceinline__ void attn_body(const bf16* __restrict__ Qb, const bf16* __restrict__ Kh, const bf16* __restrict__ Vh,
                                          void* __restrict__ Obv, int seq, char* lds, int r0, int kr0, float negMC, int tid_in) {
  int tid_ = tid_in; asm volatile("" : "+v"(tid_));
  const int tid = tid_, wid = tid >> 6, lane = tid & 63, r32 = lane & 31, hi = lane >> 5;
  bf16* V_lds = (bf16*)lds; bf16* K_lds = (bf16*)(lds + 2 * SHM_V);
  float* ws = (float*)(lds + 2 * SHM_V + 2 * SHM_K) + wid * 64; float* li_l = ws; float* al_l = ws + 32;
  const float* blds = (const float*)(lds + SHM_NA_BIAS);
  float m_reg = -1e30f, l_reg = 0; f32x16 o[4] = {}; bf16x8 qr[8];
  const bf16* Qw = Qb + (long)(wid * QBLK + r32) * LDQ + hi * 8;
#pragma unroll
  for (int d0 = 0; d0 < 8; ++d0) qr[d0] = ld8(Qw + d0 * 16);
  const int qrow = r0 + (wid >> 1), qc = (wid & 1) * 32 + r32;
  const int rs = min(max(qrow - 4, 0), 56), cs = min(max(qc - 8, 0), 48);
  const int sr = tid >> 4, sc = (tid & 15) * 8, vst0 = v_st(sr, sc), vst1 = v_st(32 + sr, sc);
  const int vb0 = (int)(uintptr_t)V_lds + v_rd_base(lane);
  struct { bf16x8 vs0, vs1, ks0, ks1; } sr_[SDEPTH];
  const unsigned koff0 = (unsigned)(sr * LDK + sc) * 2u, koff1 = (unsigned)((32 + sr) * LDK + sc) * 2u, voff0 = (unsigned)(sr * LDV + sc) * 2u, voff1 = (unsigned)((32 + sr) * LDV + sc) * 2u;
#define SLOAD(i, k0) do { const char* kt_ = (const char*)Kh + (size_t)(k0) * (LDK * 2); const char* vt_ = (const char*)Vh + (size_t)(k0) * (LDV * 2); \
    sr_[i].vs0 = *(const bf16x8*)(vt_ + voff0); sr_[i].vs1 = *(const bf16x8*)(vt_ + voff1); \
    sr_[i].ks0 = *(const bf16x8*)(kt_ + koff0); sr_[i].ks1 = *(const bf16x8*)(kt_ + koff1); } while (0)
#define SWRITE(b, i) do { *(bf16x8*)((char*)V_lds + (b) * SHM_V + vst0) = sr_[i].vs0;          \
    *(bf16x8*)((char*)V_lds + (b) * SHM_V + vst1) = sr_[i].vs1; int kc = sc * 2;               \
    *(bf16x8*)((char*)K_lds + (b) * SHM_K + KSWZ(sr, kc)) = sr_[i].ks0;                       \
    *(bf16x8*)((char*)K_lds + (b) * SHM_K + KSWZ(32 + sr, kc)) = sr_[i].ks1; } while (0)
#define SWAIT() do { if constexpr (SDEPTH == 2) asm volatile("s_waitcnt vmcnt(4)" ::: "memory"); else asm volatile("s_waitcnt vmcnt(0)" ::: "memory"); } while (0)
#define RESC(a) do { if constexpr (MODE == 1) if (__any((a) < 1.f)) { if (hi == 0) al_l[r32] = (a); asm volatile("s_waitcnt lgkmcnt(0)" ::: "memory"); \
    for (int d = 0; d < 4; ++d) for (int r = 0; r < 16; ++r) o[d][r] *= al_l[crow(r, hi)]; } } while (0)
#define PSM(P0, P1, MN, AL, J) do { if constexpr (MODE == 0) { partialSM_fix(P0, P1, negMC); AL = 1.f; } else { const int kr_ = kr0 + (J); const bool ok_ = (kr_ >= rs) && (kr_ < rs + 8); \
    const int dr_ = ok_ ? (kr_ - qrow + 7) : 0; partialSM_na(P0, P1, m_reg, MN, AL, blds + dr_ * 31, ok_, qc, cs, hi); } } while (0)
  f32x16 pA0, pA1, pB0, pB1; float mnA, mnB, alA, alB; bf16x8 pa0, pa1, pa2, pa3; const int NT = seq / KVBLK;
  if constexpr (MODE == 1) {
    SLOAD(0, 0);
    for (int j = 0; j < NT; ++j) {
      asm volatile("s_waitcnt vmcnt(0)" ::: "memory"); SWRITE(j & 1, 0);
      if (j + 1 < NT) SLOAD(0, (j + 1) * KVBLK);
      __syncthreads();
      SBAR(); qkt(pA0, pA1, (bf16*)((char*)K_lds + (j & 1) * SHM_K), qr, r32, hi);
      PSM(pA0, pA1, mnA, alA, j); RESC(alA);
      finishSM(pA0, pA1, alA, l_reg, pa0, pa1, pa2, pa3); SBAR();
      pv_d0(o, vb0 + (j & 1) * (int)SHM_V, pa0, pa1, pa2, pa3);
    }
  } else {
  constexpr int SE = 0, SO = SDEPTH - 1;
  SLOAD(SE, 0); asm volatile("s_waitcnt vmcnt(0)" ::: "memory"); SWRITE(0, SE); __syncthreads();
  qkt(pA0, pA1, K_lds, qr, r32, hi); PSM(pA0, pA1, mnA, alA, 0);
  SLOAD(SO, KVBLK); if constexpr (SDEPTH == 2) { if (2 < NT) SLOAD(SE, 2 * KVBLK); }
  SWAIT(); SWRITE(1, SO); __syncthreads();
  for (int j = 1; j + 1 < NT; j += 2) {
    SBAR(); qkt(pB0, pB1, (bf16*)((char*)K_lds + SHM_K), qr, r32, hi);
    finishSM(pA0, pA1, alA, l_reg, pa0, pa1, pa2, pa3); SBAR();
    SLOAD(SO, (j + SDEPTH) * KVBLK); SBAR();
    pv_d0(o, vb0, pa0, pa1, pa2, pa3); PSM(pB0, pB1, mnB, alB, j);
    __syncthreads(); SWAIT(); SWRITE(0, SE);
    RESC(alB); __syncthreads();
    SBAR(); qkt(pA0, pA1, K_lds, qr, r32, hi);
    finishSM(pB0, pB1, alB, l_reg, pa0, pa1, pa2, pa3); SBAR();
    if (SDEPTH == 1 || j + 3 < NT) SLOAD(SE, (j + 1 + SDEPTH) * KVBLK); SBAR();
    pv_d0(o, vb0 + (int)SHM_V, pa0, pa1, pa2, pa3); PSM(pA0, pA1, mnA, alA, j + 1);
    __syncthreads(); SWAIT(); SWRITE(1, SO);
    RESC(alA); __syncthreads();
  }
  SBAR(); qkt(pB0, pB1, (bf16*)((char*)K_lds + SHM_K), qr, r32, hi);
  finishSM(pA0, pA1, alA, l_reg, pa0, pa1, pa2, pa3); SBAR();
  pv_d0(o, vb0, pa0, pa1, pa2, pa3); PSM(pB0, pB1, mnB, alB, NT - 1);
  __syncthreads(); RESC(alB);
  finishSM(pB0, pB1, alB, l_reg, pa0, pa1, pa2, pa3); SBAR();
  pv_d0(o, vb0 + (int)SHM_V, pa0, pa1, pa2, pa3);
  }
  if (hi == 0) li_l[r32] = l_reg; asm volatile("s_waitcnt lgkmcnt(0)" ::: "memory");
  float rli[16];
#pragma unroll
  for (int r = 0; r < 16; ++r) rli[r] = __builtin_amdgcn_rcpf(li_l[crow(r, hi)]);
  if constexpr (OBF) {
    bf16* Ow = (bf16*)Obv + (long)(wid * QBLK) * LDO;
#pragma unroll
    for (int r = 0; r < 16; ++r) { int orow = crow(r, hi);
      for (int d0 = 0; d0 < 4; ++d0) Ow[(long)orow * LDO + d0 * 32 + r32] = (bf16)(cvtpk(o[d0][r] * rli[r], 0.f) & 0xffffu); }
  } else {
    float* Ow = (float*)Obv + (long)(wid * QBLK) * LDO;
#pragma unroll
    for (int r = 0; r < 16; ++r) { int orow = crow(r, hi);
      for (int d0 = 0; d0 < 4; ++d0) Ow[(long)orow * LDO + d0 * 32 + r32] = o[d0][r] * rli[r]; }
  }
#undef SLOAD
#undef SWRITE
#undef SWAIT
#undef RESC
#undef PSM
}

#define ATT_LAS __attribute__((address_space(3)))
constexpr int WIDE_K_OFF = 0, WIDE_V_OFF = 49152, WIDE_RING_BYTES = 147456, WIDE_WS_OFF = 156672, WIDE_LDS_BYTES = WIDE_WS_OFF + NW * 256;
template <int LDQ, int LDK, int LDV, int LDO>
__device__ __forceinline__ void attn_wide_body(const bf16* __restrict__ Qb, const bf16* __restrict__ Kh, const bf16* __restrict__ Vh, bf16* __restrict__ Ob, int seq,
                                               ATT_LAS unsigned char* ldsl, char* lds, float negMC, int tid_in) {
  int tid_ = tid_in; asm volatile("" : "+v"(tid_));
  const int tid = tid_, wid = __builtin_amdgcn_readfirstlane(tid >> 6), lane = tid & 63, r32 = lane & 31, hi = lane >> 5;
  float* li_l = (float*)(lds + WIDE_WS_OFF) + wid * 64;
  float l_reg = 0; f32x16 o[8] = {}; bf16x8 qr[8];
  const bf16* Qw = Qb + (long)(wid * QBLK + r32) * LDQ + hi * 8;
#pragma unroll
  for (int d0 = 0; d0 < 8; ++d0) qr[d0] = ld8(Qw + d0 * 16);
#define WSRC() unsigned ksrc[2], vsrc[4]; { int ln = lane; asm volatile("" : "+v"(ln)); \
  _Pragma("unroll") for (int i = 0; i < 2; ++i) { const int p = wid * 2 + i, row = 4 * p + (ln >> 4), cc = (ln & 15) ^ (row & 7); ksrc[i] = (unsigned)(row * LDK * 2 + cc * 16); } \
  _Pragma("unroll") for (int i = 0; i < 4; ++i) { const int P = wid * 4 + i, hf = P >> 4, p = P & 15, j = p * 64 + ln, st = j >> 5, within = j & 31; \
    const int kk = (st >> 2) * 8 + (within >> 2), c = (st & 3) * 32 + (within & 3) * 8, k = (kk & ~0xC) | ((kk & 4) << 1) | ((kk & 8) >> 1); \
    vsrc[i] = (unsigned)(k * LDV * 2 + (hf * 128 + c) * 2); } }
  const int vb0 = (int)(uintptr_t)(lds + WIDE_V_OFF) + v_rd_base(lane);
#define WDMA(T, B) do { WSRC(); const char* kt_ = (const char*)Kh + (size_t)(T) * (KVBLK * LDK * 2); const char* vt_ = (const char*)Vh + (size_t)(T) * (KVBLK * LDV * 2); \
    _Pragma("unroll") for (int i_ = 0; i_ < 2; ++i_) __builtin_amdgcn_global_load_lds((const unsigned*)(kt_ + ksrc[i_]), (ATT_LAS unsigned*)(ldsl + WIDE_K_OFF + (B) * 16384 + (wid * 2 + i_) * 1024), 16, 0, 0); \
    _Pragma("unroll") for (int i_ = 0; i_ < 4; ++i_) __builtin_amdgcn_global_load_lds((const unsigned*)(vt_ + vsrc[i_]), (ATT_LAS unsigned*)(ldsl + WIDE_V_OFF + (B) * 32768 + (wid * 4 + i_) * 1024), 16, 0, 0); } while (0)
  const int NT = seq / KVBLK;
  f32x16 p0, p1; bf16x8 pa0, pa1, pa2, pa3;
#undef WDMA
#define WDMA(T, SL) do { WSRC(); const char* kt_ = (const char*)Kh + (size_t)(T) * (KVBLK * LDK * 2); const char* vt_ = (const char*)Vh + (size_t)(T) * (KVBLK * LDV * 2); \
    _Pragma("unroll") for (int i_ = 0; i_ < 2; ++i_) __builtin_amdgcn_global_load_lds((const unsigned*)(kt_ + ksrc[i_]), (ATT_LAS unsigned*)(ldsl + WIDE_K_OFF + (SL) * 16384 + (wid * 2 + i_) * 1024), 16, 0, 0); \
    _Pragma("unroll") for (int i_ = 0; i_ < 4; ++i_) __builtin_amdgcn_global_load_lds((const unsigned*)(vt_ + vsrc[i_]), (ATT_LAS unsigned*)(ldsl + WIDE_V_OFF + (SL) * 32768 + (wid * 4 + i_) * 1024), 16, 0, 0); } while (0)
#define WQKSM(SL) do { SBAR(); __builtin_amdgcn_s_setprio(1); qkt(p0, p1, (const bf16*)(lds + WIDE_K_OFF + (SL) * 16384), qr, r32, hi); __builtin_amdgcn_s_setprio(0); partialSM_fix(p0, p1, negMC); finishSM(p0, p1, 1.f, l_reg, pa0, pa1, pa2, pa3); SBAR(); } while (0)
#define WPV(SL) do { __builtin_amdgcn_s_setprio(1); pv_wide(o, vb0 + (SL) * 32768, pa0, pa1, pa2, pa3); __builtin_amdgcn_s_setprio(0); } while (0)
  WDMA(0, 0); WDMA(1, 1);
  int sl = 0;
  for (int j = 0; j < NT; ++j) {
    const int sl2 = (sl == 0) ? 2 : sl - 1;
    if (j + 1 < NT) asm volatile("s_waitcnt vmcnt(6)" ::: "memory"); else asm volatile("s_waitcnt vmcnt(0)" ::: "memory");
    __builtin_amdgcn_s_barrier(); asm volatile("" ::: "memory");
    if (j + 2 < NT) WDMA(j + 2, sl2);
    WQKSM(sl); WPV(sl);
    sl = (sl == 2) ? 0 : sl + 1;
  }
#undef WQKSM
#undef WPV
#undef WDMA
#undef WSRC
  if (hi == 0) li_l[r32] = l_reg; asm volatile("s_waitcnt lgkmcnt(0)" ::: "memory");
  float rli[16];
#pragma unroll
  for (int r = 0; r < 16; ++r) rli[r] = __builtin_amdgcn_rcpf(li_l[crow(r, hi)]);
  bf16* Ow = Ob + (long)(wid * QBLK) * LDO;
#pragma unroll
  for (int r = 0; r < 16; ++r) { const int orow = crow(r, hi);
#pragma unroll
    for (int d0 = 0; d0 < 8; ++d0) Ow[(long)orow * LDO + d0 * 32 + r32] = (bf16)(cvtpk(o[d0][r] * rli[r], 0.f) & 0xffffu); }
}
#undef KSWZ
}

constexpr int T = 8192, DM = 2048, SEQ = 4096, NB = 2, DEPTH = 4, INW = 5120, MIXW = 2048;
constexpr int OFF_DQ = 0, OFF_DK = 1024, OFF_DV = 2048, OFF_NQ = 3072, OFF_NK = 3584, OFF_NV = 4096, OFF_MQ = 4608;
constexpr int NMEM = 256, NEXP = 16384, KVW = 1024;
constexpr float EPS = 1e-6f;
constexpr int NWAVES = 8;
#ifndef MK_PHMASK
#define MK_PHMASK 0xfff
#endif
#define PHEN(k) (((MK_PHMASK) >> (k)) & 1)
#ifndef EPV_ROPE
#define EPV_ROPE 1
#endif
#ifndef PROBE_MASK
#define PROBE_MASK 0
#endif
#define PREP(k) ((((PROBE_MASK) >> (k)) & 1) + 1)
#ifndef U_FP4
#define U_FP4 1
#endif
#ifndef U_I4
#define U_I4 1
#endif
#ifndef GATHER_SPLIT
#define GATHER_SPLIT 1
#endif
#ifndef GATHER_BATCH
#define GATHER_BATCH 8
#endif
#ifndef V_FP4
#define V_FP4 1
#endif
#ifndef V_SLICED
#define V_SLICED 1
#endif
#ifndef V_SLICES
#define V_SLICES 8
#endif
#ifndef PROBE_VL2
#define PROBE_VL2 0
#endif
#ifndef V_I4
#define V_I4 1
#endif
#ifndef MK_ATT
#define MK_ATT 7
#endif
#ifndef MK_ONE_LAUNCH
#define MK_ONE_LAUNCH 1
#endif

constexpr size_t MiB = 1u << 20;
constexpr size_t WS_CTL = 0, CTL_ZERO_BYTES = 1 * MiB;
constexpr size_t WS_ROPE = 1 * MiB;
constexpr size_t WS_MEMN = 2 * MiB;
constexpr size_t WS_MEMKV = 4 * MiB;
constexpr size_t WS_KEYS = 8 * MiB;
constexpr size_t WS_IDS = 10 * MiB;
constexpr size_t WS_GATES = 14 * MiB;
constexpr size_t WS_WTIN = 32 * MiB;
constexpr size_t WS_WTOUT = 112 * MiB;
constexpr size_t WS_WTPQ = 144 * MiB;
constexpr size_t WS_WTKV = 176 * MiB;
constexpr size_t WS_XN = 192 * MiB;
constexpr size_t WS_PROJ = 224 * MiB;
constexpr size_t WS_OD = 304 * MiB;
constexpr size_t WS_MIX = 368 * MiB;
constexpr size_t WS_PQ = 400 * MiB;
constexpr size_t WS_SSP = 20 * MiB;
constexpr size_t WS_RS = 21 * MiB;
constexpr size_t WS_WEXP = 22 * MiB;
constexpr size_t WS_USC = 18 * MiB;
constexpr size_t WS_VSC = 19 * MiB;
constexpr int UROWB = U_FP4 ? 1024 : 1536;
constexpr int VROWB = V_FP4 ? 1024 : 1536;
constexpr int ROWB = 1536;
constexpr size_t WS_UTAB = 448 * MiB;
constexpr size_t WS_VTAB = 576 * MiB;
constexpr size_t WS_END = 704 * MiB;
constexpr int CW_BAR = 4096;

constexpr int RING_BYTES = 147456;
constexpr int LDSCTL_OFF = RING_BYTES, MISC_OFF = LDSCTL_OFF + 320;
constexpr int LDS_BYTES = 163840;
constexpr int EPI_P_OFF = RING_BYTES + 1024;

#define GAS __attribute__((address_space(1)))
#define LAS __attribute__((address_space(3)))
typedef unsigned short bf16;
typedef unsigned v4u __attribute__((ext_vector_type(4)));
typedef unsigned v2u __attribute__((ext_vector_type(2)));
typedef float f32x4 __attribute__((ext_vector_type(4)));
typedef float f32x16 __attribute__((ext_vector_type(16)));
typedef short bf16x8 __attribute__((ext_vector_type(8)));
#define LDS_WAIT() asm volatile("s_waitcnt lgkmcnt(0)" ::: "memory")

__device__ __forceinline__ unsigned f2bf(float f) { unsigned u = __builtin_bit_cast(unsigned, f); return (u + 0x7fffu + ((u >> 16) & 1u)) >> 16; }
__device__ __forceinline__ unsigned pk2(float lo, float hi) { return f2bf(lo) | (f2bf(hi) << 16); }
__device__ __forceinline__ float bflo(unsigned w) { return __builtin_bit_cast(float, w << 16); }
__device__ __forceinline__ float bfhi(unsigned w) { return __builtin_bit_cast(float, w & 0xffff0000u); }
__device__ __forceinline__ float shx_(float v, int o, int lane) { return __builtin_bit_cast(float, __builtin_amdgcn_ds_bpermute((lane ^ o) << 2, __builtin_bit_cast(int, v))); }
__device__ __forceinline__ int shx_(int v, int o, int lane) { return __builtin_amdgcn_ds_bpermute((lane ^ o) << 2, v); }
__device__ __forceinline__ float shi_(float v, int src) { return __builtin_bit_cast(float, __builtin_amdgcn_ds_bpermute(src << 2, __builtin_bit_cast(int, v))); }
#define SHX(v, o) shx_((v), (o), lane)
__device__ __forceinline__ float wave_sum(float v, int lane) {
#pragma unroll
    for (int o = 1; o < 64; o <<= 1) v += SHX(v, o);
    return v;
}

#define XB_TMO      128
#define XB_XCNT(j)  (256  + 64 * (j))
#define XB_XSUB(j)  (1280 + 64 * (j))
#define XB_XGEN(j)  (2304 + 64 * (j))
#define XB_TOP      3328
#define XB_TOPGEN   3392
#define XCD_BAR_WORDS 3456
#define XB_SPIN_CAP (1u << 18)
__device__ __forceinline__ unsigned xb_ld(unsigned* p)              { return __hip_atomic_load(p, __ATOMIC_RELAXED, __HIP_MEMORY_SCOPE_AGENT); }
__device__ __forceinline__ unsigned xb_add(unsigned* p, unsigned v) { return __hip_atomic_fetch_add(p, v, __ATOMIC_RELAXED, __HIP_MEMORY_SCOPE_AGENT); }
__device__ __forceinline__ unsigned xb_xcc_id() { return (unsigned)__builtin_amdgcn_s_getreg((3 << 11) | 20) & 0xFu; }
#define XB_SPIN(cond, bar) do { unsigned _sp = 0; while (cond) { __builtin_amdgcn_s_sleep(1); \
    if ((++_sp & 255u) == 0u) { if (xb_ld(&(bar)[XB_TMO])) break; if (_sp > XB_SPIN_CAP) { atomicAdd(&(bar)[XB_TMO], 1u); break; } } } } while (0)
struct XcdBarrier { unsigned* bar; unsigned x; volatile LAS unsigned* st; };
__device__ __forceinline__ XcdBarrier xcd_barrier_post(unsigned* bar, volatile LAS unsigned* st, bool t0) {
    XcdBarrier b; b.bar = bar; b.x = xb_xcc_id(); b.st = st;
    if (t0) (void)xb_add(&bar[XB_XCNT(b.x)], 1u);
    return b;
}
__device__ __forceinline__ void xcd_barrier_complete(unsigned* bar, unsigned x, unsigned& nloc, unsigned& nx) {
    const unsigned G = gridDim.x * gridDim.y * gridDim.z;
    unsigned sum, cnt, mine, sp = 0u;
    for (;;) {
        sum = 0u; cnt = 0u; mine = 0u;
#pragma unroll 1
        for (unsigned j = 0; j < 16; ++j) { const unsigned c = xb_ld(&bar[XB_XCNT(j)]); sum += c; cnt += (c > 0u) ? 1u : 0u; mine = (j == x) ? c : mine; }
        if (sum == G) break;
        __builtin_amdgcn_s_sleep(1);
        if ((++sp & 255u) == 0u) { if (xb_ld(&bar[XB_TMO])) break; if (sp > XB_SPIN_CAP) { atomicAdd(&bar[XB_TMO], 1u); break; } }
    }
    nloc = mine > 0u ? mine : 1u; nx = cnt > 0u ? cnt : 1u;
}
__device__ __forceinline__ void xcd_barrier(const XcdBarrier& b, bool t0) {
    asm volatile("s_waitcnt vmcnt(0)" ::: "memory");
    __syncthreads();
    if (t0) {
        unsigned* bar = b.bar;
        __builtin_amdgcn_s_waitcnt(0);
        unsigned nloc = b.st[0], nx = b.st[1];
        if (nloc == 0u) { xcd_barrier_complete(bar, b.x, nloc, nx); b.st[0] = nloc; b.st[1] = nx; }
        const unsigned old = xb_add(&bar[XB_XSUB(b.x)], 1u);
        const unsigned gen = old / nloc;
        if (old + 1u == (gen + 1u) * nloc) {
            __builtin_amdgcn_fence(__ATOMIC_RELEASE, "agent");
            asm volatile("s_waitcnt vmcnt(0)" ::: "memory");
            const unsigned og = xb_add(&bar[XB_TOP], 1u);
            const unsigned tg = og / nx;
            if (og + 1u == (tg + 1u) * nx) xb_add(&bar[XB_TOPGEN], 1u);
            else XB_SPIN(xb_ld(&bar[XB_TOPGEN]) == tg, bar);
            __builtin_amdgcn_fence(__ATOMIC_ACQUIRE, "agent");
            xb_add(&bar[XB_XGEN(b.x)], 1u);
            asm volatile("s_waitcnt vmcnt(0)" ::: "memory");
        } else {
            XB_SPIN(xb_ld(&bar[XB_XGEN(b.x)]) == gen, bar);
            __builtin_amdgcn_fence(__ATOMIC_ACQUIRE, "agent");
            asm volatile("s_waitcnt vmcnt(0)" ::: "memory");
        }
    }
    __syncthreads();
}

__device__ __forceinline__ void transpose_item(const float* W, const float* gain, int K, int N, bf16* WT, LAS float* scr, int item, int lane) {
    const int nblk = N / 32, kb = item / nblk, nb = item % nblk, k0 = 64 * kb, n0 = 32 * nb;
    f32x4 v[8];
#pragma unroll
    for (int i = 0; i < 8; ++i) v[i] = *(const f32x4*)(W + (size_t)(k0 + 8 * i + (lane >> 3)) * N + n0 + 4 * (lane & 7));
    if (gain) {
#pragma unroll
        for (int i = 0; i < 8; ++i) v[i] *= gain[k0 + 8 * i + (lane >> 3)];
    }
#pragma unroll
    for (int i = 0; i < 8; ++i) { LAS float* d_ = scr + (8 * i + (lane >> 3)) * 33 + 4 * (lane & 7); d_[0] = v[i].x; d_[1] = v[i].y; d_[2] = v[i].z; d_[3] = v[i].w; }
    LDS_WAIT(); asm volatile("" ::: "memory");
    const int c = lane & 7;
#pragma unroll
    for (int j = 0; j < 4; ++j) { const int n = (lane >> 3) + 8 * j; const LAS float* s = scr + (8 * c) * 33 + n;
        v4u o; o.x = pk2(s[0 * 33], s[1 * 33]); o.y = pk2(s[2 * 33], s[3 * 33]); o.z = pk2(s[4 * 33], s[5 * 33]); o.w = pk2(s[6 * 33], s[7 * 33]);
        *(v4u*)(WT + (size_t)(n0 + n) * K + k0 + 8 * c) = o; }
    LDS_WAIT(); asm volatile("" ::: "memory");
}
__device__ __forceinline__ void rms_row_to_bf16(const float* xrow, bf16* orow, int lane) {
    const f32x4* xr = (const f32x4*)xrow + lane;
    f32x4 v[8]; float s = 0.f;
#pragma unroll
    for (int j = 0; j < 8; ++j) { v[j] = xr[64 * j]; s += (v[j].x * v[j].x + v[j].y * v[j].y) + (v[j].z * v[j].z + v[j].w * v[j].w); }
    const float r = 1.0f / sqrtf(wave_sum(s, lane) * (1.f / 2048.f) + EPS);
    v2u* o8 = (v2u*)orow + lane;
#pragma unroll
    for (int j = 0; j < 8; ++j) { v2u w; w.x = pk2(v[j].x * r, v[j].y * r); w.y = pk2(v[j].z * r, v[j].w * r); o8[64 * j] = w; }
}
__device__ __forceinline__ void row_to_bf16_rs(const float* xrow, bf16* orow, float* rs_out, int lane) {
    const f32x4* xr = (const f32x4*)xrow + lane;
    f32x4 v[8]; float s = 0.f;
#pragma unroll
    for (int j = 0; j < 8; ++j) { v[j] = xr[64 * j]; s += (v[j].x * v[j].x + v[j].y * v[j].y) + (v[j].z * v[j].z + v[j].w * v[j].w); }
    const float st = wave_sum(s, lane);
    if (lane < 8) rs_out[lane] = lane == 0 ? st : 0.f;
    v2u* o8 = (v2u*)orow + lane;
#pragma unroll
    for (int j = 0; j < 8; ++j) { v2u w; w.x = pk2(v[j].x, v[j].y); w.y = pk2(v[j].z, v[j].w); o8[64 * j] = w; }
}
__device__ __forceinline__ void slot_norm(bf16* p, const float* g, bool rope, const float* cs, const float* sn, int sub  , int lane) {
    v4u w = *(v4u*)(p + sub * 8);
    float x[8] = {bflo(w.x), bfhi(w.x), bflo(w.y), bfhi(w.y), bflo(w.z), bfhi(w.z), bflo(w.w), bfhi(w.w)};
    float s = 0.f;
#pragma unroll
    for (int j = 0; j < 8; ++j) s += x[j] * x[j];
    s += SHX(s, 1); s += SHX(s, 2); s += SHX(s, 4); s += SHX(s, 8);
    const float r = 1.0f / sqrtf(s * (1.f / 128.f) + EPS);
    const f32x4 g0 = *(const f32x4*)(g + sub * 8), g1 = *(const f32x4*)(g + sub * 8 + 4);
    x[0] *= r * g0.x; x[1] *= r * g0.y; x[2] *= r * g0.z; x[3] *= r * g0.w; x[4] *= r * g1.x; x[5] *= r * g1.y; x[6] *= r * g1.z; x[7] *= r * g1.w;
    float y[8];
#pragma unroll
    for (int j = 0; j < 8; ++j) y[j] = SHX(x[j], 2);
    if (rope && sub < 4) {
        const int i0 = (sub & 1) * 8;
#pragma unroll
        for (int j = 0; j < 8; ++j) { const float c = cs[i0 + j], sn_ = sn[i0 + j]; x[j] = (sub < 2) ? (x[j] * c - y[j] * sn_) : (x[j] * c + y[j] * sn_); }
    }
    v4u o; o.x = pk2(x[0], x[1]); o.y = pk2(x[2], x[3]); o.z = pk2(x[4], x[5]); o.w = pk2(x[6], x[7]);
    *(v4u*)(p + sub * 8) = o;
}

struct EpiResF32 {
    static constexpr bool PERM = false, AFTER_DRAIN = false;
    bf16* XB; float* SSP; int ldc;
    __device__ __forceinline__ void operator()(const pg8::f32x4 (&acc)[2][2][4][2], const pg8::Unit& u, int wr, int wc, int fr_in, int fq_in) const {
        int fr = fr_in, fq = fq_in; asm volatile("" : "+v"(fr), "+v"(fq));
        const int lane = fq * 16 + fr;
        const int row0 = u.pm * pg8::BM + wr * 64 + fr, col0 = u.pn * pg8::BM + wc * 32 + 4 * fq;
#pragma unroll
        for (int ai = 0; ai < 2; ++ai)
#pragma unroll
            for (int m = 0; m < 4; ++m) { const int row = row0 + ai * pg8::HALF + m * 16; const size_t off = (size_t)row * ldc + col0; float ss = 0.f;
#pragma unroll
                for (int bj = 0; bj < 2; ++bj)
#pragma unroll
                    for (int n = 0; n < 2; ++n) { const v2u bw = *(const v2u*)(XB + off + bj * pg8::HALF + n * 16); const pg8::f32x4 a = acc[ai][bj][m][n];
                        const float v0 = bflo(bw.x) + a[0], v1 = bfhi(bw.x) + a[1], v2 = bflo(bw.y) + a[2], v3 = bfhi(bw.y) + a[3];
                        ss += (v0 * v0 + v1 * v1) + (v2 * v2 + v3 * v3);
                        v2u w; w.x = pk2(v0, v1); w.y = pk2(v2, v3); *(v2u*)(XB + off + bj * pg8::HALF + n * 16) = w; }
                ss += SHX(ss, 16); ss += SHX(ss, 32);
                if (fq == 0) SSP[(size_t)row * 32 + u.pn * 4 + wc] = ss;
                asm volatile("" ::: "memory"); }
    }
};
template <bool MEM> struct EpiProjT {
    static constexpr bool PERM = false, AFTER_DRAIN = false;
    bf16* O; const float* gq; const float* ropec; const float* ropes; LAS float* P; int pn0;
    const float* rs;
    __device__ __forceinline__ void operator()(const pg8::f32x4 (&acc)[2][2][4][2], const pg8::Unit& u, int wr, int wc, int fr_in, int fq_in) const {
        constexpr int LDO_ = MEM ? DEPTH * KVW : INW;
        int fr = fr_in, fq = fq_in; asm volatile("" : "+v"(fr), "+v"(fq));
        const int lane = fq * 16 + fr;
        const int pn = u.pn + pn0; const int row0 = u.pm * pg8::BM + wr * 64 + fr, col0 = pn * pg8::BM + wc * 32 + 4 * fq;
        int gi = -1;
        if (MEM) { gi = ((pn & 3) < 2) ? (pn >> 2) * 6 + 5 : -1; }
        else { if (pn < 4) gi = 0; else if (pn < 8) gi = 1; else if (pn < 12) gi = -1; else if (pn < 14) gi = 2; else if (pn < 16) gi = 3; else if (pn < 18) gi = -1; else gi = 4; }
        const bool rope = !MEM && pn < 8;
        if (gi < 0) {
#pragma unroll
            for (int ai = 0; ai < 2; ++ai)
#pragma unroll
                for (int m = 0; m < 4; ++m) { const int row_ = row0 + ai * pg8::HALF + m * 16; bf16* rowp = O + (size_t)row_ * LDO_ + col0; float rsc = 1.0f; if (rs) { const f32x4 pa_ = *(const f32x4*)(rs + (size_t)row_ * 8), pb_ = *(const f32x4*)(rs + (size_t)row_ * 8 + 4); rsc = 1.0f / sqrtf((((pa_.x + pa_.y) + (pa_.z + pa_.w)) + ((pb_.x + pb_.y) + (pb_.z + pb_.w))) * (1.f / 2048.f) + EPS); }
#pragma unroll
                    for (int bj = 0; bj < 2; ++bj)
#pragma unroll
                        for (int n = 0; n < 2; ++n) { const pg8::f32x4 v = acc[ai][bj][m][n] * rsc; v2u w; w.x = pk2(v[0], v[1]); w.y = pk2(v[2], v[3]); *(v2u*)(rowp + bj * pg8::HALF + n * 16) = w; } }
            return;
        }
#pragma unroll
        for (int ai = 0; ai < 2; ++ai)
#pragma unroll
            for (int m = 0; m < 4; ++m)
#pragma unroll
                for (int bj = 0; bj < 2; ++bj) { float ss = 0.f;
#pragma unroll
                    for (int n = 0; n < 2; ++n) { const pg8::f32x4 v = acc[ai][bj][m][n]; ss += (v[0] * v[0] + v[1] * v[1]) + (v[2] * v[2] + v[3] * v[3]); }
                    ss += SHX(ss, 16); ss += SHX(ss, 32);
                    if (fq == 0) P[((ai * pg8::HALF + wr * 64 + m * 16 + fr) * 2 + bj) * 4 + wc] = ss; __builtin_amdgcn_sched_barrier(0); }
        asm volatile("s_waitcnt lgkmcnt(0)" ::: "memory"); __builtin_amdgcn_s_barrier(); asm volatile("" ::: "memory");
        const f32x4 g0 = *(const f32x4*)(gq + gi * 128 + wc * 32 + 4 * fq), g1 = *(const f32x4*)(gq + gi * 128 + wc * 32 + 16 + 4 * fq);
#pragma unroll
        for (int ai = 0; ai < 2; ++ai)
#pragma unroll
            for (int m = 0; m < 4; ++m) { const int rl = ai * pg8::HALF + wr * 64 + m * 16 + fr, row = u.pm * pg8::BM + rl; bf16* rowp = O + (size_t)row * LDO_ + col0;
                f32x4 cs = (f32x4){1.f, 1.f, 1.f, 1.f}, sn = (f32x4){0.f, 0.f, 0.f, 0.f};
                if (EPV_ROPE && rope && wc == 0) { const int pos = row & (SEQ - 1); cs = *(const f32x4*)(ropec + pos * 16 + 4 * fq); sn = *(const f32x4*)(ropes + pos * 16 + 4 * fq); }
#pragma unroll
                for (int bj = 0; bj < 2; ++bj) { const f32x4 t = *(const LAS f32x4*)(P + (rl * 2 + bj) * 4); const float r = 1.0f / sqrtf(((t.x + t.y) + (t.z + t.w)) * (1.f / 128.f) + EPS);
                    f32x4 y0 = acc[ai][bj][m][0] * r * g0, y1 = acc[ai][bj][m][1] * r * g1;
                    if (EPV_ROPE && rope && wc == 0) { const f32x4 a = y0 * cs - y1 * sn, b = y1 * cs + y0 * sn; y0 = a; y1 = b; }
                    v2u w0, w1; w0.x = pk2(y0[0], y0[1]); w0.y = pk2(y0[2], y0[3]); w1.x = pk2(y1[0], y1[1]); w1.y = pk2(y1[2], y1[3]);
                    *(v2u*)(rowp + bj * pg8::HALF) = w0; *(v2u*)(rowp + bj * pg8::HALF + 16) = w1; }
                asm volatile("" ::: "memory"); __builtin_amdgcn_sched_barrier(0); }
    }
};

typedef EpiProjT<false> EpiProj;

template <bool KLDS> __device__ __forceinline__ void select_task(const bf16* PQ, const float* SSP, const bf16* KEYS_l, int* IDS, float* GATES, int tile, int hp, LAS int* lscr, int lane, const char* klds = nullptr) {
    const int r32 = lane & 31, hi = lane >> 5; const int t = tile * 32 + r32;
    float rs;
    { float tot = 0.f;
#pragma unroll
      for (int j = 0; j < 8; ++j) { const f32x4 v = *(const f32x4*)(SSP + (size_t)t * 32 + j * 4); tot += (v.x + v.y) + (v.z + v.w); }
      rs = 1.0f / sqrtf(tot * (1.f / 2048.f) + EPS); }
    int ab[2][16];
#pragma unroll
    for (int c = 0; c < 2; ++c) {
        const int g = hp * 2 + c;
        bf16x8 qr[8];
#pragma unroll
        for (int ks = 0; ks < 8; ++ks) qr[ks] = *(const bf16x8*)(PQ + (size_t)t * 2048 + g * 128 + ks * 16 + hi * 8);
        const bf16* kb = KEYS_l + (size_t)g * 128 * 128;
        f32x16 p[4];
        if constexpr (KLDS) {
            att::qkt(p[0], p[1], (const att::bf16*)(klds + (2 * c) * 16384), qr, r32, hi);
            att::qkt(p[2], p[3], (const att::bf16*)(klds + (2 * c + 1) * 16384), qr, r32, hi);
        } else {
#pragma unroll
        for (int q = 0; q < 4; ++q) { p[q] = f32x16{};
#pragma unroll
            for (int ks = 0; ks < 8; ++ks) { const bf16x8 af = *(const bf16x8*)(kb + (size_t)(q * 32 + r32) * 128 + ks * 16 + hi * 8); p[q] = __builtin_amdgcn_mfma_f32_32x32x16_bf16(af, qr[ks], p[q], 0, 0, 0); } }
        }
        int g0[16], g1[16], g2[16], g3[16];
#pragma unroll
        for (int r = 0; r < 16; ++r) { const int idx = (r & 3) + 8 * (r >> 2) + 4 * hi;
            g0[r] = (sel::f2key(p[0][r]) & ~127) | idx; g1[r] = (sel::f2key(p[1][r]) & ~127) | (32 + idx);
            g2[r] = (sel::f2key(p[2][r]) & ~127) | (64 + idx); g3[r] = (sel::f2key(p[3][r]) & ~127) | (96 + idx); }
        sel::sort_desc(g0); sel::sort_desc(g1); sel::sort_desc(g2); sel::sort_desc(g3);
        sel::top16_merge(g0, g1); sel::top16_merge(g2, g3); sel::top16_merge(g0, g2);
        int pb[16];
#pragma unroll
        for (int i = 0; i < 16; ++i) pb[i] = SHX(g0[i], 32);
        sel::top16_merge(g0, pb);
#pragma unroll
        for (int i = 0; i < 16; ++i) ab[c][i] = g0[i];
    }
    int cc[16];
    sel::cand_top16(ab[0], ab[1], cc, rs);
#pragma unroll
    for (int i = 0; i < 16; ++i) { lscr[i * 64 + lane] = ab[0][i] & 127; lscr[(16 + i) * 64 + lane] = ab[1][i] & 127; }
    LDS_WAIT();
    float val[16], e[16]; int eid[16];
#pragma unroll
    for (int k = 0; k < 16; ++k) { const int code = cc[k] & 255; const int i = code >> 4, j = code & 15; val[k] = sel::key2f(cc[k] & ~255);
        eid[k] = lscr[i * 64 + lane] * 128 + lscr[(16 + j) * 64 + lane]; }
    float sum = 0.f;
#pragma unroll
    for (int k = 0; k < 16; ++k) { e[k] = __expf(val[k] - val[0]); sum += e[k]; }
    const float inv = 1.0f / sum;
    int* ip = IDS + (size_t)t * 128 + hp * 16 + hi * 8; float* gp = GATES + (size_t)t * 128 + hp * 16 + hi * 8;
    v4u i0, i1; f32x4 q0, q1;
    i0.x = hi ? eid[8] : eid[0]; i0.y = hi ? eid[9] : eid[1]; i0.z = hi ? eid[10] : eid[2]; i0.w = hi ? eid[11] : eid[3];
    i1.x = hi ? eid[12] : eid[4]; i1.y = hi ? eid[13] : eid[5]; i1.z = hi ? eid[14] : eid[6]; i1.w = hi ? eid[15] : eid[7];
    q0.x = (hi ? e[8] : e[0]) * inv; q0.y = (hi ? e[9] : e[1]) * inv; q0.z = (hi ? e[10] : e[2]) * inv; q0.w = (hi ? e[11] : e[3]) * inv;
    q1.x = (hi ? e[12] : e[4]) * inv; q1.y = (hi ? e[13] : e[5]) * inv; q1.z = (hi ? e[14] : e[6]) * inv; q1.w = (hi ? e[15] : e[7]) * inv;
    *(v4u*)ip = i0; *(v4u*)(ip + 4) = i1; *(f32x4*)gp = q0; *(f32x4*)(gp + 4) = q1;
    LDS_WAIT();
}

typedef float f32x2 __attribute__((ext_vector_type(2)));
typedef float v16f __attribute__((ext_vector_type(16)));
typedef float v32f __attribute__((ext_vector_type(32)));
typedef unsigned v6u __attribute__((ext_vector_type(6)));
__device__ __forceinline__ int fp6_order_probe() {
    v16f a, b;
#pragma unroll
    for (int j = 0; j < 16; ++j) { a[j] = 0.25f * (float)(j + 1); b[j] = -0.25f * (float)(j + 1); }
    asm volatile("" : "+v"(a), "+v"(b));
    const v6u w = __builtin_amdgcn_cvt_scalef32_2xpk16_fp6_f32(a, b, 1.0f);
    const v32f d = __builtin_amdgcn_cvt_scalef32_pk32_f32_fp6(w, 1.0f);
    bool okA = true, okB = true;
#pragma unroll
    for (int j = 0; j < 16; ++j) { okA = okA && (d[j] == a[j]) && (d[16 + j] == b[j]); okB = okB && (d[2 * j] == a[j]) && (d[2 * j + 1] == b[j]); }
    return okA ? 0 : (okB ? 1 : -1);
}
__device__ __forceinline__ void row_fp6_load(const float* src, f32x4 (&v)[8], int lane) {
    const f32x4* xr = (const f32x4*)src + lane;
#pragma unroll
    for (int j = 0; j < 8; ++j) v[j] = __builtin_nontemporal_load(xr + 64 * j);
}
__device__ __forceinline__ void row_fp6_finish(const f32x4 (&v)[8], unsigned char* dst  , float* scale_out, int order, int lane) {
    float am = 0.f;
#pragma unroll
    for (int j = 0; j < 8; ++j) am = fmaxf(am, fmaxf(fmaxf(fabsf(v[j].x), fabsf(v[j].y)), fmaxf(fabsf(v[j].z), fabsf(v[j].w))));
#pragma unroll
    for (int o = 1; o < 64; o <<= 1) am = fmaxf(am, SHX(am, o));
    float q = am > 0.f ? 7.5f / am : 0.f;
    if (order < 0) q = __builtin_nanf("");
    if (lane == 0) *scale_out = am * (1.0f / 7.5f);
    float c[32];
#pragma unroll
    for (int j = 0; j < 8; ++j) { c[4 * j] = v[j].x * q; c[4 * j + 1] = v[j].y * q; c[4 * j + 2] = v[j].z * q; c[4 * j + 3] = v[j].w * q; }
    v16f a, b;
#pragma unroll
    for (int i = 0; i < 16; ++i) { a[i] = (order == 1) ? c[2 * i] : c[i]; b[i] = (order == 1) ? c[2 * i + 1] : c[16 + i]; }
    const v6u w = __builtin_amdgcn_cvt_scalef32_2xpk16_fp6_f32(a, b, 1.0f);
    *(v4u*)(dst + lane * 16) = (v4u){w[0], w[1], w[2], w[3]};
    *(v2u*)(dst + 1024 + lane * 8) = (v2u){w[4], w[5]};
}
__device__ __forceinline__ int fp4_order_probe() {
    float a = 1.0f, b = 2.0f; asm volatile("" : "+v"(a), "+v"(b));
    const unsigned w = __builtin_amdgcn_cvt_scalef32_pk_fp4_f32(0u, a, b, 1.0f, 2);
    const f32x2 d = __builtin_amdgcn_cvt_scalef32_pk_f32_fp4(w, 1.0f, 2);
    return (d.x == 1.0f && d.y == 2.0f) ? 0 : ((d.x == 2.0f && d.y == 1.0f) ? 1 : -1);
}
__device__ __forceinline__ void row_fp4_finish(const f32x4 (&v)[8], unsigned char* dst  , float* scale_out, int order, int lane) {
    float am = 0.f;
#pragma unroll
    for (int j = 0; j < 8; ++j) am = fmaxf(am, fmaxf(fmaxf(fabsf(v[j].x), fabsf(v[j].y)), fmaxf(fabsf(v[j].z), fabsf(v[j].w))));
#pragma unroll
    for (int o = 1; o < 64; o <<= 1) am = fmaxf(am, SHX(am, o));
    float q = am > 0.f ? 6.0f / am : 0.f;
    if (order < 0) q = __builtin_nanf("");
    if (lane == 0) *scale_out = am * (1.0f / 6.0f);
    unsigned w[4];
#pragma unroll
    for (int d = 0; d < 4; ++d) { unsigned t = 0u;
        const float e0 = v[2 * d].x * q, e1 = v[2 * d].y * q, e2 = v[2 * d].z * q, e3 = v[2 * d].w * q, e4 = v[2 * d + 1].x * q, e5 = v[2 * d + 1].y * q, e6 = v[2 * d + 1].z * q, e7 = v[2 * d + 1].w * q;
        t = __builtin_amdgcn_cvt_scalef32_pk_fp4_f32(t, order ? e1 : e0, order ? e0 : e1, 1.0f, 0);
        t = __builtin_amdgcn_cvt_scalef32_pk_fp4_f32(t, order ? e3 : e2, order ? e2 : e3, 1.0f, 1);
        t = __builtin_amdgcn_cvt_scalef32_pk_fp4_f32(t, order ? e5 : e4, order ? e4 : e5, 1.0f, 2);
        t = __builtin_amdgcn_cvt_scalef32_pk_fp4_f32(t, order ? e7 : e6, order ? e6 : e7, 1.0f, 3);
        w[d] = t; }
    *(v4u*)(dst + lane * 16) = (v4u){w[0], w[1], w[2], w[3]};
}
__device__ __forceinline__ void row_i4_finish(const f32x4 (&v)[8], unsigned char* dst  , float* scale_out, int lane, bool sliced = false) {
    float ss = 0.f;
#pragma unroll
    for (int j = 0; j < 8; ++j) ss += (v[j].x * v[j].x + v[j].y * v[j].y) + (v[j].z * v[j].z + v[j].w * v[j].w);
    const float sig = sqrtf(wave_sum(ss, lane) * (1.f / 2048.f));
    const float q = sig > 0.f ? 7.0f / (2.5f * sig) : 0.f;
    if (lane == 0) *scale_out = sig * (2.5f / 7.0f);
    unsigned w[4];
    const float MAGIC = 12582912.0f;
#pragma unroll
    for (int d = 0; d < 4; ++d) {
        const float e[8] = {v[2 * d].x, v[2 * d].y, v[2 * d].z, v[2 * d].w, v[2 * d + 1].x, v[2 * d + 1].y, v[2 * d + 1].z, v[2 * d + 1].w};
        unsigned b[8];
#pragma unroll
        for (int n = 0; n < 8; ++n) b[n] = __builtin_bit_cast(unsigned, __builtin_amdgcn_fmed3f(__builtin_fmaf(e[n], q, MAGIC), MAGIC - 8.0f, MAGIC + 7.0f));
        const unsigned p02 = __builtin_amdgcn_perm(b[2], b[0], 0x0c0c0400u), p46 = __builtin_amdgcn_perm(b[6], b[4], 0x0c0c0400u), p13 = __builtin_amdgcn_perm(b[3], b[1], 0x0c0c0400u), p57 = __builtin_amdgcn_perm(b[7], b[5], 0x0c0c0400u);
        const unsigned E = (p46 << 16) | p02, O = (p57 << 16) | p13;
        w[d] = (E & 0x0F0F0F0Fu) | ((O << 4) & 0xF0F0F0F0u); }
    *(v4u*)(dst + (sliced ? (size_t)(lane / (64 / V_SLICES)) * ((size_t)NEXP * (1024 / V_SLICES)) + (lane & (64 / V_SLICES - 1)) * 16 : (size_t)lane * 16)) = (v4u){w[0], w[1], w[2], w[3]};
}
__device__ __forceinline__ void gather_token(const bf16* xin  , float* xrow  , const float* fg  , const int* ids, const float* gates,
                                             const unsigned char* UT, const unsigned char* VT, const float* USC, const float* VSC, bf16* xn_out  , float* rs_out  , int lane,
                                             const float* cv_src = nullptr  , size_t cv_vofs = 0, unsigned char* cv_du = nullptr, unsigned char* cv_dv = nullptr, float* cv_su = nullptr, float* cv_sv = nullptr, int cv_r0 = 0, int f4ord = 0, int f6ord = 0, LAS unsigned char* cv_lds = nullptr  ) {
    f32x2 h[16], acc[16]; float ss = 0.f;
#pragma unroll
    for (int j = 0; j < 8; ++j) { const v2u bw = *(const v2u*)(xin + j * 256 + lane * 4); const f32x4 a = (f32x4){bflo(bw.x), bfhi(bw.x), bflo(bw.y), bfhi(bw.y)};
        h[2 * j] = (f32x2){a.x, a.y}; h[2 * j + 1] = (f32x2){a.z, a.w}; acc[2 * j] = h[2 * j]; acc[2 * j + 1] = h[2 * j + 1];
        ss += (a.x * a.x + a.y * a.y) + (a.z * a.z + a.w * a.w); }
    const float r = 1.0f / sqrtf(wave_sum(ss, lane) * (1.f / 2048.f) + EPS);
#pragma unroll
    for (int j = 0; j < 8; ++j) { const f32x4 a = *(const f32x4*)(fg + j * 256 + lane * 4);
        h[2 * j] *= (f32x2){a.x * r, a.y * r}; h[2 * j + 1] *= (f32x2){a.z * r, a.w * r}; }
    typedef _Float16 h2_t __attribute__((ext_vector_type(2)));
    h2_t h16[16];
#pragma unroll
    for (int j = 0; j < 16; ++j) { h16[j].x = (_Float16)h[j].x; h16[j].y = (_Float16)h[j].y; }
    const int id_lo = ids[lane], id_hi = ids[64 + lane];
    const float ua_lo = USC[id_lo], ua_hi = USC[id_hi];
    const float gb_lo = gates[lane] * VSC[id_lo], gb_hi = gates[64 + lane] * VSC[id_hi];
    constexpr int GB = GATHER_BATCH;
#define CV_SRC(r) ((r) >= NEXP ? cv_src + cv_vofs + (size_t)((r) - NEXP) * DM : cv_src + (size_t)(r) * DM)
#define CV_LOAD(r) do { const float* sp_ = CV_SRC(r); _Pragma("unroll") for (int j_ = 0; j_ < 8; ++j_) __builtin_amdgcn_global_load_lds((const unsigned*)(sp_ + j_ * 256 + lane * 4), (LAS unsigned*)(cv_lds + j_ * 1024), 16, 0, 2); } while (0)
#define CV_FIN(r) do { asm volatile("s_waitcnt vmcnt(0)" ::: "memory"); f32x4 cvr[8]; _Pragma("unroll") for (int j_ = 0; j_ < 8; ++j_) cvr[j_] = *(const LAS f32x4*)(cv_lds + j_ * 1024 + lane * 16); \
        const bool isv_ = (r) >= NEXP; const int rr_ = isv_ ? (r) - NEXP : (r); \
        if ((isv_ && V_FP4) || (!isv_ && U_FP4)) row_fp4_finish(cvr, (isv_ ? cv_dv + (size_t)rr_ * VROWB : cv_du + (size_t)rr_ * UROWB), (isv_ ? cv_sv : cv_su) + rr_, f4ord, lane); \
        else row_fp6_finish(cvr, (isv_ ? cv_dv + (size_t)rr_ * VROWB : cv_du + (size_t)rr_ * UROWB), (isv_ ? cv_sv : cv_su) + rr_, f6ord, lane); asm volatile("s_waitcnt lgkmcnt(0)" ::: "memory"); } while (0)
    if (cv_src) CV_LOAD(cv_r0);
    for (int kk = 0; kk < 128; kk += GB) {
        if (cv_src && kk > 0 && (kk & 31) == 0) { const int rdone = cv_r0 + (kk >> 5) - 1; CV_FIN(rdone); CV_LOAD(rdone + 1); }
        v4u ua[GB], va[GB]; v2u ub[GB], vb[GB];
#pragma unroll
        for (int e = 0; e < GB; ++e) { const int k = kk + e;
            const int id = __builtin_amdgcn_readlane(kk < 64 ? id_lo : id_hi, k & 63);
            const unsigned char* ur = UT + (size_t)id * UROWB; const unsigned char* vr = VT + (size_t)id * VROWB;
            ua[e] = *(const v4u*)(ur + lane * 16); if (!U_FP4) ub[e] = *(const v2u*)(ur + 1024 + lane * 8); va[e] = *(const v4u*)(vr + lane * 16); if (!V_FP4) vb[e] = *(const v2u*)(vr + 1024 + lane * 8); }
        float d[GB];
#pragma unroll
        for (int e = 0; e < GB; ++e) { f32x2 dd = (f32x2){0.f, 0.f};
            if (U_FP4) {
                const unsigned uw[4] = {ua[e].x, ua[e].y, ua[e].z, ua[e].w}; float da = 0.f;
#pragma unroll
                for (int dq = 0; dq < 4; ++dq) { da = __builtin_amdgcn_fdot2(h16[4 * dq], __builtin_amdgcn_cvt_scalef32_pk_f16_fp4(uw[dq], 1.0f, 0), da, false); da = __builtin_amdgcn_fdot2(h16[4 * dq + 1], __builtin_amdgcn_cvt_scalef32_pk_f16_fp4(uw[dq], 1.0f, 1), da, false);
                    da = __builtin_amdgcn_fdot2(h16[4 * dq + 2], __builtin_amdgcn_cvt_scalef32_pk_f16_fp4(uw[dq], 1.0f, 2), da, false); da = __builtin_amdgcn_fdot2(h16[4 * dq + 3], __builtin_amdgcn_cvt_scalef32_pk_f16_fp4(uw[dq], 1.0f, 3), da, false); }
                dd.x = da;
            } else {
                const v32f u = __builtin_amdgcn_cvt_scalef32_pk32_f32_fp6((v6u){ua[e].x, ua[e].y, ua[e].z, ua[e].w, ub[e].x, ub[e].y}, 1.0f);
#pragma unroll
                for (int j = 0; j < 16; ++j) dd += h[j] * (f32x2){u[2 * j], u[2 * j + 1]};
            }
            d[e] = dd.x + dd.y; __builtin_amdgcn_sched_barrier(0); }
#pragma unroll
        for (int step = 1, n = GB; n > 1; step <<= 1, n >>= 1) {
            const bool bb = (lane & step) != 0;
#pragma unroll
            for (int i = 0; i < n / 2; ++i) { const float keep = bb ? d[2 * i + 1] : d[2 * i], send = bb ? d[2 * i] : d[2 * i + 1]; d[i] = keep + SHX(send, step); }
        }
        float s = d[0];
#pragma unroll
        for (int step = GB; step < 64; step <<= 1) s += SHX(s, step);
        const int src = (kk & 63) + (lane & (GB - 1));
        const float a = s * shi_(kk < 64 ? ua_lo : ua_hi, src);
        const float wv = shi_(kk < 64 ? gb_lo : gb_hi, src) * 0.5f * a * (1.0f + erff(a * 0.70710678118654752f));
#pragma unroll
        for (int e = 0; e < GB; ++e) { const float we = __builtin_bit_cast(float, __builtin_amdgcn_readlane(__builtin_bit_cast(int, wv), e)); const f32x2 w2 = (f32x2){we, we};
            if (V_FP4) {
                const unsigned vw[4] = {va[e].x, va[e].y, va[e].z, va[e].w};
#pragma unroll
                for (int dq = 0; dq < 4; ++dq) { acc[4 * dq] += w2 * __builtin_amdgcn_cvt_scalef32_pk_f32_fp4(vw[dq], 1.0f, 0); acc[4 * dq + 1] += w2 * __builtin_amdgcn_cvt_scalef32_pk_f32_fp4(vw[dq], 1.0f, 1);
                    acc[4 * dq + 2] += w2 * __builtin_amdgcn_cvt_scalef32_pk_f32_fp4(vw[dq], 1.0f, 2); acc[4 * dq + 3] += w2 * __builtin_amdgcn_cvt_scalef32_pk_f32_fp4(vw[dq], 1.0f, 3); }
            } else {
                const v32f vv = __builtin_amdgcn_cvt_scalef32_pk32_f32_fp6((v6u){va[e].x, va[e].y, va[e].z, va[e].w, vb[e].x, vb[e].y}, 1.0f);
#pragma unroll
                for (int j = 0; j < 16; ++j) acc[j] += w2 * (f32x2){vv[2 * j], vv[2 * j + 1]};
            }
            __builtin_amdgcn_sched_barrier(0); }
    }
    if (cv_src) { CV_FIN(cv_r0 + 3); }
#undef CV_SRC
#undef CV_FIN
#undef CV_LOAD
    int ln2 = lane; asm volatile("" : "+v"(ln2));
    if (xrow) {
#pragma unroll
        for (int j = 0; j < 8; ++j) *(f32x4*)(xrow + j * 256 + ln2 * 4) = (f32x4){acc[2 * j].x, acc[2 * j].y, acc[2 * j + 1].x, acc[2 * j + 1].y};
    }
    if (xn_out) {
        float s2 = 0.f;
#pragma unroll
        for (int j = 0; j < 16; ++j) s2 += acc[j].x * acc[j].x + acc[j].y * acc[j].y;
        const float r2 = 1.0f / sqrtf(wave_sum(s2, lane) * (1.f / 2048.f) + EPS);
        if (ln2 == 0) *rs_out = r2;
#pragma unroll
        for (int j = 0; j < 8; ++j) { v2u w0; w0.x = pk2(acc[2 * j].x, acc[2 * j].y); w0.y = pk2(acc[2 * j + 1].x, acc[2 * j + 1].y);
            *(v2u*)(xn_out + j * 256 + ln2 * 4) = w0; }
    }
}

__device__ __forceinline__ void gather_u(const bf16* xin, const float* fg, const int* ids, const float* gates, const unsigned char* UT, const float* USC, const float* VSC, float* wexp, int lane, int idmask = 0x7fffffff  , int* wpl = nullptr  , float* swi = nullptr  ) {
    static_assert(U_I4 && V_FP4, "split gather: int4 u rows, fp4 v rows");
    float wk_lo = 0.f, wk_hi = 0.f;
    float hx[32]; float ss = 0.f;
#pragma unroll
    for (int j = 0; j < 8; ++j) { const v2u bw = *(const v2u*)(xin + j * 256 + lane * 4); hx[4 * j] = bflo(bw.x); hx[4 * j + 1] = bfhi(bw.x); hx[4 * j + 2] = bflo(bw.y); hx[4 * j + 3] = bfhi(bw.y);
        ss += (hx[4 * j] * hx[4 * j] + hx[4 * j + 1] * hx[4 * j + 1]) + (hx[4 * j + 2] * hx[4 * j + 2] + hx[4 * j + 3] * hx[4 * j + 3]); }
    const float r = 1.0f / sqrtf(wave_sum(ss, lane) * (1.f / 2048.f) + EPS);
    float hm = 0.f;
#pragma unroll
    for (int j = 0; j < 8; ++j) { const f32x4 a = *(const f32x4*)(fg + j * 256 + lane * 4);
        hx[4 * j] *= a.x * r; hx[4 * j + 1] *= a.y * r; hx[4 * j + 2] *= a.z * r; hx[4 * j + 3] *= a.w * r;
        hm = fmaxf(hm, fmaxf(fmaxf(fabsf(hx[4 * j]), fabsf(hx[4 * j + 1])), fmaxf(fabsf(hx[4 * j + 2]), fabsf(hx[4 * j + 3])))); }
#pragma unroll
    for (int o = 1; o < 64; o <<= 1) hm = fmaxf(hm, SHX(hm, o));
    const float sh = hm > 0.f ? 119.0f / hm : 0.f, shinv = hm * (1.0f / 119.0f);
    unsigned hiP[4], loP[4];
#pragma unroll
    for (int d = 0; d < 4; ++d) { unsigned th = 0u, tl = 0u;
#pragma unroll
        for (int n = 0; n < 8; ++n) { const int hq = (int)rintf(hx[8 * d + n] * sh); const int hi_ = (hq + 8) >> 4, lo_ = hq - 16 * hi_; th |= ((unsigned)hi_ & 15u) << (4 * n); tl |= ((unsigned)lo_ & 15u) << (4 * n); }
        hiP[d] = th; loP[d] = tl; }
    const int id_lo = ids[lane] & idmask, id_hi = ids[64 + lane] & idmask;
    const float ua_lo = USC[id_lo] * shinv, ua_hi = USC[id_hi] * shinv;
    const float gb_lo = gates[lane] * VSC[id_lo], gb_hi = gates[64 + lane] * VSC[id_hi];
    constexpr int GB = 16;
    for (int kk = 0; kk < 128; kk += GB) {
        v4u ua[GB];
#pragma unroll
        for (int e = 0; e < GB; ++e) { const int id = __builtin_amdgcn_readlane(kk < 64 ? id_lo : id_hi, (kk + e) & 63); ua[e] = *(const v4u*)(UT + (size_t)id * UROWB + lane * 16); }
        float d[GB];
#pragma unroll
        for (int e = 0; e < GB; ++e) {
            int ah = __builtin_amdgcn_sdot8((int)ua[e].x, (int)hiP[0], 0, false), al = __builtin_amdgcn_sdot8((int)ua[e].x, (int)loP[0], 0, false);
            ah = __builtin_amdgcn_sdot8((int)ua[e].y, (int)hiP[1], ah, false); al = __builtin_amdgcn_sdot8((int)ua[e].y, (int)loP[1], al, false);
            ah = __builtin_amdgcn_sdot8((int)ua[e].z, (int)hiP[2], ah, false); al = __builtin_amdgcn_sdot8((int)ua[e].z, (int)loP[2], al, false);
            ah = __builtin_amdgcn_sdot8((int)ua[e].w, (int)hiP[3], ah, false); al = __builtin_amdgcn_sdot8((int)ua[e].w, (int)loP[3], al, false);
            d[e] = (float)(16 * ah + al); }
#pragma unroll
        for (int step = 1, n = GB; n > 1; step <<= 1, n >>= 1) {
            const bool bb = (lane & step) != 0;
#pragma unroll
            for (int i = 0; i < n / 2; ++i) { const float keep = bb ? d[2 * i + 1] : d[2 * i], send = bb ? d[2 * i] : d[2 * i + 1]; d[i] = keep + SHX(send, step); }
        }
        float s = d[0];
        s += SHX(s, 16); s += SHX(s, 32);
        const int src = (kk & 63) + (lane & 15);
        const float a = s * shi_(kk < 64 ? ua_lo : ua_hi, src);
        const float wv = shi_(kk < 64 ? gb_lo : gb_hi, src) * 0.5f * a * (1.0f + erff(a * 0.70710678118654752f));
#if V_SLICED
        if ((lane >> 4) == ((kk >> 4) & 3)) { if (kk < 64) wk_lo = wv; else wk_hi = wv; }
#else
        if (lane < 16) wexp[kk + lane] = wv;
#endif
    }
#if V_SLICED
    {
        float wm = fmaxf(fabsf(wk_lo), fabsf(wk_hi));
#pragma unroll
        for (int o = 1; o < 64; o <<= 1) wm = fmaxf(wm, SHX(wm, o));
        const float sw = wm > 0.f ? 119.0f / wm : 0.f;
        const int sh4 = 4 * (lane & 7);
        const int q0 = (int)rintf(wk_lo * sw), q1 = (int)rintf(wk_hi * sw);
        const int h0 = (q0 + 8) >> 4, l0 = q0 - 16 * h0, h1 = (q1 + 8) >> 4, l1 = q1 - 16 * h1;
        int PHlo = (int)(((unsigned)h0 & 15u) << sh4), PLlo = (int)(((unsigned)l0 & 15u) << sh4), PHhi = (int)(((unsigned)h1 & 15u) << sh4), PLhi = (int)(((unsigned)l1 & 15u) << sh4);
#pragma unroll
        for (int o = 1; o < 8; o <<= 1) { PHlo |= SHX(PHlo, o); PLlo |= SHX(PLlo, o); PHhi |= SHX(PHhi, o); PLhi |= SHX(PLhi, o); }
        if ((lane & 7) == 0) { *(v2u*)(wpl + 2 * (lane >> 3)) = (v2u){(unsigned)PHlo, (unsigned)PLlo}; *(v2u*)(wpl + 16 + 2 * (lane >> 3)) = (v2u){(unsigned)PHhi, (unsigned)PLhi}; }
        if (lane == 0) *swi = wm * (1.0f / 119.0f);
    }
#endif
}
__device__ __forceinline__ void gather_v(const bf16* xin, float* xrow, const float* wexp, const int* ids, const unsigned char* VT, bf16* xn_out, float* rs_out, int lane,
                                         const float* cv_src, size_t cv_vofs, unsigned char* cv_du, unsigned char* cv_dv, float* cv_su, float* cv_sv, int cv_r0, int f4ord, int f6ord, LAS unsigned char* cv_lds, int idmask = 0x7fffffff  ) {
#if V_I4
    int accH[32], accL[32];
#pragma unroll
    for (int j = 0; j < 32; ++j) { accH[j] = 0; accL[j] = 0; }
    const int id_lo = ids[lane] & idmask, id_hi = ids[64 + lane] & idmask;
    const float w_lo = wexp[lane], w_hi = wexp[64 + lane];
    float wm = fmaxf(fabsf(w_lo), fabsf(w_hi));
#pragma unroll
    for (int o = 1; o < 64; o <<= 1) wm = fmaxf(wm, SHX(wm, o));
    const float sw = wm > 0.f ? 119.0f / wm : 0.f, swinv = wm * (1.0f / 119.0f);
    int PHlo, PLlo, PHhi, PLhi;
    { const int sh4 = 4 * (lane & 7);
      const int q0 = (int)rintf(w_lo * sw), q1 = (int)rintf(w_hi * sw);
      const int h0 = (q0 + 8) >> 4, l0 = q0 - 16 * h0, h1 = (q1 + 8) >> 4, l1 = q1 - 16 * h1;
      PHlo = (int)(((unsigned)h0 & 15u) << sh4); PLlo = (int)(((unsigned)l0 & 15u) << sh4); PHhi = (int)(((unsigned)h1 & 15u) << sh4); PLhi = (int)(((unsigned)l1 & 15u) << sh4);
#pragma unroll
      for (int o = 1; o < 8; o <<= 1) { PHlo |= SHX(PHlo, o); PLlo |= SHX(PLlo, o); PHhi |= SHX(PHhi, o); PLhi |= SHX(PLhi, o); } }
#else
    typedef _Float16 h2_t __attribute__((ext_vector_type(2)));
    h2_t dacc[16];
#pragma unroll
    for (int j = 0; j < 16; ++j) dacc[j] = (h2_t){(_Float16)0.f, (_Float16)0.f};
    const int id_lo = ids[lane], id_hi = ids[64 + lane];
    const float w_lo = wexp[lane], w_hi = wexp[64 + lane];
#endif
#define CV_SRC(r) ((r) >= NEXP ? cv_src + cv_vofs + (size_t)((r) - NEXP) * DM : cv_src + (size_t)(r) * DM)
#define CV_LOAD(r) do { const float* sp_ = CV_SRC(r); _Pragma("unroll") for (int j_ = 0; j_ < 8; ++j_) __builtin_amdgcn_global_load_lds((const unsigned*)(sp_ + j_ * 256 + lane * 4), (LAS unsigned*)(cv_lds + j_ * 1024), 16, 0, 2); } while (0)
#define CV_FIN(r) do { asm volatile("s_waitcnt vmcnt(0)" ::: "memory"); f32x4 cvr[8]; _Pragma("unroll") for (int j_ = 0; j_ < 8; ++j_) cvr[j_] = *(const LAS f32x4*)(cv_lds + j_ * 1024 + lane * 16); \
        const bool isv_ = (r) >= NEXP; const int rr_ = isv_ ? (r) - NEXP : (r); \
        if ((U_I4 && !isv_) || (V_I4 && isv_)) row_i4_finish(cvr, (isv_ ? cv_dv + (size_t)rr_ * VROWB : cv_du + (size_t)rr_ * UROWB), (isv_ ? cv_sv : cv_su) + rr_, lane); else row_fp4_finish(cvr, (isv_ ? cv_dv + (size_t)rr_ * VROWB : cv_du + (size_t)rr_ * UROWB), (isv_ ? cv_sv : cv_su) + rr_, f4ord, lane); asm volatile("s_waitcnt lgkmcnt(0)" ::: "memory"); } while (0)
    if (cv_src) CV_LOAD(cv_r0);
    constexpr int GB = 16;
    for (int kk = 0; kk < 128; kk += GB) {
        if (cv_src && kk > 0 && (kk & 31) == 0) { const int rdone = cv_r0 + (kk >> 5) - 1; CV_FIN(rdone); CV_LOAD(rdone + 1); }
        v4u va[GB];
#pragma unroll
        for (int e = 0; e < GB; ++e) { const int id = __builtin_amdgcn_readlane(kk < 64 ? id_lo : id_hi, (kk + e) & 63); va[e] = *(const v4u*)(VT + (size_t)id * VROWB + lane * 16); }
#if V_I4
#pragma unroll
        for (int g = 0; g < GB / 8; ++g) {
            const int ph = __builtin_amdgcn_readlane(kk < 64 ? PHlo : PHhi, (kk & 63) + 8 * g), pl = __builtin_amdgcn_readlane(kk < 64 ? PLlo : PLhi, (kk & 63) + 8 * g);
#pragma unroll
            for (int d = 0; d < 4; ++d) {
                unsigned a[8], s1[8], s2[8];
#pragma unroll
                for (int k = 0; k < 8; ++k) a[k] = d == 0 ? va[8 * g + k].x : (d == 1 ? va[8 * g + k].y : (d == 2 ? va[8 * g + k].z : va[8 * g + k].w));
#pragma unroll
                for (int m = 0; m < 4; ++m) { const unsigned x = a[2 * m], y = a[2 * m + 1];
                    s1[2 * m] = (x & 0x0F0F0F0Fu) | ((y << 4) & 0xF0F0F0F0u); s1[2 * m + 1] = ((x >> 4) & 0x0F0F0F0Fu) | (y & 0xF0F0F0F0u); }
#pragma unroll
                for (int r = 0; r < 8; ++r) if (!(r & 2)) { s2[r] = __builtin_amdgcn_perm(s1[r | 2], s1[r], 0x06020400u); s2[r | 2] = __builtin_amdgcn_perm(s1[r | 2], s1[r], 0x07030501u); }
#pragma unroll
                for (int r = 0; r < 8; ++r) if (!(r & 4)) { const unsigned t0 = __builtin_amdgcn_perm(s2[r | 4], s2[r], 0x05040100u), t1 = __builtin_amdgcn_perm(s2[r | 4], s2[r], 0x07060302u);
                    accH[8 * d + r] = __builtin_amdgcn_sdot8((int)t0, ph, accH[8 * d + r], false); accL[8 * d + r] = __builtin_amdgcn_sdot8((int)t0, pl, accL[8 * d + r], false);
                    accH[8 * d + (r | 4)] = __builtin_amdgcn_sdot8((int)t1, ph, accH[8 * d + (r | 4)], false); accL[8 * d + (r | 4)] = __builtin_amdgcn_sdot8((int)t1, pl, accL[8 * d + (r | 4)], false); }
            }
            __builtin_amdgcn_sched_barrier(0);
        }
#else
#pragma unroll
        for (int e = 0; e < GB; ++e) { const float we = __builtin_bit_cast(float, __builtin_amdgcn_readlane(__builtin_bit_cast(int, kk < 64 ? w_lo : w_hi), (kk + e) & 63)); const h2_t w2 = (h2_t){(_Float16)we, (_Float16)we};
            const unsigned vw[4] = {va[e].x, va[e].y, va[e].z, va[e].w};
#pragma unroll
            for (int dq = 0; dq < 4; ++dq) { dacc[4 * dq] = __builtin_elementwise_fma(w2, __builtin_bit_cast(h2_t, __builtin_amdgcn_cvt_scalef32_pk_f16_fp4(vw[dq], 1.0f, 0)), dacc[4 * dq]); dacc[4 * dq + 1] = __builtin_elementwise_fma(w2, __builtin_bit_cast(h2_t, __builtin_amdgcn_cvt_scalef32_pk_f16_fp4(vw[dq], 1.0f, 1)), dacc[4 * dq + 1]);
                dacc[4 * dq + 2] = __builtin_elementwise_fma(w2, __builtin_bit_cast(h2_t, __builtin_amdgcn_cvt_scalef32_pk_f16_fp4(vw[dq], 1.0f, 2)), dacc[4 * dq + 2]); dacc[4 * dq + 3] = __builtin_elementwise_fma(w2, __builtin_bit_cast(h2_t, __builtin_amdgcn_cvt_scalef32_pk_f16_fp4(vw[dq], 1.0f, 3)), dacc[4 * dq + 3]); }
            __builtin_amdgcn_sched_barrier(0); }
#endif
    }
    if (cv_src) { CV_FIN(cv_r0 + 3); }
#undef CV_SRC
#undef CV_FIN
#undef CV_LOAD
    (void)f6ord;
    int ln2 = lane; asm volatile("" : "+v"(ln2));
    f32x2 acc[16];
#pragma unroll
    for (int j = 0; j < 8; ++j) { const v2u bw = *(const v2u*)(xin + j * 256 + ln2 * 4);
#if V_I4
        acc[2 * j] = (f32x2){bflo(bw.x) + (float)(16 * accH[4 * j] + accL[4 * j]) * swinv, bfhi(bw.x) + (float)(16 * accH[4 * j + 1] + accL[4 * j + 1]) * swinv};
        acc[2 * j + 1] = (f32x2){bflo(bw.y) + (float)(16 * accH[4 * j + 2] + accL[4 * j + 2]) * swinv, bfhi(bw.y) + (float)(16 * accH[4 * j + 3] + accL[4 * j + 3]) * swinv}; }
#else
        acc[2 * j] = (f32x2){bflo(bw.x) + (float)dacc[2 * j].x, bfhi(bw.x) + (float)dacc[2 * j].y}; acc[2 * j + 1] = (f32x2){bflo(bw.y) + (float)dacc[2 * j + 1].x, bfhi(bw.y) + (float)dacc[2 * j + 1].y}; }
#endif
    if (xrow) {
#pragma unroll
        for (int j = 0; j < 8; ++j) *(f32x4*)(xrow + j * 256 + ln2 * 4) = (f32x4){acc[2 * j].x, acc[2 * j].y, acc[2 * j + 1].x, acc[2 * j + 1].y};
    }
    if (xn_out) {
        float s2 = 0.f;
#pragma unroll
        for (int j = 0; j < 16; ++j) s2 += acc[j].x * acc[j].x + acc[j].y * acc[j].y;
        const float st2 = wave_sum(s2, lane);
        if (ln2 < 8) rs_out[ln2] = ln2 == 0 ? st2 : 0.f;
#pragma unroll
        for (int j = 0; j < 8; ++j) { v2u w0; w0.x = pk2(acc[2 * j].x, acc[2 * j].y); w0.y = pk2(acc[2 * j + 1].x, acc[2 * j + 1].y);
            *(v2u*)(xn_out + j * 256 + ln2 * 4) = w0; }
    }
}

#if V_SLICED
__device__ __forceinline__ void gather_v_sliced(bf16* xrows  , float* xout  , const int* WPL, const float* SWI, const int* IDS, const unsigned char* VT,
                                                float* ssq  , int uidx, int x, int lane,
                                                const float* cv_src, size_t cv_vofs, unsigned char* cv_du, unsigned char* cv_dv, float* cv_su, float* cv_sv, int cv_r0, int f4ord, LAS unsigned char* cv_lds) {
    static_assert(V_I4 && U_I4, "sliced v sub-pass: int4 tables");
    constexpr int LPT = 64 / V_SLICES, TPW = V_SLICES, SROW = 1024 / V_SLICES;
    const int c = lane & (LPT - 1), L = LPT * x + c, m = TPW * uidx + lane / LPT;
    int accH[32], accL[32];
#pragma unroll
    for (int j = 0; j < 32; ++j) { accH[j] = 0; accL[j] = 0; }
    const int* idp = IDS + (size_t)m * 128; const int* wp = WPL + (size_t)m * 32;
    const unsigned lofs = (unsigned)c * 16u;
#define CV_SRC(r) ((r) >= NEXP ? cv_src + cv_vofs + (size_t)((r) - NEXP) * DM : cv_src + (size_t)(r) * DM)
#define CV_LOAD(r, slot) do { const float* sp_ = CV_SRC(r); _Pragma("unroll") for (int j_ = 0; j_ < 8; ++j_) __builtin_amdgcn_global_load_lds((const unsigned*)(sp_ + j_ * 256 + lane * 4), (LAS unsigned*)(cv_lds + (slot) * 8192 + j_ * 1024), 16, 0, 2); } while (0)
#define CV_FIN(r, slot) do { asm volatile("s_waitcnt vmcnt(0)" ::: "memory"); f32x4 cvr[8]; _Pragma("unroll") for (int j_ = 0; j_ < 8; ++j_) cvr[j_] = *(const LAS f32x4*)(cv_lds + (slot) * 8192 + j_ * 1024 + lane * 16); \
        const bool isv_ = (r) >= NEXP; const int rr_ = isv_ ? (r) - NEXP : (r); \
        row_i4_finish(cvr, (isv_ ? cv_dv + (size_t)rr_ * SROW : cv_du + (size_t)rr_ * UROWB), (isv_ ? cv_sv : cv_su) + rr_, lane, isv_); asm volatile("s_waitcnt lgkmcnt(0)" ::: "memory"); } while (0)
    typedef int v4i_ __attribute__((ext_vector_type(4)));
    v4i_ idn[4], pln;
#pragma unroll
    for (int q = 0; q < 4; ++q) idn[q] = *(const v4i_*)(idp + 4 * q);
    pln = *(const v4i_*)wp;
    constexpr int GB = 16;
    for (int kk = 0; kk < 128; kk += GB) {
        const int idc[16] = {idn[0].x, idn[0].y, idn[0].z, idn[0].w, idn[1].x, idn[1].y, idn[1].z, idn[1].w, idn[2].x, idn[2].y, idn[2].z, idn[2].w, idn[3].x, idn[3].y, idn[3].z, idn[3].w};
        const int plc[4] = {pln.x, pln.y, pln.z, pln.w};
        v4u va[GB];
#pragma unroll
        for (int e = 0; e < GB; ++e) va[e] = *(const v4u*)(VT + (size_t)((unsigned)idc[e] * (unsigned)SROW + lofs));
        { const int kn = kk + GB < 128 ? kk + GB : kk;
#pragma unroll
          for (int q = 0; q < 4; ++q) idn[q] = *(const v4i_*)(idp + kn + 4 * q);
          pln = *(const v4i_*)(wp + (kn >> 2)); }
#pragma unroll
        for (int g = 0; g < GB / 8; ++g) {
            const int ph = plc[2 * g], pl = plc[2 * g + 1];
#pragma unroll
            for (int d = 0; d < 4; ++d) {
                unsigned a[8], s1[8], s2[8];
#pragma unroll
                for (int k = 0; k < 8; ++k) a[k] = d == 0 ? va[8 * g + k].x : (d == 1 ? va[8 * g + k].y : (d == 2 ? va[8 * g + k].z : va[8 * g + k].w));
#pragma unroll
                for (int mm = 0; mm < 4; ++mm) { const unsigned xx = a[2 * mm], yy = a[2 * mm + 1];
                    s1[2 * mm] = (xx & 0x0F0F0F0Fu) | ((yy << 4) & 0xF0F0F0F0u); s1[2 * mm + 1] = ((xx >> 4) & 0x0F0F0F0Fu) | (yy & 0xF0F0F0F0u); }
#pragma unroll
                for (int r = 0; r < 8; ++r) if (!(r & 2)) { s2[r] = __builtin_amdgcn_perm(s1[r | 2], s1[r], 0x06020400u); s2[r | 2] = __builtin_amdgcn_perm(s1[r | 2], s1[r], 0x07030501u); }
#pragma unroll
                for (int r = 0; r < 8; ++r) if (!(r & 4)) { const unsigned t0 = __builtin_amdgcn_perm(s2[r | 4], s2[r], 0x05040100u), t1 = __builtin_amdgcn_perm(s2[r | 4], s2[r], 0x07060302u);
                    accH[8 * d + r] = __builtin_amdgcn_sdot8((int)t0, ph, accH[8 * d + r], false); accL[8 * d + r] = __builtin_amdgcn_sdot8((int)t0, pl, accL[8 * d + r], false);
                    accH[8 * d + (r | 4)] = __builtin_amdgcn_sdot8((int)t1, ph, accH[8 * d + (r | 4)], false); accL[8 * d + (r | 4)] = __builtin_amdgcn_sdot8((int)t1, pl, accL[8 * d + (r | 4)], false); }
            }
            __builtin_amdgcn_sched_barrier(0);
        }
    }
#undef CV_FIN
#undef CV_LOAD
    (void)f4ord;
    int L2_ = L, m2_ = m; asm volatile("" : "+v"(L2_), "+v"(m2_));
    f32x4 cra[8], crb[8], crc[8], crd[8];
    if (cv_src) { int ln_ = lane; asm volatile("" : "+v"(ln_)); row_fp6_load(CV_SRC(cv_r0), cra, ln_); row_fp6_load(CV_SRC(cv_r0 + 1), crb, ln_); row_fp6_load(CV_SRC(cv_r0 + 2), crc, ln_); row_fp6_load(CV_SRC(cv_r0 + 3), crd, ln_); }
    const float swinv = SWI[m2_];
    bf16* xr = xrows + (size_t)m2_ * DM + 4 * L2_;
    f32x2 acc[16];
#pragma unroll
    for (int j = 0; j < 8; ++j) { const v2u bw = *(const v2u*)(xr + j * 256);
        acc[2 * j] = (f32x2){bflo(bw.x) + (float)(16 * accH[4 * j] + accL[4 * j]) * swinv, bfhi(bw.x) + (float)(16 * accH[4 * j + 1] + accL[4 * j + 1]) * swinv};
        acc[2 * j + 1] = (f32x2){bflo(bw.y) + (float)(16 * accH[4 * j + 2] + accL[4 * j + 2]) * swinv, bfhi(bw.y) + (float)(16 * accH[4 * j + 3] + accL[4 * j + 3]) * swinv}; }
    if (xout) {
        float* xo_ = xout + (size_t)m2_ * DM + 4 * L2_;
#pragma unroll
        for (int j = 0; j < 8; ++j) *(f32x4*)(xo_ + j * 256) = (f32x4){acc[2 * j].x, acc[2 * j].y, acc[2 * j + 1].x, acc[2 * j + 1].y};
    } else {
        float sq = 0.f;
#pragma unroll
        for (int j = 0; j < 16; ++j) sq += acc[j].x * acc[j].x + acc[j].y * acc[j].y;
#pragma unroll
        for (int o = 1; o < LPT; o <<= 1) sq += SHX(sq, o);
        if ((L2_ & (LPT - 1)) == 0) {
#pragma unroll
            for (int q = 0; q < 8 / V_SLICES; ++q) ssq[(size_t)m2_ * 8 + L2_ / LPT + q * V_SLICES] = q == 0 ? sq : 0.f; }
#pragma unroll
        for (int j = 0; j < 8; ++j) { v2u w0; w0.x = pk2(acc[2 * j].x, acc[2 * j].y); w0.y = pk2(acc[2 * j + 1].x, acc[2 * j + 1].y); *(v2u*)(xr + j * 256) = w0; }
    }
    if (cv_src) {
#define CV_FINR(V, r) do { const bool isv_ = (r) >= NEXP; const int rr_ = isv_ ? (r) - NEXP : (r); \
        row_i4_finish(V, (isv_ ? cv_dv + (size_t)rr_ * SROW : cv_du + (size_t)rr_ * UROWB), (isv_ ? cv_sv : cv_su) + rr_, lane, isv_); } while (0)
        CV_FINR(cra, cv_r0); CV_FINR(crb, cv_r0 + 1); CV_FINR(crc, cv_r0 + 2); CV_FINR(crd, cv_r0 + 3);
#undef CV_FINR
#undef CV_SRC
    }
}
#endif

__device__ __forceinline__ int lane_id_volatile() { int l_; asm volatile("v_mbcnt_lo_u32_b32 %0, -1, 0\n\tv_mbcnt_hi_u32_b32 %0, -1, %0" : "=v"(l_)); return l_; }
struct Args { const float* in[16]; float* out; unsigned char* ws; int ph_lo, ph_hi; };
constexpr int NPL = 7 + V_SLICED, NPH = 2 + DEPTH * NPL;

__global__ void __launch_bounds__(NWAVES * 64, 2) mk_fwd(Args args) {
    extern __shared__ __attribute__((aligned(16))) unsigned char lds[];
    LAS unsigned char* ldsl = (LAS unsigned char*)lds;
    volatile LAS unsigned* MISC = (volatile LAS unsigned*)(ldsl + MISC_OFF);
    const int G = gridDim.x; const int bx = blockIdx.x; const int vcu = (G % 8 == 0) ? (bx % 8) * (G / 8) + bx / 8 : bx;
    const int NGW = G * NWAVES;
    const int wave_s = __builtin_amdgcn_readfirstlane((int)threadIdx.x >> 6);
#define CAS __attribute__((address_space(4)))
#define GIN(k) ((const float*)(const GAS float*)ap->in[k])
#define PH_BEGIN() \
    int lane_; asm volatile("v_mbcnt_lo_u32_b32 %0, -1, 0\n\tv_mbcnt_hi_u32_b32 %0, -1, %0" : "=v"(lane_)); const int lane = lane_, wave = wave_s, tid = wave_s * 64 + lane_; const int gw = vcu * NWAVES + wave; \
    const CAS Args* ap = (const CAS Args*)__builtin_amdgcn_kernarg_segment_ptr(); asm volatile("" : "+s"(ap)); \
    GAS unsigned char* wsg = (GAS unsigned char*)ap->ws; unsigned char* ws = (unsigned char*)wsg; \
    const float* x_in = GIN(0); float* xo = (float*)(GAS float*)ap->out; \
    bf16* WTIN = (bf16*)(ws + WS_WTIN); bf16* WTOUT = (bf16*)(ws + WS_WTOUT); bf16* WTPQ = (bf16*)(ws + WS_WTPQ); bf16* WTKV = (bf16*)(ws + WS_WTKV); \
    bf16* XN = (bf16*)(ws + WS_XN); bf16* PROJ = (bf16*)(ws + WS_PROJ); bf16* OD = (bf16*)(ws + WS_OD); bf16* MIX = (bf16*)(ws + WS_MIX); bf16* PQ = (bf16*)(ws + WS_PQ); \
    unsigned char* UTAB = ws + WS_UTAB; unsigned char* VTAB = ws + WS_VTAB; float* USC = (float*)(ws + WS_USC); float* VSC = (float*)(ws + WS_VSC); bf16* KEYS = (bf16*)(ws + WS_KEYS); \
    bf16* MEMN = (bf16*)(ws + WS_MEMN); bf16* MEMKV = (bf16*)(ws + WS_MEMKV); \
    float* ROPEC = (float*)(ws + WS_ROPE); float* ROPES = ROPEC + 4096 * 16; \
    int* IDS = (int*)(ws + WS_IDS); float* GATES = (float*)(ws + WS_GATES); float* SSP = (float*)(ws + WS_SSP); float* RS = (float*)(ws + WS_RS); float* WEXP = (float*)(ws + WS_WEXP); \
    const float* xcur = (l == 0) ? x_in : xo; const float* gq = GIN(4) + (size_t)l * 6 * 128; \
    (void)lane; (void)gw; (void)x_in; (void)xo; (void)WTIN; (void)WTOUT; (void)WTPQ; (void)WTKV; (void)XN; (void)PROJ; (void)OD; (void)MIX; (void)PQ; (void)UTAB; (void)VTAB; (void)USC; (void)VSC; (void)KEYS; (void)MEMN; (void)MEMKV; (void)ROPEC; (void)ROPES; (void)IDS; (void)GATES; (void)SSP; (void)RS; (void)WEXP; (void)xcur; (void)gq;
    for (int u = (int)threadIdx.x; u < (LDS_BYTES - LDSCTL_OFF) / 4; u += NWAVES * 64) ((LAS unsigned*)(ldsl + LDSCTL_OFF))[u] = 0u;
    __syncthreads();
    const int lo = args.ph_lo, hi = args.ph_hi;
    XcdBarrier bar; bar.bar = (unsigned*)(args.ws + WS_CTL) + CW_BAR; bar.x = 0; bar.st = nullptr;
    if (hi - lo > 1) bar = xcd_barrier_post((unsigned*)(args.ws + WS_CTL) + CW_BAR, MISC + 8, threadIdx.x == 0);
#define IN(k) (lo <= (k) && (k) < hi)
#define T0() (wave_s == 0 && lane_id_volatile() == 0)
#define SEAM(k) do { if (IN(k) && IN((k) + 1)) xcd_barrier(bar, T0()); } while (0)

    if (PHEN(10) && IN(0)) for (int rep_ = 0; rep_ < PREP(10); ++rep_) { const int l = 0; PH_BEGIN();
        LAS float* scr = (LAS float*)(ldsl + wave * 16384);
        constexpr int I_IN = 32 * 160, I_OUT = 32 * 64, I_PQ = 32 * 64, I_KV = 32 * 32, I_L = I_IN + I_OUT + I_PQ + I_KV;
        for (int rep2_ = 0; rep2_ < PREP(12); ++rep2_)
        for (int it = gw; it < DEPTH * I_L; it += NGW) {
            const int l = it / I_L; int r = it % I_L;
            if (r < I_IN) { transpose_item(GIN(3) + (size_t)l * DM * INW, GIN(2) + l * DM, DM, INW, WTIN + (size_t)l * INW * DM, scr, r, lane); continue; } r -= I_IN;
            if (r < I_OUT) { transpose_item(GIN(10) + (size_t)l * MIXW * DM, nullptr, MIXW, DM, WTOUT + (size_t)l * DM * MIXW, scr, r, lane); continue; } r -= I_OUT;
            if (r < I_PQ) { transpose_item(GIN(12) + (size_t)l * DM * DM, GIN(11) + l * DM, DM, DM, WTPQ + (size_t)l * DM * DM, scr, r, lane); continue; } r -= I_PQ;
            transpose_item(GIN(9) + (size_t)l * DM * KVW, GIN(8) + l * DM, DM, KVW, WTKV + (size_t)l * KVW * DM, scr, r, lane);
        }
        for (int m = gw; m < NB * NMEM; m += NGW) rms_row_to_bf16(GIN(1) + (size_t)m * DM, MEMN + (size_t)m * DM, lane);
    }
    SEAM(0);
    if (PHEN(11) && IN(1)) { const int l = 0; PH_BEGIN();
        constexpr int NGEMM_ = (NB * NMEM / 256) * (DEPTH * KVW / 256);
        const int Gall = gridDim.x; const bool split_ = Gall > NGEMM_;
        if (!split_ || bx >= NGEMM_) {
            const int vcu = split_ ? bx - NGEMM_ : bx, G = split_ ? Gall - NGEMM_ : Gall; const int gw = vcu * NWAVES + wave, NGW = G * NWAVES;
        const int f6ord = fp6_order_probe(); const int f4ord = fp4_order_probe(); (void)f4ord;
        if (vcu == 0 && tid == 0) { ((int*)ws)[64] = f6ord; ((int*)ws)[65] = f4ord; }
        for (int rep3_ = 0; rep3_ < PREP(13); ++rep3_)
        for (int rw = gw; rw < 2 * NEXP; rw += 4 * NGW) {
            f32x4 va[8], vb[8], vc[8], vd[8];
            const int r1 = rw + NGW, r2 = rw + 2 * NGW, r3 = rw + 3 * NGW; const int NR = 2 * NEXP;
#define TSRC(r) (((r) >= NEXP ? GIN(15) + (size_t)((r) - NEXP) * DM : GIN(14) + (size_t)(r) * DM))
#define TDST(r) (((r) >= NEXP ? VTAB + (size_t)((r) - NEXP) * (V_SLICED ? 1024 / V_SLICES : VROWB) : UTAB + (size_t)(r) * UROWB))
#define TSCL(r) (((r) >= NEXP ? VSC + ((r) - NEXP) : USC + (r)))
            row_fp6_load(TSRC(rw), va, lane); if (r1 < NR) row_fp6_load(TSRC(r1), vb, lane); if (r2 < NR) row_fp6_load(TSRC(r2), vc, lane); if (r3 < NR) row_fp6_load(TSRC(r3), vd, lane);
#define TFIN(V, r) do { if ((U_I4 && (r) < NEXP) || (V_I4 && (r) >= NEXP)) row_i4_finish(V, TDST(r), TSCL(r), lane, V_SLICED && (r) >= NEXP); else if ((U_FP4 && (r) < NEXP) || (V_FP4 && (r) >= NEXP)) row_fp4_finish(V, TDST(r), TSCL(r), f4ord, lane); else row_fp6_finish(V, TDST(r), TSCL(r), f6ord, lane); } while (0)
            TFIN(va, rw); if (r1 < NR) TFIN(vb, r1); if (r2 < NR) TFIN(vc, r2); if (r3 < NR) TFIN(vd, r3);
#undef TFIN
#undef TSRC
#undef TDST
#undef TSCL
        }
        {
            const size_t gt = (size_t)vcu * (NWAVES * 64) + tid, NT_ = (size_t)G * NWAVES * 64;
            const size_t nk8 = (size_t)DEPTH * 8 * 2 * 128 * 128 / 8;
            for (size_t i = gt; i < nk8; i += NT_) {
                const float* src = GIN(13);
                const f32x4 a = *(const f32x4*)(src + i * 8), b = *(const f32x4*)(src + i * 8 + 4);
                v4u o; o.x = pk2(a.x, a.y); o.y = pk2(a.z, a.w); o.z = pk2(b.x, b.y); o.w = pk2(b.z, b.w);
                *(v4u*)(KEYS + i * 8) = o;
            }
            for (size_t i = gt; i < 4096 * 16; i += NT_) {
                const int pos = (int)(i >> 4), fi = (int)(i & 15);
                const double inv = exp2(-(double)fi * (18.931568569324174 / 16.0));
                const double rev = (double)pos * inv * 0.15915494309189535;
                const float fr = (float)(rev - floor(rev));
                ROPEC[i] = __builtin_amdgcn_cosf(fr); ROPES[i] = __builtin_amdgcn_sinf(fr);
            }
        }
        for (int m = gw; m < T; m += NGW) row_to_bf16_rs(x_in + (size_t)m * DM, XN + (size_t)m * DM, RS + (size_t)m * 8, lane);
        }
        pg8::Gemm g{MEMN, WTKV, NB * NMEM, DEPTH * KVW, DM}; pg8::StaticOrder S; S.init(NB * NMEM, DEPTH * KVW, Gall, bx);
        EpiProjT<true> E{MEMKV, GIN(4), nullptr, nullptr, (LAS float*)(ldsl + EPI_P_OFF), 0, nullptr};
        pg8::gemm_phase<EpiProjT<true>, pg8::StaticOrder, false>((PG8_LAS unsigned char*)ldsl, g, S, E, nullptr, tid);
    }
    SEAM(1);

    for (int l = 0; l < DEPTH; ++l) {
        const int pb = 2 + l * NPL;
        const float lam_init = 0.8f - 0.6f * expf(-0.3f * (float)l);
        if (PHEN(0) && IN(pb + 0)) { PH_BEGIN();
            for (int rep_ = 0; rep_ < PREP(0); ++rep_) {
            pg8::Gemm g{XN, WTIN + (size_t)l * INW * DM + (size_t)OFF_NQ * DM, T, INW - OFF_NQ, DM}; pg8::StaticOrder S; S.init(T, INW - OFF_NQ, G, bx);
            EpiProj E{PROJ, gq, ROPEC, ROPES, (LAS float*)(ldsl + EPI_P_OFF), OFF_NQ / 256, RS};
            pg8::gemm_phase<EpiProj, pg8::StaticOrder, false>((PG8_LAS unsigned char*)ldsl, g, S, E, nullptr, tid); }
        }
        SEAM(pb + 0);
        if (PHEN(3) && IN(pb + 1)) for (int rep_ = 0; rep_ < PREP(3); ++rep_) { PH_BEGIN();
            {
            pg8::Gemm g{XN, WTIN + (size_t)l * INW * DM, T, OFF_NQ, DM}; pg8::StaticOrder S; S.init(T, OFF_NQ, G, bx);
            EpiProj E{PROJ, gq, ROPEC, ROPES, (LAS float*)(ldsl + EPI_P_OFF), 0, RS};
            pg8::gemm_phase<EpiProj, pg8::StaticOrder, false>((PG8_LAS unsigned char*)ldsl, g, S, E, nullptr, tid);
            }
            float negm;
            { float a4 = fmaxf(fabsf(gq[512 + lane]), fabsf(gq[576 + lane])), a5 = fmaxf(fabsf(gq[640 + lane]), fabsf(gq[704 + lane]));
#pragma unroll
              for (int o = 1; o < 64; o <<= 1) { a4 = fmaxf(a4, SHX(a4, o)); a5 = fmaxf(a5, SHX(a5, o)); }
              negm = -11.313708498984761f * a4 * a5 * 1.4426950408889634f; }
            const int nshort = (G > 128) ? 128 : 0;
            for (int u = (nshort ? bx - (G - 128) : bx); u >= 0 && u < 128; u += (nshort ? 128 : G)) {
                const int rb = u & 15, h = (u >> 4) & 3, b = u >> 6; const int r0 = rb * 4, kr0 = min(max(r0 - 4, 0), 52);
                __syncthreads();
                if (tid < 465) ((float*)(lds + att::SHM_NA_BIAS))[tid] = GIN(7)[((size_t)l * 4 + h) * 465 + tid] * 1.4426950408889634f;
                att::attn_body<1, 1, INW, INW, INW, MIXW, true>(PROJ + (size_t)(b * SEQ + r0 * 64) * INW + OFF_NQ + h * 128,
                    PROJ + (size_t)(b * SEQ + kr0 * 64) * INW + OFF_NK + h * 128, PROJ + (size_t)(b * SEQ + kr0 * 64) * INW + OFF_NV + h * 128,
                    MIX + (size_t)(b * SEQ + r0 * 64) * MIXW + 1024 + h * 128, 768, (char*)lds, r0, kr0, 0.f, tid);
            }
            for (int u = (nshort ? bx - (G - 128) : bx); u >= 0 && u < 128; u += (nshort ? 128 : G)) {
                const int qb = u & 15, h = (u >> 4) & 3, b = u >> 6;
                __syncthreads();
                att::attn_body<0, 2, INW, DEPTH * KVW, DEPTH * KVW, MIXW, true>(PROJ + (size_t)(b * SEQ + qb * 256) * INW + OFF_MQ + h * 128,
                    MEMKV + (size_t)(b * NMEM) * (DEPTH * KVW) + l * KVW + h * 128, MEMKV + (size_t)(b * NMEM) * (DEPTH * KVW) + l * KVW + 512 + h * 128,
                    MIX + (size_t)(b * SEQ + qb * 256) * MIXW + 1536 + h * 128, NMEM, (char*)lds, 0, 0, negm, tid);
            }
            __syncthreads();
        }
        SEAM(pb + 1);
        if (PHEN(4) && IN(pb + 2)) for (int rep_ = 0; rep_ < PREP(4); ++rep_) { PH_BEGIN();
            float negd;
            { float a0 = fmaxf(fabsf(gq[lane]), fabsf(gq[64 + lane])), a1 = fmaxf(fabsf(gq[128 + lane]), fabsf(gq[192 + lane]));
#pragma unroll
              for (int o = 1; o < 64; o <<= 1) { a0 = fmaxf(a0, SHX(a0, o)); a1 = fmaxf(a1, SHX(a1, o)); }
              negd = -11.313708498984761f * a0 * a1 * 1.4426950408889634f; }
            for (int u = vcu; u < 256; u += G) {
                const int qb = u & 15, c = (u >> 4) & 1, h = (u >> 5) & 3, b = u >> 7;
                __syncthreads();
                att::attn_wide_body<INW, INW, INW, 1024>(PROJ + (size_t)(b * SEQ + qb * 256) * INW + OFF_DQ + h * 256 + c * 128,
                    PROJ + (size_t)(b * SEQ) * INW + OFF_DK + h * 256 + c * 128, PROJ + (size_t)(b * SEQ) * INW + OFF_DV + h * 256,
                    OD + ((size_t)c * T + b * SEQ + qb * 256) * 1024 + h * 256, SEQ, ldsl, (char*)lds, negd, tid);
            }
            __syncthreads();
        }
        SEAM(pb + 2);
        if (PHEN(6) && IN(pb + 3)) { PH_BEGIN();
            const float* lq = GIN(5) + (size_t)l * 4 * 128;
            const float d01 = wave_sum(lq[lane] * lq[128 + lane] + lq[64 + lane] * lq[192 + lane], lane);
            const float d23 = wave_sum(lq[256 + lane] * lq[384 + lane] + lq[320 + lane] * lq[448 + lane], lane);
            const float lam = expf(d01) - expf(d23) + lam_init;
            const float* sg_ = GIN(6) + (size_t)l * 256; const int sub = lane & 15, h = lane >> 4;
            float gs[16];
#pragma unroll
            for (int j = 0; j < 16; ++j) gs[j] = sg_[sub * 16 + j] * (1.0f - lam_init);
            for (int m = gw; m < T; m += NGW) {
                const bf16* o0 = OD + (size_t)m * 1024 + h * 256 + sub * 16; const bf16* o1 = o0 + (size_t)T * 1024;
                float v[16]; float s = 0.f;
#pragma unroll
                for (int q = 0; q < 2; ++q) { const v4u a = *(const v4u*)(o0 + q * 8), b2 = *(const v4u*)(o1 + q * 8);
                    v[q * 8 + 0] = bflo(a.x) - lam * bflo(b2.x); v[q * 8 + 1] = bfhi(a.x) - lam * bfhi(b2.x); v[q * 8 + 2] = bflo(a.y) - lam * bflo(b2.y); v[q * 8 + 3] = bfhi(a.y) - lam * bfhi(b2.y);
                    v[q * 8 + 4] = bflo(a.z) - lam * bflo(b2.z); v[q * 8 + 5] = bfhi(a.z) - lam * bfhi(b2.z); v[q * 8 + 6] = bflo(a.w) - lam * bflo(b2.w); v[q * 8 + 7] = bfhi(a.w) - lam * bfhi(b2.w); }
#pragma unroll
                for (int j = 0; j < 16; ++j) s += v[j] * v[j];
                s += SHX(s, 1); s += SHX(s, 2); s += SHX(s, 4); s += SHX(s, 8);
                const float r = 1.0f / sqrtf(s * (1.f / 256.f) + EPS);
                v4u w0, w1;
                w0.x = pk2(v[0] * r * gs[0], v[1] * r * gs[1]); w0.y = pk2(v[2] * r * gs[2], v[3] * r * gs[3]); w0.z = pk2(v[4] * r * gs[4], v[5] * r * gs[5]); w0.w = pk2(v[6] * r * gs[6], v[7] * r * gs[7]);
                w1.x = pk2(v[8] * r * gs[8], v[9] * r * gs[9]); w1.y = pk2(v[10] * r * gs[10], v[11] * r * gs[11]); w1.z = pk2(v[12] * r * gs[12], v[13] * r * gs[13]); w1.w = pk2(v[14] * r * gs[14], v[15] * r * gs[15]);
                bf16* mp = MIX + (size_t)m * MIXW + h * 256 + sub * 16;
                *(v4u*)mp = w0; *(v4u*)(mp + 8) = w1;
            }
        }
        SEAM(pb + 3);
        if (PHEN(5) && IN(pb + 4)) { PH_BEGIN();
            pg8::Gemm g{MIX, WTOUT + (size_t)l * DM * MIXW, T, DM, MIXW}; pg8::StaticOrder S; S.init(T, DM, G, bx);
            EpiResF32 E{XN, SSP, DM};
            pg8::gemm_phase<EpiResF32, pg8::StaticOrder, false>((PG8_LAS unsigned char*)ldsl, g, S, E, nullptr, tid);
        }
        SEAM(pb + 4);
        if (PHEN(7) && IN(pb + 5)) for (int rep_ = 0; rep_ < PREP(7); ++rep_) { PH_BEGIN();
            pg8::Gemm g{XN, WTPQ + (size_t)l * DM * DM, T, DM, DM}; pg8::StaticOrder S; S.init(T, DM, G, bx);
            pg8::EpiBf16<0> E{PQ, DM, nullptr, 0, 0};
            pg8::gemm_phase<pg8::EpiBf16<0>, pg8::StaticOrder, false>((PG8_LAS unsigned char*)ldsl, g, S, E, nullptr, tid);
            LAS int* lscr = (LAS int*)(ldsl + 65536 + wave * 8192);
            if (G == (T / 256) * (DM / 256)) {
                pg8::Unit u; S.next(0, u);
                asm volatile("s_waitcnt vmcnt(0)" ::: "memory"); __syncthreads();
                {
                    const bf16* ksrc_ = KEYS + ((size_t)l * 8 + u.pn) * 2 * 128 * 128;
#pragma unroll
                    for (int i = 0; i < 8; ++i) { const int ch = i * 512 + tid; const int row = ch >> 4, cc = ch & 15;
                        const v4u kv = *(const v4u*)(ksrc_ + (size_t)row * 128 + cc * 8);
                        *(v4u*)(lds + (row >> 6) * 16384 + (row & 63) * 256 + ((cc * 16) ^ ((row & 7) << 4))) = kv; }
                }
                __syncthreads();
                select_task<true>(PQ, SSP, KEYS + (size_t)l * 8 * 2 * 128 * 128, IDS, GATES, u.pm * 8 + wave, u.pn, lscr, lane, (const char*)lds);
            } else if (hi - lo > 1) {
                xcd_barrier(bar, T0());
                for (int task = gw; task < (T / 32) * 8; task += NGW) select_task<false>(PQ, SSP, KEYS + (size_t)l * 8 * 2 * 128 * 128, IDS, GATES, task >> 3, task & 7, lscr, lane);
            }
        }
        SEAM(pb + 5);
        if (PHEN(9) && IN(pb + 6)) { PH_BEGIN();
            const int f6g = ((const int*)ws)[64], f4g = ((const int*)ws)[65];
#if GATHER_SPLIT
#if V_SLICED
            for (int m = gw; m < T; m += NGW) gather_u(XN + (size_t)m * DM, GIN(11) + (size_t)l * DM, IDS + (size_t)m * 128, GATES + (size_t)m * 128, UTAB + (size_t)l * NEXP * UROWB, USC + l * NEXP, VSC + l * NEXP, nullptr, lane, 0x7fffffff,
                                                       (int*)WEXP + (size_t)m * 32, WEXP + (size_t)T * 32 + m);
        }
        SEAM(pb + 6);
        if (PHEN(9) && IN(pb + 7)) { PH_BEGIN();
            const int f4g = ((const int*)ws)[65];
            const int NSW = NGW / V_SLICES;
            const int xs = gw / NSW;
#if PROBE_VL2
            for (int uidx = gw - xs * NSW; uidx < T / V_SLICES; uidx += NSW)
                gather_v_sliced(XN, (float*)PROJ, (const int*)WEXP, WEXP + (size_t)T * 32, IDS, VTAB + (size_t)l * NEXP * VROWB + (size_t)xs * NEXP * (1024 / V_SLICES), RS, uidx, xs, lane, nullptr, 0, nullptr, nullptr, nullptr, nullptr, 0, f4g, ldsl + wave * 8192);
#endif
            for (int uidx = gw - xs * NSW; uidx < T / V_SLICES; uidx += NSW)
                gather_v_sliced(XN, (l + 1 == DEPTH) ? xo : nullptr, (const int*)WEXP, WEXP + (size_t)T * 32, IDS, VTAB + (size_t)l * NEXP * VROWB + (size_t)xs * NEXP * (1024 / V_SLICES), RS, uidx, xs, lane,
                                (l + 1 < DEPTH) ? GIN(14) + (size_t)(l + 1) * NEXP * DM : nullptr, (size_t)(GIN(15) - GIN(14)), UTAB + (size_t)(l + 1) * NEXP * UROWB, VTAB + (size_t)(l + 1) * NEXP * VROWB, USC + (l + 1) * NEXP, VSC + (l + 1) * NEXP,
                                4 * (xs * (T / V_SLICES) + uidx), f4g, ldsl + wave * 16384);
#else
            for (int m = gw; m < T; m += NGW) gather_u(XN + (size_t)m * DM, GIN(11) + (size_t)l * DM, IDS + (size_t)m * 128, GATES + (size_t)m * 128, UTAB + (size_t)l * NEXP * UROWB, USC + l * NEXP, VSC + l * NEXP, WEXP + (size_t)m * 128, lane);
            asm volatile("s_waitcnt vmcnt(0)" ::: "memory");
#if PROBE_VL2
            for (int m = gw; m < T; m += NGW) gather_v(XN + (size_t)m * DM, (float*)PROJ + (size_t)m * DM, WEXP + (size_t)m * 128, IDS + (size_t)m * 128, VTAB + (size_t)l * NEXP * VROWB, nullptr, RS + m, lane,
                                                       nullptr, 0, nullptr, nullptr, nullptr, nullptr, 0, f4g, f6g, ldsl + wave * 8192, PROBE_VL2 == 1 ? 0x7ff : 0x7fffffff);
#endif
            for (int m = gw; m < T; m += NGW) gather_v(XN + (size_t)m * DM, (l + 1 == DEPTH) ? xo + (size_t)m * DM : nullptr, WEXP + (size_t)m * 128, IDS + (size_t)m * 128, VTAB + (size_t)l * NEXP * VROWB,
                                                       (l + 1 < DEPTH) ? XN + (size_t)m * DM : nullptr, RS + (size_t)m * 8, lane,
                                                       (l + 1 < DEPTH) ? GIN(14) + (size_t)(l + 1) * NEXP * DM : nullptr, (size_t)(GIN(15) - GIN(14)), UTAB + (size_t)(l + 1) * NEXP * UROWB, VTAB + (size_t)(l + 1) * NEXP * VROWB, USC + (l + 1) * NEXP, VSC + (l + 1) * NEXP, 4 * m, f4g, f6g, ldsl + wave * 8192);
#endif
#else
            for (int rep_ = PREP(9) - 1; rep_ >= 0; --rep_)
            for (int m = gw; m < T; m += NGW) gather_token(XN + (size_t)m * DM, rep_ ? (float*)PROJ + (size_t)m * DM : ((l + 1 == DEPTH) ? xo + (size_t)m * DM : nullptr), GIN(11) + (size_t)l * DM, IDS + (size_t)m * 128, GATES + (size_t)m * 128,
                                                           UTAB + (size_t)l * NEXP * UROWB, VTAB + (size_t)l * NEXP * VROWB, USC + l * NEXP, VSC + l * NEXP, (l + 1 < DEPTH && !rep_) ? XN + (size_t)m * DM : nullptr, RS + m, lane,
                                                           (l + 1 < DEPTH && !rep_) ? GIN(14) + (size_t)(l + 1) * NEXP * DM : nullptr, (size_t)(GIN(15) - GIN(14)), UTAB + (size_t)(l + 1) * NEXP * UROWB, VTAB + (size_t)(l + 1) * NEXP * VROWB, USC + (l + 1) * NEXP, VSC + (l + 1) * NEXP, 4 * m, f4g, f6g, ldsl + wave * 8192);
#endif
        }
        SEAM(pb + 6 + V_SLICED);
        if (hi - lo > 1) for (int xb_ = 0; xb_ < (PREP(14) - 1) * 16; ++xb_) xcd_barrier(bar, T0());
    }
#undef IN
#undef SEAM
}

extern "C" void kernel_launch(void* const* d_in, const int* in_sizes, int n_in, void* d_out, int out_size, void* d_ws, size_t ws_size, hipStream_t stream) {
    static int grid = 0;
    if (grid == 0) {
        if (n_in != 16 || out_size != T * DM || ws_size < WS_END) { fprintf(stderr, "kernel_launch: unexpected shapes: n_in %d out %d ws %zu (need >= %zu)\n", n_in, out_size, ws_size, (size_t)WS_END); grid = -1; return; }
        int dev = 0, cus = 0, per_cu = 0;
        if (hipGetDevice(&dev) != hipSuccess || hipDeviceGetAttribute(&cus, hipDeviceAttributeMultiprocessorCount, dev) != hipSuccess) { grid = -1; return; }
        if (hipFuncSetAttribute((const void*)mk_fwd, hipFuncAttributeMaxDynamicSharedMemorySize, LDS_BYTES) != hipSuccess) { fprintf(stderr, "kernel_launch: hipFuncSetAttribute failed\n"); grid = -1; return; }
        if (hipOccupancyMaxActiveBlocksPerMultiprocessor(&per_cu, (const void*)mk_fwd, NWAVES * 64, LDS_BYTES) != hipSuccess || per_cu < 1) { fprintf(stderr, "kernel_launch: occupancy query says %d blocks per CU\n", per_cu); }
        (void)hipGetLastError();
        grid = cus;
    }
    if (grid < 0) return;
    if (hipMemsetAsync((char*)d_ws + WS_CTL, 0, CTL_ZERO_BYTES, stream) != hipSuccess) return;
    Args a{};
    for (int i = 0; i < 16; ++i) a.in[i] = (const float*)d_in[i];
    a.out = (float*)d_out; a.ws = (unsigned char*)d_ws;
#if MK_ONE_LAUNCH
    a.ph_lo = 0; a.ph_hi = NPH;
    hipLaunchKernelGGL(mk_fwd, dim3(grid), dim3(NWAVES * 64), LDS_BYTES, stream, a);
#else
    for (int p = 0; p < NPH; ++p) { a.ph_lo = p; a.ph_hi = p + 1; hipLaunchKernelGGL(mk_fwd, dim3(grid), dim3(NWAVES * 64), LDS_BYTES, stream, a); }
#endif
    const hipError_t le = hipPeekAtLastError();
    if (le != hipSuccess) fprintf(stderr, "kernel_launch: launch failed: %s\n", hipGetErrorName(le));
}
```

```cpp
#include <hip/hip_runtime.h>
#include <cstdio>
#include <cstdint>
namespace pg8 {
#define PG8_LAS __attribute__((address_space(3)))
typedef unsigned short bf16_t;
typedef short bf16x8 __attribute__((ext_vector_type(8)));
typedef float f32x4 __attribute__((ext_vector_type(4)));
typedef unsigned u32x4 __attribute__((ext_vector_type(4)));
constexpr int BM = 256, BK = 64, HALF = 128, HTB = HALF * BK * 2  , STAGE_BYTES = 8 * HTB, NXCD = 8, WGM = 8;

__host__ __device__ __forceinline__ int lds_byte(int r, int c) { const int st = (r >> 4) * 2 + (c >> 5), rr = r & 15, cc = c & 31, ob = rr * 64 + cc * 2; return st * 1024 + (ob ^ (((ob >> 9) & 1) << 5)); }
__host__ __device__ __forceinline__ void stage_rc(int b, int& R, int& C) { const int st = b / 1024, sb = b % 1024, swz = sb ^ (((sb >> 9) & 1) << 5); R = (st >> 1) * 16 + swz / 64; C = (st & 1) * 32 + (swz % 64) / 2; }
__host__ __device__ __forceinline__ int perm32(int rho) { const int n = rho >> 4, i = rho & 15; return 8 * (i >> 2) + 4 * n + (i & 3); }

struct Unit { int pm, pn; };
struct Gemm { const bf16_t* A; const bf16_t* Bt; int M, N, K; };

struct StaticOrder {
    int nM, nN, nwg, G, c;
    __host__ __device__ void init(int M, int N, int G_, int c_) { nM = M / BM; nN = N / BM; nwg = nM * nN; G = G_; c = c_; }
    __host__ __device__ bool next(int i, Unit& u) const {
        const long L = (long)i * G + c; if (L >= nwg) return false;
        int wgid = (int)L; { const int q = nwg / NXCD, r = nwg % NXCD, xcd = wgid % NXCD, off = wgid / NXCD; wgid = (xcd < r ? xcd * (q + 1) : r * (q + 1) + (xcd - r) * q) + off; }
        const int nig = WGM * nN, gid = wgid / nig, fm = gid * WGM, gsz = (nM - fm) < WGM ? (nM - fm) : WGM;
        u.pm = fm + ((wgid % nig) % gsz); u.pn = (wgid % nig) / gsz; return true;
    }
    __device__ __forceinline__ void a_ready(const Unit&) const {}
    __device__ __forceinline__ void done(const Unit&) const {}
};
struct CountedOrder : StaticOrder {
    const unsigned* ready; unsigned need; unsigned* tmo;
    __device__ __forceinline__ void a_ready(const Unit& u) const {
        if (threadIdx.x < 64) {
            const unsigned long long t0 = __builtin_amdgcn_s_memrealtime(); unsigned polls = 0;
            while ((unsigned)__builtin_amdgcn_readfirstlane(__hip_atomic_load(ready + 64 * u.pm, __ATOMIC_RELAXED, __HIP_MEMORY_SCOPE_AGENT)) < need) {
                if ((++polls & 255u) == 0u && __builtin_amdgcn_readfirstlane(__hip_atomic_load(tmo, __ATOMIC_RELAXED, __HIP_MEMORY_SCOPE_AGENT)) != 0u) break;
                if (__builtin_amdgcn_s_memrealtime() - t0 > 2000000ull) {
                    if (threadIdx.x == 0) { unsigned expect = 0u; __hip_atomic_compare_exchange_strong(tmo + 1, &expect, 0x600u | (unsigned)(u.pm & 0xff), __ATOMIC_RELAXED, __ATOMIC_RELAXED, __HIP_MEMORY_SCOPE_AGENT); __hip_atomic_store(tmo, 1u, __ATOMIC_RELAXED, __HIP_MEMORY_SCOPE_AGENT); }
                    break; }
                __builtin_amdgcn_s_sleep(2); }
            __builtin_amdgcn_fence(__ATOMIC_ACQUIRE, "agent");
            asm volatile("s_waitcnt vmcnt(0)" ::: "memory");
        }
#if !defined(BROKEN_HOOK_NO_BARRIER)
        asm volatile("" ::: "memory"); __builtin_amdgcn_s_barrier(); asm volatile("" ::: "memory");
#endif
    }
};

__device__ __forceinline__ unsigned cvt_pk_bf16(float lo, float hi) { unsigned r; asm volatile("v_cvt_pk_bf16_f32 %0, %1, %2" : "=v"(r) : "v"(lo), "v"(hi)); return r; }
typedef float f32x2 __attribute__((ext_vector_type(2)));
__device__ __forceinline__ f32x2 gelu_pk(f32x2 v) {
    const f32x2 av = __builtin_elementwise_abs(v), d = av * 0.2316418882f + 1.0f;
    f32x2 t; t.x = __builtin_amdgcn_rcpf(d.x); t.y = __builtin_amdgcn_rcpf(d.y);
    f32x2 q = t * 0.5307027145f + (-0.7265760135f); q = q * t + 0.7107068705f; q = q * t + (-0.142248368f); q = q * t + 0.127414796f; q = q * t;
    const f32x2 s = (v * v) * (-0.72134752044f);
    f32x2 e; e.x = __builtin_amdgcn_exp2f(s.x); e.y = __builtin_amdgcn_exp2f(s.y);
    const f32x2 m = v * (q * e), r = v - m;
    f32x2 o; o.x = v.x < 0.f ? m.x : r.x; o.y = v.y < 0.f ? m.y : r.y; return o;
}

struct EpiF32 {
    static constexpr bool PERM = false, AFTER_DRAIN = false;
    float* C; int ldc; const float* bias;
    __device__ __forceinline__ void operator()(const f32x4 (&acc)[2][2][4][2], const Unit& u, int wr, int wc, int fr, int fq) const {
        const int row0 = u.pm * BM + wr * 64 + fr, col0 = u.pn * BM + wc * 32 + 4 * fq;
        f32x4 bv[2][2];
#pragma unroll
        for (int bj = 0; bj < 2; ++bj)
#pragma unroll
            for (int n = 0; n < 2; ++n) bv[bj][n] = bias ? *(const f32x4*)(bias + col0 + bj * HALF + n * 16) : (f32x4){0.f, 0.f, 0.f, 0.f};
#pragma unroll
        for (int ai = 0; ai < 2; ++ai)
#pragma unroll
            for (int m = 0; m < 4; ++m) { float* rowp = C + (size_t)(row0 + ai * HALF + m * 16) * ldc + col0;
#pragma unroll
                for (int bj = 0; bj < 2; ++bj)
#pragma unroll
                    for (int n = 0; n < 2; ++n) *(f32x4*)(rowp + bj * HALF + n * 16) = acc[ai][bj][m][n] + bv[bj][n]; }
    }
};
template <int ACT  > struct EpiBf16 {
    static constexpr bool PERM = true, AFTER_DRAIN = false;
    bf16_t* O; int ldc; const float* bias; int split_cols; size_t split_stride;
    __device__ __forceinline__ void operator()(const f32x4 (&acc)[2][2][4][2], const Unit& u, int wr, int wc, int fr, int fq) const {
        const int row0 = u.pm * BM + wr * 64 + fr; int colt = u.pn * BM; bf16_t* base = O;
        if (split_cols) { const int t = colt / split_cols; base += (size_t)t * split_stride; colt -= t * split_cols; }
        const int col0 = colt + wc * 32 + 8 * fq, bcol0 = u.pn * BM + wc * 32 + 8 * fq;
        f32x4 bv[2][2];
#pragma unroll
        for (int bj = 0; bj < 2; ++bj)
#pragma unroll
            for (int n = 0; n < 2; ++n) bv[bj][n] = bias ? *(const f32x4*)(bias + bcol0 + bj * HALF + 4 * n) : (f32x4){0.f, 0.f, 0.f, 0.f};
#pragma unroll
        for (int ai = 0; ai < 2; ++ai)
#pragma unroll
            for (int m = 0; m < 4; ++m) { bf16_t* rowp = base + (size_t)(row0 + ai * HALF + m * 16) * ldc + col0;
#pragma unroll
                for (int bj = 0; bj < 2; ++bj) { f32x4 v0 = acc[ai][bj][m][0] + bv[bj][0], v1 = acc[ai][bj][m][1] + bv[bj][1];
                    if (ACT == 1) { f32x2 a = gelu_pk((f32x2){v0[0], v0[1]}), b = gelu_pk((f32x2){v0[2], v0[3]}), c = gelu_pk((f32x2){v1[0], v1[1]}), d = gelu_pk((f32x2){v1[2], v1[3]});
                        v0 = (f32x4){a.x, a.y, b.x, b.y}; v1 = (f32x4){c.x, c.y, d.x, d.y}; }
                    if (ACT == 2) {
#pragma unroll
                        for (int j = 0; j < 4; ++j) { v0[j] = 0.5f * v0[j] * (1.0f + erff(v0[j] * 0.70710678f)); v1[j] = 0.5f * v1[j] * (1.0f + erff(v1[j] * 0.70710678f)); } }
                    u32x4 w; w.x = cvt_pk_bf16(v0[0], v0[1]); w.y = cvt_pk_bf16(v0[2], v0[3]); w.z = cvt_pk_bf16(v1[0], v1[1]); w.w = cvt_pk_bf16(v1[2], v1[3]);
                    *(u32x4*)(rowp + bj * HALF) = w; } }
    }
};

template <class Epi, class Sched, bool STAMP = false>
__device__ __forceinline__ void gemm_phase(PG8_LAS unsigned char* lds, const Gemm g, const Sched& S, const Epi& E, unsigned long long* stamps, int tid_in) {
    int tid_ = tid_in; asm volatile("" : "+v"(tid_));
    const int tid = tid_, wid = __builtin_amdgcn_readfirstlane(tid >> 6), lane = tid & 63, wr = wid >> 2, wc = wid & 3, fr = lane & 15, fq = lane >> 4;
    const int K = g.K, nt = K / BK;
    int ts_lo = 0, ts_hi = 0, nts = 0; const unsigned long long rt_entry = STAMP ? (unsigned long long)wall_clock64() : 0ull;
#define PG8_STAMP() do { if (STAMP && wid == 0 && nts < 64) { const unsigned long long _c = (unsigned long long)clock64(); \
        ts_lo = (lane == nts) ? (int)(unsigned)_c : ts_lo; ts_hi = (lane == nts) ? (int)(unsigned)(_c >> 32) : ts_hi; ++nts; } } while (0)
    PG8_STAMP();
    unsigned voffA[2], voffB[2];
#pragma unroll
    for (int i = 0; i < 2; ++i) { int R, C; stage_rc(tid * 16 + i * 8192, R, C); const int Rb = Epi::PERM ? ((R & ~31) + perm32(R & 31)) : R;
        voffA[i] = (unsigned)(R * K + C) * 2u; voffB[i] = (unsigned)(Rb * K + C) * 2u; }
    const size_t kstep = (size_t)(BK * 2);
    const size_t hstep = (size_t)HALF * K * 2;
    const size_t tstep = 2 * hstep;
    const unsigned ldsw = (unsigned)wid * 1024u;
    const int aoff = lds_byte(wr * 64 + fr, fq * 8), boff = lds_byte(wc * 32 + fr, fq * 8);
#define PG8_SA(b, h) (((b) * 2 + (h)) * HTB)
#define PG8_SB(b, h) ((4 + (b) * 2 + (h)) * HTB)
#define PG8_STAGE(bufoff, gbase, voff) do { _Pragma("unroll") for (int _i = 0; _i < 2; ++_i) \
        __builtin_amdgcn_global_load_lds((const unsigned*)((const char*)(gbase) + (voff)[_i]), (PG8_LAS unsigned*)(lds + (bufoff) + ldsw + _i * 8192), 16, 0, 0); } while (0)
#define PG8_LDA(dst, b, h) do { _Pragma("unroll") for (int m = 0; m < 4; ++m) _Pragma("unroll") for (int k = 0; k < 2; ++k) dst[m][k] = *(const PG8_LAS bf16x8*)(lds + PG8_SA(b, h) + aoff + m * 2048 + k * 1024); } while (0)
#define PG8_LDB(dst, b, h) do { _Pragma("unroll") for (int n = 0; n < 2; ++n) _Pragma("unroll") for (int k = 0; k < 2; ++k) dst[n][k] = *(const PG8_LAS bf16x8*)(lds + PG8_SB(b, h) + boff + n * 2048 + k * 1024); } while (0)
#define PG8_MMA(ai, bj, At, Bt) do { __builtin_amdgcn_s_setprio(1); _Pragma("unroll") for (int m = 0; m < 4; ++m) _Pragma("unroll") for (int n = 0; n < 2; ++n) _Pragma("unroll") for (int k = 0; k < 2; ++k) \
        acc[ai][bj][m][n] = __builtin_amdgcn_mfma_f32_16x16x32_bf16(Bt[n][k], At[m][k], acc[ai][bj][m][n], 0, 0, 0); __builtin_amdgcn_s_setprio(0); } while (0)
#define PG8_WAIT_V(n) asm volatile("s_waitcnt vmcnt(" #n ")" ::: "memory")
#define PG8_WAIT_L(n) asm volatile("s_waitcnt lgkmcnt(" #n ")" ::: "memory")
#define PG8_BAR __builtin_amdgcn_s_barrier()
#define PG8_SCHED __builtin_amdgcn_sched_barrier(0)
    Unit cur, nxt; int ui = 0;
    if (!S.next(0, cur)) return;
    f32x4 acc[2][2][4][2];
#pragma unroll
    for (int a = 0; a < 2; ++a)
#pragma unroll
        for (int b = 0; b < 2; ++b)
#pragma unroll
            for (int m = 0; m < 4; ++m)
#pragma unroll
                for (int n = 0; n < 2; ++n) acc[a][b][m][n] = (f32x4){0.f, 0.f, 0.f, 0.f};
    bf16x8 At[4][2], B0[2][2], B1[2][2];
    const char* cA = (const char*)g.A + (size_t)cur.pm * tstep; const char* cB = (const char*)g.Bt + (size_t)cur.pn * tstep;
    S.a_ready(cur);
    PG8_STAGE(PG8_SB(0, 0), cB, voffB); PG8_STAGE(PG8_SA(0, 0), cA, voffA); PG8_STAGE(PG8_SB(0, 1), cB + hstep, voffB); PG8_STAGE(PG8_SA(0, 1), cA + hstep, voffA);
    if (wr == 1) PG8_BAR;
    PG8_WAIT_V(4); PG8_BAR;
    PG8_STAGE(PG8_SB(1, 0), cB + kstep, voffB); PG8_STAGE(PG8_SA(1, 0), cA + kstep, voffA); PG8_STAGE(PG8_SB(1, 1), cB + hstep + kstep, voffB);
    PG8_WAIT_V(6); PG8_BAR;
    PG8_STAMP();
    for (;;) {
        const bool has_next = S.next(ui + 1, nxt);
        const char* nA = has_next ? (const char*)g.A + (size_t)nxt.pm * tstep : cA; const char* nB = has_next ? (const char*)g.Bt + (size_t)nxt.pn * tstep : cB;
        for (int t = 0; t < nt; t += 2) {
            const bool last = (t == nt - 2);
            const char* a1 = cA + (size_t)(t + 1) * kstep;
            const char* a2 = last ? nA : cA + (size_t)(t + 2) * kstep; const char* b2 = last ? nB : cB + (size_t)(t + 2) * kstep;
            const char* a3 = a2 + kstep; const char* b3 = b2 + kstep;
            if (last && has_next) S.a_ready(nxt);
            PG8_LDB(B0, 0, 0); PG8_SCHED; PG8_LDA(At, 0, 0); PG8_STAGE(PG8_SA(1, 1), a1 + hstep, voffA);
            PG8_WAIT_L(8); PG8_BAR; PG8_WAIT_L(0); PG8_MMA(0, 0, At, B0); PG8_BAR; PG8_SCHED;
            PG8_LDB(B1, 0, 1); PG8_STAGE(PG8_SB(0, 0), b2, voffB);
            PG8_BAR; PG8_WAIT_L(0); PG8_MMA(0, 1, At, B1); PG8_BAR;
            PG8_LDA(At, 0, 1); PG8_STAGE(PG8_SA(0, 0), a2, voffA);
            PG8_BAR; PG8_WAIT_L(0); PG8_MMA(1, 0, At, B0); PG8_BAR; PG8_SCHED;
            PG8_STAGE(PG8_SB(0, 1), b2 + hstep, voffB);
            PG8_WAIT_V(6); PG8_BAR; PG8_MMA(1, 1, At, B1); PG8_BAR;
            PG8_LDB(B0, 1, 0); PG8_SCHED; PG8_LDA(At, 1, 0); PG8_STAGE(PG8_SA(0, 1), a2 + hstep, voffA);
            PG8_WAIT_L(8); PG8_BAR; PG8_WAIT_L(0); PG8_MMA(0, 0, At, B0); PG8_BAR; PG8_SCHED;
            PG8_LDB(B1, 1, 1); PG8_STAGE(PG8_SB(1, 0), b3, voffB);
            PG8_BAR; PG8_WAIT_L(0); PG8_MMA(0, 1, At, B1); PG8_BAR;
            PG8_LDA(At, 1, 1); PG8_STAGE(PG8_SA(1, 0), a3, voffA);
            PG8_BAR; PG8_WAIT_L(0); PG8_MMA(1, 0, At, B0); PG8_BAR; PG8_SCHED;
            PG8_STAGE(PG8_SB(1, 1), b3 + hstep, voffB);
            PG8_WAIT_V(6); PG8_BAR; PG8_MMA(1, 1, At, B1); PG8_BAR;
        }
        PG8_STAMP();
        if constexpr (!Epi::AFTER_DRAIN) { E(acc, cur, wr, wc, fr, fq); S.done(cur); }
        PG8_STAMP();
        if (!has_next) break;
#pragma unroll
        for (int a = 0; a < 2; ++a)
#pragma unroll
            for (int b = 0; b < 2; ++b)
#pragma unroll
                for (int m = 0; m < 4; ++m)
#pragma unroll
                    for (int n = 0; n < 2; ++n) acc[a][b][m][n] = (f32x4){0.f, 0.f, 0.f, 0.f};
        cur = nxt; cA = nA; cB = nB; ++ui;
    }
    PG8_WAIT_V(0);
    if (wr == 0) PG8_BAR;
    PG8_BAR;
    if constexpr (Epi::AFTER_DRAIN) { E.fused(acc, cur, wr, wc, fr, fq, lds, wid, lane); S.done(cur); }
    PG8_STAMP();
    if (STAMP && wid == 0) { stamps[lane] = lane < nts ? (((unsigned long long)(unsigned)ts_hi << 32) | (unsigned)ts_lo) : 0ull;
        if (lane == 62) stamps[62] = rt_entry; if (lane == 63) stamps[63] = (unsigned long long)wall_clock64(); }
#undef PG8_STAMP
#undef PG8_SA
#undef PG8_SB
#undef PG8_STAGE
#undef PG8_LDA
#undef PG8_LDB
#undef PG8_MMA
#undef PG8_WAIT_V
#undef PG8_WAIT_L
#undef PG8_BAR
#undef PG8_SCHED
}
}
namespace sel {
#define SEL_HD __host__ __device__ __forceinline__
#if defined(__HIP_DEVICE_COMPILE__)
SEL_HD int imax(int a, int b) { int r; asm("v_max_f32 %0, %1, %2" : "=v"(r) : "v"(a), "v"(b)); return r; }
SEL_HD int imin(int a, int b) { int r; asm("v_min_f32 %0, %1, %2" : "=v"(r) : "v"(a), "v"(b)); return r; }
#else
SEL_HD int imax(int a, int b) { return __builtin_bit_cast(int, __builtin_fmaxf(__builtin_bit_cast(float, a), __builtin_bit_cast(float, b))); }
SEL_HD int imin(int a, int b) { return __builtin_bit_cast(int, __builtin_fminf(__builtin_bit_cast(float, a), __builtin_bit_cast(float, b))); }
#endif
constexpr int SEL_PAD = (int)0xff800000;
SEL_HD int f2key(float f) { return __builtin_bit_cast(int, f); }
SEL_HD float key2f(int k) { return __builtin_bit_cast(float, k); }
#define SEL_CE(i, j) do { const int hi_ = imax(a[i], a[j]), lo_ = imin(a[i], a[j]); a[i] = hi_; a[j] = lo_; } while (0)
template <int N> SEL_HD void sort_desc(int (&a)[N]) {
    if constexpr (N == 16) {
        SEL_CE(0,13); SEL_CE(1,12); SEL_CE(2,15); SEL_CE(3,14); SEL_CE(4,8); SEL_CE(5,6); SEL_CE(7,11); SEL_CE(9,10);
        SEL_CE(0,5); SEL_CE(1,7); SEL_CE(2,9); SEL_CE(3,4); SEL_CE(6,13); SEL_CE(8,14); SEL_CE(10,15); SEL_CE(11,12);
        SEL_CE(0,1); SEL_CE(2,3); SEL_CE(4,5); SEL_CE(6,8); SEL_CE(7,9); SEL_CE(10,11); SEL_CE(12,13); SEL_CE(14,15);
        SEL_CE(0,2); SEL_CE(1,3); SEL_CE(4,10); SEL_CE(5,11); SEL_CE(6,7); SEL_CE(8,9); SEL_CE(12,14); SEL_CE(13,15);
        SEL_CE(1,2); SEL_CE(3,12); SEL_CE(4,6); SEL_CE(5,7); SEL_CE(8,10); SEL_CE(9,11); SEL_CE(13,14);
        SEL_CE(1,4); SEL_CE(2,6); SEL_CE(5,8); SEL_CE(7,10); SEL_CE(9,13); SEL_CE(11,14);
        SEL_CE(2,4); SEL_CE(3,6); SEL_CE(9,12); SEL_CE(11,13);
        SEL_CE(3,5); SEL_CE(6,8); SEL_CE(7,9); SEL_CE(10,12);
        SEL_CE(3,4); SEL_CE(5,6); SEL_CE(7,8); SEL_CE(9,10); SEL_CE(11,12);
        SEL_CE(6,7); SEL_CE(8,9);
        return;
    }
#pragma unroll
    for (int k = 2; k <= N; k <<= 1) {
#pragma unroll
        for (int j = k >> 1; j > 0; j >>= 1) {
#pragma unroll
            for (int i = 0; i < N; ++i) {
                const int l = i ^ j;
                if (l > i) { const bool desc = ((i & k) == 0); const int hi = imax(a[i], a[l]), lo = imin(a[i], a[l]); a[i] = desc ? hi : lo; a[l] = desc ? lo : hi; }
            }
        }
    }
}
SEL_HD void merge_desc16(int (&a)[16]) {
#pragma unroll
    for (int j = 8; j > 0; j >>= 1) {
#pragma unroll
        for (int i = 0; i < 16; ++i) { const int l = i ^ j; if (l > i) { const int hi = imax(a[i], a[l]), lo = imin(a[i], a[l]); a[i] = hi; a[l] = lo; } }
    }
}
SEL_HD void top16_merge(int (&a)[16], const int (&b)[16]) {
#pragma unroll
    for (int i = 0; i < 16; ++i) a[i] = imax(a[i], b[15 - i]);
    merge_desc16(a);
}
SEL_HD void cand_top16(const int (&a)[16], const int (&b)[16], int (&c0)[16], float scale = 1.0f  ) {
    float av[16], bv[16];
#pragma unroll
    for (int i = 0; i < 16; ++i) { av[i] = key2f(a[i] & ~127) * scale; bv[i] = key2f(b[i] & ~127) * scale; }
    int c1[16], c2[16]; int x0 = SEL_PAD, x1 = SEL_PAD;
    {
        int n = 0;
#pragma unroll
        for (int i = 0; i < 16; ++i) {
#pragma unroll
            for (int j = 0; j < 16; ++j) {
                if ((i + 1) * (j + 1) <= 16) {
                    const int key = (f2key(av[i] + bv[j]) & ~255) | (i << 4) | j;
                    if (n < 16) c0[n & 15] = key; else if (n < 32) c1[n & 15] = key; else if (n < 48) c2[n & 15] = key; else if (n == 48) x0 = key; else x1 = key;
                    ++n;
                }
            }
        }
    }
    sort_desc(c0); sort_desc(c1); sort_desc(c2);
    { const int xh = imax(x0, x1), xl = imin(x0, x1);
      c2[14] = imax(c2[14], xl); c2[15] = imax(c2[15], xh); merge_desc16(c2); }
    top16_merge(c0, c1); top16_merge(c0, c2);
}
}
namespace att {
using bf16 = unsigned short;
constexpr int   D = 128, NW = 8, QBLK = 32, KVBLK = 64;
constexpr float SCALE = 0.088388347648318440f;
constexpr float THR = 8.f;
constexpr size_t SHM_V = KVBLK * D * 2, SHM_K = KVBLK * D * 2, SHM_ATTN = 2 * SHM_V + 2 * SHM_K + NW * 64 * 4;
constexpr size_t SHM_NA_BIAS = SHM_ATTN;
using bf16x8 = __attribute__((ext_vector_type(8))) short;
using s16x4  = __attribute__((ext_vector_type(4))) short;
using f32x16 = __attribute__((ext_vector_type(16))) float;
using u32x4  = __attribute__((ext_vector_type(4))) unsigned;
#define KSWZ(row, colB) ((row) * 256 + ((colB) ^ (((row) & 7) << 4)))
#define SBAR() __builtin_amdgcn_sched_barrier(0)
__device__ __forceinline__ int crow(int r, int hi) { return (r & 3) + 8 * (r >> 2) + 4 * hi; }
__device__ __forceinline__ unsigned cvtpk(float lo, float hi) { unsigned r; asm volatile("v_cvt_pk_bf16_f32 %0, %1, %2" : "=v"(r) : "v"(lo), "v"(hi)); return r; }
__device__ __forceinline__ bf16x8 ld8(const bf16* p) { return *reinterpret_cast<const bf16x8*>(p); }

__device__ __forceinline__ void partialSM(f32x16& p0, f32x16& p1, float& m_reg, float& mn, float& alpha) {
  constexpr float C = SCALE * 1.4426950408889634f;
  float pmax = p0[0]; for (int r = 1; r < 16; ++r) pmax = fmaxf(pmax, p0[r]); for (int r = 0; r < 16; ++r) pmax = fmaxf(pmax, p1[r]);
  { auto rr = __builtin_amdgcn_permlane32_swap(__float_as_uint(pmax), __float_as_uint(pmax), false, false);
    pmax = fmaxf(__uint_as_float(rr[0]), __uint_as_float(rr[1])); }
  if (__builtin_expect(__all(pmax - m_reg <= THR / SCALE), 1)) { mn = m_reg; alpha = 1.f; }
  else { mn = fmaxf(m_reg, pmax); alpha = __builtin_amdgcn_exp2f((m_reg - mn) * C); m_reg = mn; }
  float mnC = -mn * C;
  for (int r = 0; r < 16; ++r) p0[r] = fmaf(p0[r], C, mnC); for (int r = 0; r < 16; ++r) p1[r] = fmaf(p1[r], C, mnC);
  for (int r = 0; r < 16; ++r) p0[r] = __builtin_amdgcn_exp2f(p0[r]);
}
__device__ __forceinline__ void partialSM_fix(f32x16& p0, f32x16& p1, float negMC) {
  constexpr float C = SCALE * 1.4426950408889634f;
  for (int r = 0; r < 16; ++r) p0[r] = fmaf(p0[r], C, negMC); for (int r = 0; r < 16; ++r) p1[r] = fmaf(p1[r], C, negMC);
  for (int r = 0; r < 16; ++r) p0[r] = __builtin_amdgcn_exp2f(p0[r]);
}
__device__ __forceinline__ void partialSM_na(f32x16& p0, f32x16& p1, float& m_reg, float& mn, float& alpha, const float* brow, bool rowok, int c, int cs, int hi) {
  constexpr float C = SCALE * 1.4426950408889634f;
  const float ninf = -__builtin_inff();
#pragma unroll
  for (int r = 0; r < 16; ++r) {
    const int kc0 = crow(r, hi), kc1 = 32 + kc0;
    const bool ok0 = rowok && ((unsigned)(kc0 - cs) < 16u), ok1 = rowok && ((unsigned)(kc1 - cs) < 16u);
    const int d0 = ok0 ? (kc0 - c + 15) : 0, d1 = ok1 ? (kc1 - c + 15) : 0;
    const float b0 = brow[d0], b1 = brow[d1];
    p0[r] = ok0 ? fmaf(p0[r], C, b0) : ninf;
    p1[r] = ok1 ? fmaf(p1[r], C, b1) : ninf;
  }
  float pmax = p0[0]; for (int r = 1; r < 16; ++r) pmax = fmaxf(pmax, p0[r]); for (int r = 0; r < 16; ++r) pmax = fmaxf(pmax, p1[r]);
  { auto rr = __builtin_amdgcn_permlane32_swap(__float_as_uint(pmax), __float_as_uint(pmax), false, false);
    pmax = fmaxf(__uint_as_float(rr[0]), __uint_as_float(rr[1])); }
  if (__all(pmax - m_reg <= THR * 1.4426950408889634f)) { mn = m_reg; alpha = 1.f; }
  else { mn = fmaxf(m_reg, pmax); alpha = __builtin_amdgcn_exp2f(m_reg - mn); m_reg = mn; }
  for (int r = 0; r < 16; ++r) p0[r] = p0[r] - mn; for (int r = 0; r < 16; ++r) p1[r] = p1[r] - mn;
  for (int r = 0; r < 16; ++r) p0[r] = __builtin_amdgcn_exp2f(p0[r]);
}
__device__ __forceinline__ void finishSM(f32x16& p0, f32x16& p1, float alpha, float& l_reg, bf16x8& pa0, bf16x8& pa1, bf16x8& pa2, bf16x8& pa3) {
  for (int r = 0; r < 16; ++r) p1[r] = __builtin_amdgcn_exp2f(p1[r]);
  float ps = 0; for (int r = 0; r < 16; ++r) ps += p0[r]; for (int r = 0; r < 16; ++r) ps += p1[r];
  { auto rr = __builtin_amdgcn_permlane32_swap(__float_as_uint(ps), __float_as_uint(ps), false, false);
    ps = __uint_as_float(rr[0]) + __uint_as_float(rr[1]); }
  l_reg = l_reg * alpha + ps;
#define PK4(P, BASE, OUT) do { unsigned a0 = cvtpk(P[BASE + 0], P[BASE + 1]), a1 = cvtpk(P[BASE + 2], P[BASE + 3]);   \
    unsigned b0 = cvtpk(P[BASE + 4], P[BASE + 5]), b1 = cvtpk(P[BASE + 6], P[BASE + 7]);                              \
    auto r0 = __builtin_amdgcn_permlane32_swap(a0, b0, false, false); auto r1 = __builtin_amdgcn_permlane32_swap(a1, b1, false, false); \
    u32x4 w = {r0[0], r1[0], r0[1], r1[1]}; OUT = *reinterpret_cast<bf16x8*>(&w); } while (0)
  PK4(p0, 0, pa0); PK4(p0, 8, pa1); PK4(p1, 0, pa2); PK4(p1, 8, pa3);
#undef PK4
}
__device__ __forceinline__ void qkt(f32x16& p0, f32x16& p1, const bf16* Ks, const bf16x8* qr, int r32, int hi) {
  p0 = f32x16{}; p1 = f32x16{};
  for (int d0 = 0; d0 < 8; ++d0) { int cb = (d0 * 16 + hi * 8) * 2;
    bf16x8 b0 = *reinterpret_cast<const bf16x8*>((const char*)Ks + KSWZ(r32, cb));
    bf16x8 b1 = *reinterpret_cast<const bf16x8*>((const char*)Ks + KSWZ(32 + r32, cb));
    p0 = __builtin_amdgcn_mfma_f32_32x32x16_bf16(b0, qr[d0], p0, 0, 0, 0);
    p1 = __builtin_amdgcn_mfma_f32_32x32x16_bf16(b1, qr[d0], p1, 0, 0, 0); }
}
__device__ __forceinline__ int v_st(int k, int c) { const int kk = (k & ~0xC) | ((k & 4) << 1) | ((k & 8) >> 1); return ((kk >> 3) * 4 + (c >> 5)) * 512 + ((kk & 7) * 32 + (c & 31)) * 2; }
__device__ __forceinline__ int v_rd_base(int lane) { return ((lane & 3) << 3) | (((lane >> 2) & 3) << 6) | (((lane >> 4) & 1) << 5) | (((lane >> 5) & 1) << 8); }
constexpr int v_rd_off(int d0, int ks, int half) { return d0 * 512 + ks * 4096 + half * 2048; }
template <int OFF> __device__ __forceinline__ s16x4 tr_read(int vb) {
  s16x4 r; asm volatile("ds_read_b64_tr_b16 %0, %1 offset:%2" : "=&v"(r) : "v"(vb), "i"(OFF) : "memory"); return r;
}
template <int D0> __device__ __forceinline__ void pv_one(f32x16& od, int vb, bf16x8 pa0, bf16x8 pa1, bf16x8 pa2, bf16x8 pa3) {
  const s16x4 l0 = tr_read<v_rd_off(D0, 0, 0)>(vb), h0 = tr_read<v_rd_off(D0, 0, 1)>(vb), l1 = tr_read<v_rd_off(D0, 1, 0)>(vb), h1 = tr_read<v_rd_off(D0, 1, 1)>(vb);
  const s16x4 l2 = tr_read<v_rd_off(D0, 2, 0)>(vb), h2 = tr_read<v_rd_off(D0, 2, 1)>(vb), l3 = tr_read<v_rd_off(D0, 3, 0)>(vb), h3 = tr_read<v_rd_off(D0, 3, 1)>(vb);
  asm volatile("s_waitcnt lgkmcnt(0)" ::: "memory"); SBAR();
#define PK(L, H) (bf16x8){L[0], L[1], L[2], L[3], H[0], H[1], H[2], H[3]}
  od = __builtin_amdgcn_mfma_f32_32x32x16_bf16(pa0, PK(l0, h0), od, 0, 0, 0);
  od = __builtin_amdgcn_mfma_f32_32x32x16_bf16(pa1, PK(l1, h1), od, 0, 0, 0);
  od = __builtin_amdgcn_mfma_f32_32x32x16_bf16(pa2, PK(l2, h2), od, 0, 0, 0);
  od = __builtin_amdgcn_mfma_f32_32x32x16_bf16(pa3, PK(l3, h3), od, 0, 0, 0);
#undef PK
}
template <int D0, int KS0> __device__ __forceinline__ void pv_half(f32x16& od, int vb, bf16x8 pa, bf16x8 pb) {
  const s16x4 l0 = tr_read<v_rd_off(D0, KS0, 0)>(vb), h0 = tr_read<v_rd_off(D0, KS0, 1)>(vb), l1 = tr_read<v_rd_off(D0, KS0 + 1, 0)>(vb), h1 = tr_read<v_rd_off(D0, KS0 + 1, 1)>(vb);
  asm volatile("s_waitcnt lgkmcnt(0)" ::: "memory"); SBAR();
#define PK(L, H) (bf16x8){L[0], L[1], L[2], L[3], H[0], H[1], H[2], H[3]}
  od = __builtin_amdgcn_mfma_f32_32x32x16_bf16(pa, PK(l0, h0), od, 0, 0, 0);
  od = __builtin_amdgcn_mfma_f32_32x32x16_bf16(pb, PK(l1, h1), od, 0, 0, 0);
#undef PK
}
__device__ __forceinline__ void pv_d0h(f32x16* o, int vb, bf16x8 pa0, bf16x8 pa1, bf16x8 pa2, bf16x8 pa3) {
  pv_half<0, 0>(o[0], vb, pa0, pa1); pv_half<0, 2>(o[0], vb, pa2, pa3); pv_half<1, 0>(o[1], vb, pa0, pa1); pv_half<1, 2>(o[1], vb, pa2, pa3);
  pv_half<2, 0>(o[2], vb, pa0, pa1); pv_half<2, 2>(o[2], vb, pa2, pa3); pv_half<3, 0>(o[3], vb, pa0, pa1); pv_half<3, 2>(o[3], vb, pa2, pa3);
}
constexpr int pvw_off(int n, int dk, int hf) { return (n >> 3) * 16384 + v_rd_off((n >> 1) & 3, (n & 1) * 2 + dk, hf); }
#define PVW_RD(n, L0, H0, L1, H1) do { L0 = tr_read<pvw_off(n, 0, 0)>(vb); H0 = tr_read<pvw_off(n, 0, 1)>(vb); L1 = tr_read<pvw_off(n, 1, 0)>(vb); H1 = tr_read<pvw_off(n, 1, 1)>(vb); } while (0)
#define PVW_PK(L, H) (bf16x8){L[0], L[1], L[2], L[3], H[0], H[1], H[2], H[3]}
#define PVW_MM(n, L0, H0, L1, H1) do { f32x16& od_ = o[((n) >> 3) * 4 + (((n) >> 1) & 3)]; \
    od_ = __builtin_amdgcn_mfma_f32_32x32x16_bf16(((n) & 1) ? pa2 : pa0, PVW_PK(L0, H0), od_, 0, 0, 0); \
    od_ = __builtin_amdgcn_mfma_f32_32x32x16_bf16(((n) & 1) ? pa3 : pa1, PVW_PK(L1, H1), od_, 0, 0, 0); } while (0)
#define PVW_STEP(n, CL0, CH0, CL1, CH1, NL0, NH0, NL1, NH1) do { PVW_RD((n) + 1, NL0, NH0, NL1, NH1); asm volatile("s_waitcnt lgkmcnt(4)" ::: "memory"); SBAR(); PVW_MM(n, CL0, CH0, CL1, CH1); SBAR(); } while (0)
__device__ __forceinline__ void pv_wide(f32x16* o, int vb, bf16x8 pa0, bf16x8 pa1, bf16x8 pa2, bf16x8 pa3) {
  s16x4 a0, a1, a2, a3, b0, b1, b2, b3;
  PVW_RD(0, a0, a1, a2, a3);
  PVW_STEP(0, a0, a1, a2, a3, b0, b1, b2, b3);  PVW_STEP(1, b0, b1, b2, b3, a0, a1, a2, a3);
  PVW_STEP(2, a0, a1, a2, a3, b0, b1, b2, b3);  PVW_STEP(3, b0, b1, b2, b3, a0, a1, a2, a3);
  PVW_STEP(4, a0, a1, a2, a3, b0, b1, b2, b3);  PVW_STEP(5, b0, b1, b2, b3, a0, a1, a2, a3);
  PVW_STEP(6, a0, a1, a2, a3, b0, b1, b2, b3);  PVW_STEP(7, b0, b1, b2, b3, a0, a1, a2, a3);
  PVW_STEP(8, a0, a1, a2, a3, b0, b1, b2, b3);  PVW_STEP(9, b0, b1, b2, b3, a0, a1, a2, a3);
  PVW_STEP(10, a0, a1, a2, a3, b0, b1, b2, b3); PVW_STEP(11, b0, b1, b2, b3, a0, a1, a2, a3);
  PVW_STEP(12, a0, a1, a2, a3, b0, b1, b2, b3); PVW_STEP(13, b0, b1, b2, b3, a0, a1, a2, a3);
  PVW_STEP(14, a0, a1, a2, a3, b0, b1, b2, b3);
  asm volatile("s_waitcnt lgkmcnt(0)" ::: "memory"); SBAR(); PVW_MM(15, b0, b1, b2, b3);
}
__device__ __forceinline__ void pv_d0(f32x16* o, int vb, bf16x8 pa0, bf16x8 pa1, bf16x8 pa2, bf16x8 pa3) {
  pv_one<0>(o[0], vb, pa0, pa1, pa2, pa3); pv_one<1>(o[1], vb, pa0, pa1, pa2, pa3); pv_one<2>(o[2], vb, pa0, pa1, pa2, pa3); pv_one<3>(o[3], vb, pa0, pa1, pa2, pa3);
}

template <int MODE, int SDEPTH, int LDQ, int LDK, int LDV, int LDO, bool OBF>
__device__ __forceinline__ void attn_body(const bf16* __restrict__ Qb, const bf16* __restrict__ Kh, const bf16* __restrict__ Vh,
                                          void* __restrict__ Obv, int seq, char* lds, int r0, int kr0, float negMC, int tid_in) {
  int tid_ = tid_in; asm volatile("" : "+v"(tid_));
  const int tid = tid_, wid = tid >> 6, lane = tid & 63, r32 = lane & 31, hi = lane >> 5;
  bf16* V_lds = (bf16*)lds; bf16* K_lds = (bf16*)(lds + 2 * SHM_V);
  float* ws = (float*)(lds + 2 * SHM_V + 2 * SHM_K) + wid * 64; float* li_l = ws; float* al_l = ws + 32;
  const float* blds = (const float*)(lds + SHM_NA_BIAS);
  float m_reg = -1e30f, l_reg = 0; f32x16 o[4] = {}; bf16x8 qr[8];
  const bf16* Qw = Qb + (long)(wid * QBLK + r32) * LDQ + hi * 8;
#pragma unroll
  for (int d0 = 0; d0 < 8; ++d0) qr[d0] = ld8(Qw + d0 * 16);
  const int qrow = r0 + (wid >> 1), qc = (wid & 1) * 32 + r32;
  const int rs = min(max(qrow - 4, 0), 56), cs = min(max(qc - 8, 0), 48);
  const int sr = tid >> 4, sc = (tid & 15) * 8, vst0 = v_st(sr, sc), vst1 = v_st(32 + sr, sc);
  const int vb0 = (int)(uintptr_t)V_lds + v_rd_base(lane);
  struct { bf16x8 vs0, vs1, ks0, ks1; } sr_[SDEPTH];
  const unsigned koff0 = (unsigned)(sr * LDK + sc) * 2u, koff1 = (unsigned)((32 + sr) * LDK + sc) * 2u, voff0 = (unsigned)(sr * LDV + sc) * 2u, voff1 = (unsigned)((32 + sr) * LDV + sc) * 2u;
#define SLOAD(i, k0) do { const char* kt_ = (const char*)Kh + (size_t)(k0) * (LDK * 2); const char* vt_ = (const char*)Vh + (size_t)(k0) * (LDV * 2); \
    sr_[i].vs0 = *(const bf16x8*)(vt_ + voff0); sr_[i].vs1 = *(const bf16x8*)(vt_ + voff1); \
    sr_[i].ks0 = *(const bf16x8*)(kt_ + koff0); sr_[i].ks1 = *(const bf16x8*)(kt_ + koff1); } while (0)
#define SWRITE(b, i) do { *(bf16x8*)((char*)V_lds + (b) * SHM_V + vst0) = sr_[i].vs0;          \
    *(bf16x8*)((char*)V_lds + (b) * SHM_V + vst1) = sr_[i].vs1; int kc = sc * 2;               \
    *(bf16x8*)((char*)K_lds + (b) * SHM_K + KSWZ(sr, kc)) = sr_[i].ks0;                       \
    *(bf16x8*)((char*)K_lds + (b) * SHM_K + KSWZ(32 + sr, kc)) = sr_[i].ks1; } while (0)
#define SWAIT() do { if constexpr (SDEPTH == 2) asm volatile("s_waitcnt vmcnt(4)" ::: "memory"); else asm volatile("s_waitcnt vmcnt(0)" ::: "memory"); } while (0)
#define RESC(a) do { if constexpr (MODE == 1) if (__any((a) < 1.f)) { if (hi == 0) al_l[r32] = (a); asm volatile("s_waitcnt lgkmcnt(0)" ::: "memory"); \
    for (int d = 0; d < 4; ++d) for (int r = 0; r < 16; ++r) o[d][r] *= al_l[crow(r, hi)]; } } while (0)
#define PSM(P0, P1, MN, AL, J) do { if constexpr (MODE == 0) { partialSM_fix(P0, P1, negMC); AL = 1.f; } else { const int kr_ = kr0 + (J); const bool ok_ = (kr_ >= rs) && (kr_ < rs + 8); \
    const int dr_ = ok_ ? (kr_ - qrow + 7) : 0; partialSM_na(P0, P1, m_reg, MN, AL, blds + dr_ * 31, ok_, qc, cs, hi); } } while (0)
  f32x16 pA0, pA1, pB0, pB1; float mnA, mnB, alA, alB; bf16x8 pa0, pa1, pa2, pa3; const int NT = seq / KVBLK;
  if constexpr (MODE == 1) {
    SLOAD(0, 0);
    for (int j = 0; j < NT; ++j) {
      asm volatile("s_waitcnt vmcnt(0)" ::: "memory"); SWRITE(j & 1, 0);
      if (j + 1 < NT) SLOAD(0, (j + 1) * KVBLK);
      __syncthreads();
      SBAR(); qkt(pA0, pA1, (bf16*)((char*)K_lds + (j & 1) * SHM_K), qr, r32, hi);
      PSM(pA0, pA1, mnA, alA, j); RESC(alA);
      finishSM(pA0, pA1, alA, l_reg, pa0, pa1, pa2, pa3); SBAR();
      pv_d0(o, vb0 + (j & 1) * (int)SHM_V, pa0, pa1, pa2, pa3);
    }
  } else {
  constexpr int SE = 0, SO = SDEPTH - 1;
  SLOAD(SE, 0); asm volatile("s_waitcnt vmcnt(0)" ::: "memory"); SWRITE(0, SE); __syncthreads();
  qkt(pA0, pA1, K_lds, qr, r32, hi); PSM(pA0, pA1, mnA, alA, 0);
  SLOAD(SO, KVBLK); if constexpr (SDEPTH == 2) { if (2 < NT) SLOAD(SE, 2 * KVBLK); }
  SWAIT(); SWRITE(1, SO); __syncthreads();
  for (int j = 1; j + 1 < NT; j += 2) {
    SBAR(); qkt(pB0, pB1, (bf16*)((char*)K_lds + SHM_K), qr, r32, hi);
    finishSM(pA0, pA1, alA, l_reg, pa0, pa1, pa2, pa3); SBAR();
    SLOAD(SO, (j + SDEPTH) * KVBLK); SBAR();
    pv_d0(o, vb0, pa0, pa1, pa2, pa3); PSM(pB0, pB1, mnB, alB, j);
    __syncthreads(); SWAIT(); SWRITE(0, SE);
    RESC(alB); __syncthreads();
    SBAR(); qkt(pA0, pA1, K_lds, qr, r32, hi);
    finishSM(pB0, pB1, alB, l_reg, pa0, pa1, pa2, pa3); SBAR();
    if (SDEPTH == 1 || j + 3 < NT) SLOAD(SE, (j + 1 + SDEPTH) * KVBLK); SBAR();
    pv_d0(o, vb0 + (int)SHM_V, pa0, pa1, pa2, pa3); PSM(pA0, pA1, mnA, alA, j + 1);
    __syncthreads(); SWAIT(); SWRITE(1, SO);
    RESC(alA); __syncthreads();
  }
  SBAR(); qkt(pB0, pB1, (bf16*)((char*)K_lds + SHM_K), qr, r32, hi);
  finishSM(pA0, pA1, alA, l_reg, pa0, pa1, pa2, pa3); SBAR();
  pv_d0(o, vb0, pa0, pa1, pa2, pa3); PSM(pB0, pB1, mnB, alB, NT - 1);
  __syncthreads(); RESC(alB);
  finishSM(pB0, pB1, alB, l_reg, pa0, pa1, pa2, pa3); SBAR();
  pv_d0(o, vb0 + (int)SHM_V, pa0, pa1, pa2, pa3);
  }
  if (hi == 0) li_l[r32] = l_reg; asm volatile("s_waitcnt lgkmcnt(0)" ::: "memory");
  float rli[16];
#pragma unroll
  for (int r = 0; r < 16; ++r) rli[r] = __builtin_amdgcn_rcpf(li_l[crow(r, hi)]);
  if constexpr (OBF) {
    bf16* Ow = (bf16*)Obv + (long)(wid * QBLK) * LDO;
#pragma unroll
    for (int r = 0; r < 16; ++r) { int orow = crow(r, hi);
      for (int d0 = 0; d0 < 4; ++d0) Ow[(long)orow * LDO + d0 * 32 + r32] = (bf16)(cvtpk(o[d0][r] * rli[r], 0.f) & 0xffffu); }
  } else {
    float* Ow = (float*)Obv + (long)(wid * QBLK) * LDO;
#pragma unroll
    for (int r = 0; r < 16; ++r) { int orow = crow(r, hi);
      for (int d0 = 0; d0 < 4; ++d0) Ow[(long)orow * LDO + d0 * 32 + r32] = o[d0][r] * rli[r]; }
  }
#undef SLOAD
#undef SWRITE
#undef SWAIT
#undef RESC
#undef PSM
}

#define ATT_LAS __attribute__((address_space(3)))
constexpr int WIDE_K_OFF = 0, WIDE_V_OFF = 49152, WIDE_RING_BYTES = 147456, WIDE_WS_OFF = 156672, WIDE_LDS_BYTES = WIDE_WS_OFF + NW * 256;
template <int LDQ, int LDK, int LDV, int LDO>
__device__ __forceinline__ void attn_wide_body(const bf16* __restrict__ Qb, const bf16* __restrict__ Kh, const bf16* __restrict__ Vh, bf16* __restrict__ Ob, int seq,
                                               ATT_LAS unsigned char* ldsl, char* lds, float negMC, int tid_in) {
  int tid_ = tid_in; asm volatile("" : "+v"(tid_));
  const int tid = tid_, wid = __builtin_amdgcn_readfirstlane(tid >> 6), lane = tid & 63, r32 = lane & 31, hi = lane >> 5;
  float* li_l = (float*)(lds + WIDE_WS_OFF) + wid * 64;
  float l_reg = 0; f32x16 o[8] = {}; bf16x8 qr[8];
  const bf16* Qw = Qb + (long)(wid * QBLK + r32) * LDQ + hi * 8;
#pragma unroll
  for (int d0 = 0; d0 < 8; ++d0) qr[d0] = ld8(Qw + d0 * 16);
#define WSRC() unsigned ksrc[2], vsrc[4]; { int ln = lane; asm volatile("" : "+v"(ln)); \
  _Pragma("unroll") for (int i = 0; i < 2; ++i) { const int p = wid * 2 + i, row = 4 * p + (ln >> 4), cc = (ln & 15) ^ (row & 7); ksrc[i] = (unsigned)(row * LDK * 2 + cc * 16); } \
  _Pragma("unroll") for (int i = 0; i < 4; ++i) { const int P = wid * 4 + i, hf = P >> 4, p = P & 15, j = p * 64 + ln, st = j >> 5, within = j & 31; \
    const int kk = (st >> 2) * 8 + (within >> 2), c = (st & 3) * 32 + (within & 3) * 8, k = (kk & ~0xC) | ((kk & 4) << 1) | ((kk & 8) >> 1); \
    vsrc[i] = (unsigned)(k * LDV * 2 + (hf * 128 + c) * 2); } }
  const int vb0 = (int)(uintptr_t)(lds + WIDE_V_OFF) + v_rd_base(lane);
#define WDMA(T, B) do { WSRC(); const char* kt_ = (const char*)Kh + (size_t)(T) * (KVBLK * LDK * 2); const char* vt_ = (const char*)Vh + (size_t)(T) * (KVBLK * LDV * 2); \
    _Pragma("unroll") for (int i_ = 0; i_ < 2; ++i_) __builtin_amdgcn_global_load_lds((const unsigned*)(kt_ + ksrc[i_]), (ATT_LAS unsigned*)(ldsl + WIDE_K_OFF + (B) * 16384 + (wid * 2 + i_) * 1024), 16, 0, 0); \
    _Pragma("unroll") for (int i_ = 0; i_ < 4; ++i_) __builtin_amdgcn_global_load_lds((const unsigned*)(vt_ + vsrc[i_]), (ATT_LAS unsigned*)(ldsl + WIDE_V_OFF + (B) * 32768 + (wid * 4 + i_) * 1024), 16, 0, 0); } while (0)
  const int NT = seq / KVBLK;
  f32x16 p0, p1; bf16x8 pa0, pa1, pa2, pa3;
#undef WDMA
#define WDMA(T, SL) do { WSRC(); const char* kt_ = (const char*)Kh + (size_t)(T) * (KVBLK * LDK * 2); const char* vt_ = (const char*)Vh + (size_t)(T) * (KVBLK * LDV * 2); \
    _Pragma("unroll") for (int i_ = 0; i_ < 2; ++i_) __builtin_amdgcn_global_load_lds((const unsigned*)(kt_ + ksrc[i_]), (ATT_LAS unsigned*)(ldsl + WIDE_K_OFF + (SL) * 16384 + (wid * 2 + i_) * 1024), 16, 0, 0); \
    _Pragma("unroll") for (int i_ = 0; i_ < 4; ++i_) __builtin_amdgcn_global_load_lds((const unsigned*)(vt_ + vsrc[i_]), (ATT_LAS unsigned*)(ldsl + WIDE_V_OFF + (SL) * 32768 + (wid * 4 + i_) * 1024), 16, 0, 0); } while (0)
#define WQKSM(SL) do { SBAR(); __builtin_amdgcn_s_setprio(1); qkt(p0, p1, (const bf16*)(lds + WIDE_K_OFF + (SL) * 16384), qr, r32, hi); __builtin_amdgcn_s_setprio(0); partialSM_fix(p0, p1, negMC); finishSM(p0, p1, 1.f, l_reg, pa0, pa1, pa2, pa3); SBAR(); } while (0)
#define WPV(SL) do { __builtin_amdgcn_s_setprio(1); pv_wide(o, vb0 + (SL) * 32768, pa0, pa1, pa2, pa3); __builtin_amdgcn_s_setprio(0); } while (0)
  WDMA(0, 0); WDMA(1, 1);
  int sl = 0;
  for (int j = 0; j < NT; ++j) {
    const int sl2 = (sl == 0) ? 2 : sl - 1;
    if (j + 1 < NT) asm volatile("s_waitcnt vmcnt(6)" ::: "memory"); else asm volatile("s_waitcnt vmcnt(0)" ::: "memory");
    __builtin_amdgcn_s_barrier(); asm volatile("" ::: "memory");
    if (j + 2 < NT) WDMA(j + 2, sl2);
    WQKSM(sl); WPV(sl);
    sl = (sl == 2) ? 0 : sl + 1;
  }
#undef WQKSM
#undef WPV
#undef WDMA
#undef WSRC
  if (hi == 0) li_l[r32] = l_reg; asm volatile("s_waitcnt lgkmcnt(0)" ::: "memory");
  float rli[16];
#pragma unroll
  for (int r = 0; r < 16; ++r) rli[r] = __builtin_amdgcn_rcpf(li_l[crow(r, hi)]);
  bf16* Ow = Ob + (long)(wid * QBLK) * LDO;
#pragma unroll
  for (int r = 0; r < 16; ++r) { const int orow = crow(r, hi);
#pragma unroll
    for (int d0 = 0; d0 < 8; ++d0) Ow[(long)orow * LDO + d0 * 32 + r32] = (bf16)(cvtpk(o[d0][r] * rli[r], 0.f) & 0xffffu); }
}
#undef KSWZ
}

constexpr int T = 8192, DM = 2048, SEQ = 4096, NB = 2, DEPTH = 4, INW = 5120, MIXW = 2048;
constexpr int OFF_DQ = 0, OFF_DK = 1024, OFF_DV = 2048, OFF_NQ = 3072, OFF_NK = 3584, OFF_NV = 4096, OFF_MQ = 4608;
constexpr int NMEM = 256, NEXP = 16384, KVW = 1024;
constexpr float EPS = 1e-6f;
constexpr int NWAVES = 8;
#ifndef MK_PHMASK
#define MK_PHMASK 0xfff
#endif
#define PHEN(k) (((MK_PHMASK) >> (k)) & 1)
#ifndef EPV_ROPE
#define EPV_ROPE 1
#endif
#ifndef PROBE_MASK
#define PROBE_MASK 0
#endif
#define PREP(k) ((((PROBE_MASK) >> (k)) & 1) + 1)
#ifndef U_FP4
#define U_FP4 1
#endif
#ifndef U_I4
#define U_I4 1
#endif
#ifndef GATHER_SPLIT
#define GATHER_SPLIT 1
#endif
#ifndef GATHER_BATCH
#define GATHER_BATCH 8
#endif
#ifndef V_FP4
#define V_FP4 1
#endif
#ifndef V_SLICED
#define V_SLICED 1
#endif
#ifndef V_SLICES
#define V_SLICES 8
#endif
#ifndef PROBE_VL2
#define PROBE_VL2 0
#endif
#ifndef V_I4
#define V_I4 1
#endif
#ifndef MK_ATT
#define MK_ATT 7
#endif
#ifndef MK_ONE_LAUNCH
#define MK_ONE_LAUNCH 1
#endif

constexpr size_t MiB = 1u << 20;
constexpr size_t WS_CTL = 0, CTL_ZERO_BYTES = 1 * MiB;
constexpr size_t WS_ROPE = 1 * MiB;
constexpr size_t WS_MEMN = 2 * MiB;
constexpr size_t WS_MEMKV = 4 * MiB;
constexpr size_t WS_KEYS = 8 * MiB;
constexpr size_t WS_IDS = 10 * MiB;
constexpr size_t WS_GATES = 14 * MiB;
constexpr size_t WS_WTIN = 32 * MiB;
constexpr size_t WS_WTOUT = 112 * MiB;
constexpr size_t WS_WTPQ = 144 * MiB;
constexpr size_t WS_WTKV = 176 * MiB;
constexpr size_t WS_XN = 192 * MiB;
constexpr size_t WS_PROJ = 224 * MiB;
constexpr size_t WS_OD = 304 * MiB;
constexpr size_t WS_MIX = 368 * MiB;
constexpr size_t WS_PQ = 400 * MiB;
constexpr size_t WS_SSP = 20 * MiB;
constexpr size_t WS_RS = 21 * MiB;
constexpr size_t WS_WEXP = 22 * MiB;
constexpr size_t WS_USC = 18 * MiB;
constexpr size_t WS_VSC = 19 * MiB;
constexpr int UROWB = U_FP4 ? 1024 : 1536;
constexpr int VROWB = V_FP4 ? 1024 : 1536;
constexpr int ROWB = 1536;
constexpr size_t WS_UTAB = 448 * MiB;
constexpr size_t WS_VTAB = 576 * MiB;
constexpr size_t WS_END = 704 * MiB;
constexpr int CW_BAR = 4096;

constexpr int RING_BYTES = 147456;
constexpr int LDSCTL_OFF = RING_BYTES, MISC_OFF = LDSCTL_OFF + 320;
constexpr int LDS_BYTES = 163840;
constexpr int EPI_P_OFF = RING_BYTES + 1024;

#define GAS __attribute__((address_space(1)))
#define LAS __attribute__((address_space(3)))
typedef unsigned short bf16;
typedef unsigned v4u __attribute__((ext_vector_type(4)));
typedef unsigned v2u __attribute__((ext_vector_type(2)));
typedef float f32x4 __attribute__((ext_vector_type(4)));
typedef float f32x16 __attribute__((ext_vector_type(16)));
typedef short bf16x8 __attribute__((ext_vector_type(8)));
#define LDS_WAIT() asm volatile("s_waitcnt lgkmcnt(0)" ::: "memory")

__device__ __forceinline__ unsigned f2bf(float f) { unsigned u = __builtin_bit_cast(unsigned, f); return (u + 0x7fffu + ((u >> 16) & 1u)) >> 16; }
__device__ __forceinline__ unsigned pk2(float lo, float hi) { return f2bf(lo) | (f2bf(hi) << 16); }
__device__ __forceinline__ float bflo(unsigned w) { return __builtin_bit_cast(float, w << 16); }
__device__ __forceinline__ float bfhi(unsigned w) { return __builtin_bit_cast(float, w & 0xffff0000u); }
__device__ __forceinline__ float shx_(float v, int o, int lane) { return __builtin_bit_cast(float, __builtin_amdgcn_ds_bpermute((lane ^ o) << 2, __builtin_bit_cast(int, v))); }
__device__ __forceinline__ int shx_(int v, int o, int lane) { return __builtin_amdgcn_ds_bpermute((lane ^ o) << 2, v); }
__device__ __forceinline__ float shi_(float v, int src) { return __builtin_bit_cast(float, __builtin_amdgcn_ds_bpermute(src << 2, __builtin_bit_cast(int, v))); }
#define SHX(v, o) shx_((v), (o), lane)
__device__ __forceinline__ float wave_sum(float v, int lane) {
#pragma unroll
    for (int o = 1; o < 64; o <<= 1) v += SHX(v, o);
    return v;
}

#define XB_TMO      128
#define XB_XCNT(j)  (256  + 64 * (j))
#define XB_XSUB(j)  (1280 + 64 * (j))
#define XB_XGEN(j)  (2304 + 64 * (j))
#define XB_TOP      3328
#define XB_TOPGEN   3392
#define XCD_BAR_WORDS 3456
#define XB_SPIN_CAP (1u << 18)
__device__ __forceinline__ unsigned xb_ld(unsigned* p)              { return __hip_atomic_load(p, __ATOMIC_RELAXED, __HIP_MEMORY_SCOPE_AGENT); }
__device__ __forceinline__ unsigned xb_add(unsigned* p, unsigned v) { return __hip_atomic_fetch_add(p, v, __ATOMIC_RELAXED, __HIP_MEMORY_SCOPE_AGENT); }
__device__ __forceinline__ unsigned xb_xcc_id() { return (unsigned)__builtin_amdgcn_s_getreg((3 << 11) | 20) & 0xFu; }
#define XB_SPIN(cond, bar) do { unsigned _sp = 0; while (cond) { __builtin_amdgcn_s_sleep(1); \
    if ((++_sp & 255u) == 0u) { if (xb_ld(&(bar)[XB_TMO])) break; if (_sp > XB_SPIN_CAP) { atomicAdd(&(bar)[XB_TMO], 1u); break; } } } } while (0)
struct XcdBarrier { unsigned* bar; unsigned x; volatile LAS unsigned* st; };
__device__ __forceinline__ XcdBarrier xcd_barrier_post(unsigned* bar, volatile LAS unsigned* st, bool t0) {
    XcdBarrier b; b.bar = bar; b.x = xb_xcc_id(); b.st = st;
    if (t0) (void)xb_add(&bar[XB_XCNT(b.x)], 1u);
    return b;
}
__device__ __forceinline__ void xcd_barrier_complete(unsigned* bar, unsigned x, unsigned& nloc, unsigned& nx) {
    const unsigned G = gridDim.x * gridDim.y * gridDim.z;
    unsigned sum, cnt, mine, sp = 0u;
    for (;;) {
        sum = 0u; cnt = 0u; mine = 0u;
#pragma unroll 1
        for (unsigned j = 0; j < 16; ++j) { const unsigned c = xb_ld(&bar[XB_XCNT(j)]); sum += c; cnt += (c > 0u) ? 1u : 0u; mine = (j == x) ? c : mine; }
        if (sum == G) break;
        __builtin_amdgcn_s_sleep(1);
        if ((++sp & 255u) == 0u) { if (xb_ld(&bar[XB_TMO])) break; if (sp > XB_SPIN_CAP) { atomicAdd(&bar[XB_TMO], 1u); break; } }
    }
    nloc = mine > 0u ? mine : 1u; nx = cnt > 0u ? cnt : 1u;
}
__device__ __forceinline__ void xcd_barrier(const XcdBarrier& b, bool t0) {
    asm volatile("s_waitcnt vmcnt(0)" ::: "memory");
    __syncthreads();
    if (t0) {
        unsigned* bar = b.bar;
        __builtin_amdgcn_s_waitcnt(0);
        unsigned nloc = b.st[0], nx = b.st[1];
        if (nloc == 0u) { xcd_barrier_complete(bar, b.x, nloc, nx); b.st[0] = nloc; b.st[1] = nx; }
        const unsigned old = xb_add(&bar[XB_XSUB(b.x)], 1u);
        const unsigned gen = old / nloc;
        if (old + 1u == (gen + 1u) * nloc) {
            __builtin_amdgcn_fence(__ATOMIC_RELEASE, "agent");
            asm volatile("s_waitcnt vmcnt(0)" ::: "memory");
            const unsigned og = xb_add(&bar[XB_TOP], 1u);
            const unsigned tg = og / nx;
            if (og + 1u == (tg + 1u) * nx) xb_add(&bar[XB_TOPGEN], 1u);
            else XB_SPIN(xb_ld(&bar[XB_TOPGEN]) == tg, bar);
            __builtin_amdgcn_fence(__ATOMIC_ACQUIRE, "agent");
            xb_add(&bar[XB_XGEN(b.x)], 1u);
            asm volatile("s_waitcnt vmcnt(0)" ::: "memory");
        } else {
            XB_SPIN(xb_ld(&bar[XB_XGEN(b.x)]) == gen, bar);
            __builtin_amdgcn_fence(__ATOMIC_ACQUIRE, "agent");
            asm volatile("s_waitcnt vmcnt(0)" ::: "memory");
        }
    }
    __syncthreads();
}

__device__ __forceinline__ void transpose_item(const float* W, const float* gain, int K, int N, bf16* WT, LAS float* scr, int item, int lane) {
    const int nblk = N / 32, kb = item / nblk, nb = item % nblk, k0 = 64 * kb, n0 = 32 * nb;
    f32x4 v[8];
#pragma unroll
    for (int i = 0; i < 8; ++i) v[i] = *(const f32x4*)(W + (size_t)(k0 + 8 * i + (lane >> 3)) * N + n0 + 4 * (lane & 7));
    if (gain) {
#pragma unroll
        for (int i = 0; i < 8; ++i) v[i] *= gain[k0 + 8 * i + (lane >> 3)];
    }
#pragma unroll
    for (int i = 0; i < 8; ++i) { LAS float* d_ = scr + (8 * i + (lane >> 3)) * 33 + 4 * (lane & 7); d_[0] = v[i].x; d_[1] = v[i].y; d_[2] = v[i].z; d_[3] = v[i].w; }
    LDS_WAIT(); asm volatile("" ::: "memory");
    const int c = lane & 7;
#pragma unroll
    for (int j = 0; j < 4; ++j) { const int n = (lane >> 3) + 8 * j; const LAS float* s = scr + (8 * c) * 33 + n;
        v4u o; o.x = pk2(s[0 * 33], s[1 * 33]); o.y = pk2(s[2 * 33], s[3 * 33]); o.z = pk2(s[4 * 33], s[5 * 33]); o.w = pk2(s[6 * 33], s[7 * 33]);
        *(v4u*)(WT + (size_t)(n0 + n) * K + k0 + 8 * c) = o; }
    LDS_WAIT(); asm volatile("" ::: "memory");
}
__device__ __forceinline__ void rms_row_to_bf16(const float* xrow, bf16* orow, int lane) {
    const f32x4* xr = (const f32x4*)xrow + lane;
    f32x4 v[8]; float s = 0.f;
#pragma unroll
    for (int j = 0; j < 8; ++j) { v[j] = xr[64 * j]; s += (v[j].x * v[j].x + v[j].y * v[j].y) + (v[j].z * v[j].z + v[j].w * v[j].w); }
    const float r = 1.0f / sqrtf(wave_sum(s, lane) * (1.f / 2048.f) + EPS);
    v2u* o8 = (v2u*)orow + lane;
#pragma unroll
    for (int j = 0; j < 8; ++j) { v2u w; w.x = pk2(v[j].x * r, v[j].y * r); w.y = pk2(v[j].z * r, v[j].w * r); o8[64 * j] = w; }
}
__device__ __forceinline__ void row_to_bf16_rs(const float* xrow, bf16* orow, float* rs_out, int lane) {
    const f32x4* xr = (const f32x4*)xrow + lane;
    f32x4 v[8]; float s = 0.f;
#pragma unroll
    for (int j = 0; j < 8; ++j) { v[j] = xr[64 * j]; s += (v[j].x * v[j].x + v[j].y * v[j].y) + (v[j].z * v[j].z + v[j].w * v[j].w); }
    const float st = wave_sum(s, lane);
    if (lane < 8) rs_out[lane] = lane == 0 ? st : 0.f;
    v2u* o8 = (v2u*)orow + lane;
#pragma unroll
    for (int j = 0; j < 8; ++j) { v2u w; w.x = pk2(v[j].x, v[j].y); w.y = pk2(v[j].z, v[j].w); o8[64 * j] = w; }
}
__device__ __forceinline__ void slot_norm(bf16* p, const float* g, bool rope, const float* cs, const float* sn, int sub  , int lane) {
    v4u w = *(v4u*)(p + sub * 8);
    float x[8] = {bflo(w.x), bfhi(w.x), bflo(w.y), bfhi(w.y), bflo(w.z), bfhi(w.z), bflo(w.w), bfhi(w.w)};
    float s = 0.f;
#pragma unroll
    for (int j = 0; j < 8; ++j) s += x[j] * x[j];
    s += SHX(s, 1); s += SHX(s, 2); s += SHX(s, 4); s += SHX(s, 8);
    const float r = 1.0f / sqrtf(s * (1.f / 128.f) + EPS);
    const f32x4 g0 = *(const f32x4*)(g + sub * 8), g1 = *(const f32x4*)(g + sub * 8 + 4);
    x[0] *= r * g0.x; x[1] *= r * g0.y; x[2] *= r * g0.z; x[3] *= r * g0.w; x[4] *= r * g1.x; x[5] *= r * g1.y; x[6] *= r * g1.z; x[7] *= r * g1.w;
    float y[8];
#pragma unroll
    for (int j = 0; j < 8; ++j) y[j] = SHX(x[j], 2);
    if (rope && sub < 4) {
        const int i0 = (sub & 1) * 8;
#pragma unroll
        for (int j = 0; j < 8; ++j) { const float c = cs[i0 + j], sn_ = sn[i0 + j]; x[j] = (sub < 2) ? (x[j] * c - y[j] * sn_) : (x[j] * c + y[j] * sn_); }
    }
    v4u o; o.x = pk2(x[0], x[1]); o.y = pk2(x[2], x[3]); o.z = pk2(x[4], x[5]); o.w = pk2(x[6], x[7]);
    *(v4u*)(p + sub * 8) = o;
}

struct EpiResF32 {
    static constexpr bool PERM = false, AFTER_DRAIN = false;
    bf16* XB; float* SSP; int ldc;
    __device__ __forceinline__ void operator()(const pg8::f32x4 (&acc)[2][2][4][2], const pg8::Unit& u, int wr, int wc, int fr_in, int fq_in) const {
        int fr = fr_in, fq = fq_in; asm volatile("" : "+v"(fr), "+v"(fq));
        const int lane = fq * 16 + fr;
        const int row0 = u.pm * pg8::BM + wr * 64 + fr, col0 = u.pn * pg8::BM + wc * 32 + 4 * fq;
#pragma unroll
        for (int ai = 0; ai < 2; ++ai)
#pragma unroll
            for (int m = 0; m < 4; ++m) { const int row = row0 + ai * pg8::HALF + m * 16; const size_t off = (size_t)row * ldc + col0; float ss = 0.f;
#pragma unroll
                for (int bj = 0; bj < 2; ++bj)
#pragma unroll
                    for (int n = 0; n < 2; ++n) { const v2u bw = *(const v2u*)(XB + off + bj * pg8::HALF + n * 16); const pg8::f32x4 a = acc[ai][bj][m][n];
                        const float v0 = bflo(bw.x) + a[0], v1 = bfhi(bw.x) + a[1], v2 = bflo(bw.y) + a[2], v3 = bfhi(bw.y) + a[3];
                        ss += (v0 * v0 + v1 * v1) + (v2 * v2 + v3 * v3);
                        v2u w; w.x = pk2(v0, v1); w.y = pk2(v2, v3); *(v2u*)(XB + off + bj * pg8::HALF + n * 16) = w; }
                ss += SHX(ss, 16); ss += SHX(ss, 32);
                if (fq == 0) SSP[(size_t)row * 32 + u.pn * 4 + wc] = ss;
                asm volatile("" ::: "memory"); }
    }
};
template <bool MEM> struct EpiProjT {
    static constexpr bool PERM = false, AFTER_DRAIN = false;
    bf16* O; const float* gq; const float* ropec; const float* ropes; LAS float* P; int pn0;
    const float* rs;
    __device__ __forceinline__ void operator()(const pg8::f32x4 (&acc)[2][2][4][2], const pg8::Unit& u, int wr, int wc, int fr_in, int fq_in) const {
        constexpr int LDO_ = MEM ? DEPTH * KVW : INW;
        int fr = fr_in, fq = fq_in; asm volatile("" : "+v"(fr), "+v"(fq));
        const int lane = fq * 16 + fr;
        const int pn = u.pn + pn0; const int row0 = u.pm * pg8::BM + wr * 64 + fr, col0 = pn * pg8::BM + wc * 32 + 4 * fq;
        int gi = -1;
        if (MEM) { gi = ((pn & 3) < 2) ? (pn >> 2) * 6 + 5 : -1; }
        else { if (pn < 4) gi = 0; else if (pn < 8) gi = 1; else if (pn < 12) gi = -1; else if (pn < 14) gi = 2; else if (pn < 16) gi = 3; else if (pn < 18) gi = -1; else gi = 4; }
        const bool rope = !MEM && pn < 8;
        if (gi < 0) {
#pragma unroll
            for (int ai = 0; ai < 2; ++ai)
#pragma unroll
                for (int m = 0; m < 4; ++m) { const int row_ = row0 + ai * pg8::HALF + m * 16; bf16* rowp = O + (size_t)row_ * LDO_ + col0; float rsc = 1.0f; if (rs) { const f32x4 pa_ = *(const f32x4*)(rs + (size_t)row_ * 8), pb_ = *(const f32x4*)(rs + (size_t)row_ * 8 + 4); rsc = __builtin_amdgcn_rsqf((((pa_.x + pa_.y) + (pa_.z + pa_.w)) + ((pb_.x + pb_.y) + (pb_.z + pb_.w))) * (1.f / 2048.f) + EPS); }
#pragma unroll
                    for (int bj = 0; bj < 2; ++bj)
#pragma unroll
                        for (int n = 0; n < 2; ++n) { const pg8::f32x4 v = acc[ai][bj][m][n] * rsc; v2u w; w.x = pk2(v[0], v[1]); w.y = pk2(v[2], v[3]); *(v2u*)(rowp + bj * pg8::HALF + n * 16) = w; } }
            return;
        }
#pragma unroll
        for (int ai = 0; ai < 2; ++ai)
#pragma unroll
            for (int m = 0; m < 4; ++m)
#pragma unroll
                for (int bj = 0; bj < 2; ++bj) { float ss = 0.f;
#pragma unroll
                    for (int n = 0; n < 2; ++n) { const pg8::f32x4 v = acc[ai][bj][m][n]; ss += (v[0] * v[0] + v[1] * v[1]) + (v[2] * v[2] + v[3] * v[3]); }
                    ss += SHX(ss, 16); ss += SHX(ss, 32);
                    if (fq == 0) P[((ai * pg8::HALF + wr * 64 + m * 16 + fr) * 2 + bj) * 4 + wc] = ss; __builtin_amdgcn_sched_barrier(0); }
        asm volatile("s_waitcnt lgkmcnt(0)" ::: "memory"); __builtin_amdgcn_s_barrier(); asm volatile("" ::: "memory");
        const f32x4 g0 = *(const f32x4*)(gq + gi * 128 + wc * 32 + 4 * fq), g1 = *(const f32x4*)(gq + gi * 128 + wc * 32 + 16 + 4 * fq);
#pragma unroll
        for (int ai = 0; ai < 2; ++ai)
#pragma unroll
            for (int m = 0; m < 4; ++m) { const int rl = ai * pg8::HALF + wr * 64 + m * 16 + fr, row = u.pm * pg8::BM + rl; bf16* rowp = O + (size_t)row * LDO_ + col0;
                f32x4 cs = (f32x4){1.f, 1.f, 1.f, 1.f}, sn = (f32x4){0.f, 0.f, 0.f, 0.f};
                if (EPV_ROPE && rope && wc == 0) { const int pos = row & (SEQ - 1); cs = *(const f32x4*)(ropec + pos * 16 + 4 * fq); sn = *(const f32x4*)(ropes + pos * 16 + 4 * fq); }
#pragma unroll
                for (int bj = 0; bj < 2; ++bj) { const f32x4 t = *(const LAS f32x4*)(P + (rl * 2 + bj) * 4); const float r = __builtin_amdgcn_rsqf(((t.x + t.y) + (t.z + t.w)) * (1.f / 128.f) + EPS);
                    f32x4 y0 = acc[ai][bj][m][0] * r * g0, y1 = acc[ai][bj][m][1] * r * g1;
                    if (EPV_ROPE && rope && wc == 0) { const f32x4 a = y0 * cs - y1 * sn, b = y1 * cs + y0 * sn; y0 = a; y1 = b; }
                    v2u w0, w1; w0.x = pk2(y0[0], y0[1]); w0.y = pk2(y0[2], y0[3]); w1.x = pk2(y1[0], y1[1]); w1.y = pk2(y1[2], y1[3]);
                    *(v2u*)(rowp + bj * pg8::HALF) = w0; *(v2u*)(rowp + bj * pg8::HALF + 16) = w1; }
                asm volatile("" ::: "memory"); __builtin_amdgcn_sched_barrier(0); }
    }
};

typedef EpiProjT<false> EpiProj;

template <bool KLDS> __device__ __forceinline__ void select_task(const bf16* PQ, const float* SSP, const bf16* KEYS_l, int* IDS, float* GATES, int tile, int hp, LAS int* lscr, int lane, const char* klds = nullptr) {
    const int r32 = lane & 31, hi = lane >> 5; const int t = tile * 32 + r32;
    float rs;
    { float tot = 0.f;
#pragma unroll
      for (int j = 0; j < 8; ++j) { const f32x4 v = *(const f32x4*)(SSP + (size_t)t * 32 + j * 4); tot += (v.x + v.y) + (v.z + v.w); }
      rs = 1.0f / sqrtf(tot * (1.f / 2048.f) + EPS); }
    int ab[2][16];
#pragma unroll
    for (int c = 0; c < 2; ++c) {
        const int g = hp * 2 + c;
        bf16x8 qr[8];
#pragma unroll
        for (int ks = 0; ks < 8; ++ks) qr[ks] = *(const bf16x8*)(PQ + (size_t)t * 2048 + g * 128 + ks * 16 + hi * 8);
        const bf16* kb = KEYS_l + (size_t)g * 128 * 128;
        f32x16 p[4];
        if constexpr (KLDS) {
            att::qkt(p[0], p[1], (const att::bf16*)(klds + (2 * c) * 16384), qr, r32, hi);
            att::qkt(p[2], p[3], (const att::bf16*)(klds + (2 * c + 1) * 16384), qr, r32, hi);
        } else {
#pragma unroll
        for (int q = 0; q < 4; ++q) { p[q] = f32x16{};
#pragma unroll
            for (int ks = 0; ks < 8; ++ks) { const bf16x8 af = *(const bf16x8*)(kb + (size_t)(q * 32 + r32) * 128 + ks * 16 + hi * 8); p[q] = __builtin_amdgcn_mfma_f32_32x32x16_bf16(af, qr[ks], p[q], 0, 0, 0); } }
        }
        int g0[16], g1[16], g2[16], g3[16];
#pragma unroll
        for (int r = 0; r < 16; ++r) { const int idx = (r & 3) + 8 * (r >> 2) + 4 * hi;
            g0[r] = (sel::f2key(p[0][r]) & ~127) | idx; g1[r] = (sel::f2key(p[1][r]) & ~127) | (32 + idx);
            g2[r] = (sel::f2key(p[2][r]) & ~127) | (64 + idx); g3[r] = (sel::f2key(p[3][r]) & ~127) | (96 + idx); }
        sel::sort_desc(g0); sel::sort_desc(g1); sel::sort_desc(g2); sel::sort_desc(g3);
        sel::top16_merge(g0, g1); sel::top16_merge(g2, g3); sel::top16_merge(g0, g2);
        int pb[16];
#pragma unroll
        for (int i = 0; i < 16; ++i) pb[i] = SHX(g0[i], 32);
        sel::top16_merge(g0, pb);
#pragma unroll
        for (int i = 0; i < 16; ++i) ab[c][i] = g0[i];
    }
    int cc[16];
    sel::cand_top16(ab[0], ab[1], cc, rs);
#pragma unroll
    for (int i = 0; i < 16; ++i) { lscr[i * 64 + lane] = ab[0][i] & 127; lscr[(16 + i) * 64 + lane] = ab[1][i] & 127; }
    LDS_WAIT();
    float val[16], e[16]; int eid[16];
#pragma unroll
    for (int k = 0; k < 16; ++k) { const int code = cc[k] & 255; const int i = code >> 4, j = code & 15; val[k] = sel::key2f(cc[k] & ~255);
        eid[k] = lscr[i * 64 + lane] * 128 + lscr[(16 + j) * 64 + lane]; }
    float sum = 0.f;
#pragma unroll
    for (int k = 0; k < 16; ++k) { e[k] = __expf(val[k] - val[0]); sum += e[k]; }
    const float inv = 1.0f / sum;
    int* ip = IDS + (size_t)t * 128 + hp * 16 + hi * 8; float* gp = GATES + (size_t)t * 128 + hp * 16 + hi * 8;
    v4u i0, i1; f32x4 q0, q1;
    i0.x = hi ? eid[8] : eid[0]; i0.y = hi ? eid[9] : eid[1]; i0.z = hi ? eid[10] : eid[2]; i0.w = hi ? eid[11] : eid[3];
    i1.x = hi ? eid[12] : eid[4]; i1.y = hi ? eid[13] : eid[5]; i1.z = hi ? eid[14] : eid[6]; i1.w = hi ? eid[15] : eid[7];
    q0.x = (hi ? e[8] : e[0]) * inv; q0.y = (hi ? e[9] : e[1]) * inv; q0.z = (hi ? e[10] : e[2]) * inv; q0.w = (hi ? e[11] : e[3]) * inv;
    q1.x = (hi ? e[12] : e[4]) * inv; q1.y = (hi ? e[13] : e[5]) * inv; q1.z = (hi ? e[14] : e[6]) * inv; q1.w = (hi ? e[15] : e[7]) * inv;
    *(v4u*)ip = i0; *(v4u*)(ip + 4) = i1; *(f32x4*)gp = q0; *(f32x4*)(gp + 4) = q1;
    LDS_WAIT();
}

typedef float f32x2 __attribute__((ext_vector_type(2)));
typedef float v16f __attribute__((ext_vector_type(16)));
typedef float v32f __attribute__((ext_vector_type(32)));
typedef unsigned v6u __attribute__((ext_vector_type(6)));
__device__ __forceinline__ int fp6_order_probe() {
    v16f a, b;
#pragma unroll
    for (int j = 0; j < 16; ++j) { a[j] = 0.25f * (float)(j + 1); b[j] = -0.25f * (float)(j + 1); }
    asm volatile("" : "+v"(a), "+v"(b));
    const v6u w = __builtin_amdgcn_cvt_scalef32_2xpk16_fp6_f32(a, b, 1.0f);
    const v32f d = __builtin_amdgcn_cvt_scalef32_pk32_f32_fp6(w, 1.0f);
    bool okA = true, okB = true;
#pragma unroll
    for (int j = 0; j < 16; ++j) { okA = okA && (d[j] == a[j]) && (d[16 + j] == b[j]); okB = okB && (d[2 * j] == a[j]) && (d[2 * j + 1] == b[j]); }
    return okA ? 0 : (okB ? 1 : -1);
}
__device__ __forceinline__ void row_fp6_load(const float* src, f32x4 (&v)[8], int lane) {
    const f32x4* xr = (const f32x4*)src + lane;
#pragma unroll
    for (int j = 0; j < 8; ++j) v[j] = __builtin_nontemporal_load(xr + 64 * j);
}
__device__ __forceinline__ void row_fp6_finish(const f32x4 (&v)[8], unsigned char* dst  , float* scale_out, int order, int lane) {
    float am = 0.f;
#pragma unroll
    for (int j = 0; j < 8; ++j) am = fmaxf(am, fmaxf(fmaxf(fabsf(v[j].x), fabsf(v[j].y)), fmaxf(fabsf(v[j].z), fabsf(v[j].w))));
#pragma unroll
    for (int o = 1; o < 64; o <<= 1) am = fmaxf(am, SHX(am, o));
    float q = am > 0.f ? 7.5f / am : 0.f;
    if (order < 0) q = __builtin_nanf("");
    if (lane == 0) *scale_out = am * (1.0f / 7.5f);
    float c[32];
#pragma unroll
    for (int j = 0; j < 8; ++j) { c[4 * j] = v[j].x * q; c[4 * j + 1] = v[j].y * q; c[4 * j + 2] = v[j].z * q; c[4 * j + 3] = v[j].w * q; }
    v16f a, b;
#pragma unroll
    for (int i = 0; i < 16; ++i) { a[i] = (order == 1) ? c[2 * i] : c[i]; b[i] = (order == 1) ? c[2 * i + 1] : c[16 + i]; }
    const v6u w = __builtin_amdgcn_cvt_scalef32_2xpk16_fp6_f32(a, b, 1.0f);
    *(v4u*)(dst + lane * 16) = (v4u){w[0], w[1], w[2], w[3]};
    *(v2u*)(dst + 1024 + lane * 8) = (v2u){w[4], w[5]};
}
__device__ __forceinline__ int fp4_order_probe() {
    float a = 1.0f, b = 2.0f; asm volatile("" : "+v"(a), "+v"(b));
    const unsigned w = __builtin_amdgcn_cvt_scalef32_pk_fp4_f32(0u, a, b, 1.0f, 2);
    const f32x2 d = __builtin_amdgcn_cvt_scalef32_pk_f32_fp4(w, 1.0f, 2);
    return (d.x == 1.0f && d.y == 2.0f) ? 0 : ((d.x == 2.0f && d.y == 1.0f) ? 1 : -1);
}
__device__ __forceinline__ void row_fp4_finish(const f32x4 (&v)[8], unsigned char* dst  , float* scale_out, int order, int lane) {
    float am = 0.f;
#pragma unroll
    for (int j = 0; j < 8; ++j) am = fmaxf(am, fmaxf(fmaxf(fabsf(v[j].x), fabsf(v[j].y)), fmaxf(fabsf(v[j].z), fabsf(v[j].w))));
#pragma unroll
    for (int o = 1; o < 64; o <<= 1) am = fmaxf(am, SHX(am, o));
    float q = am > 0.f ? 6.0f / am : 0.f;
    if (order < 0) q = __builtin_nanf("");
    if (lane == 0) *scale_out = am * (1.0f / 6.0f);
    unsigned w[4];
#pragma unroll
    for (int d = 0; d < 4; ++d) { unsigned t = 0u;
        const float e0 = v[2 * d].x * q, e1 = v[2 * d].y * q, e2 = v[2 * d].z * q, e3 = v[2 * d].w * q, e4 = v[2 * d + 1].x * q, e5 = v[2 * d + 1].y * q, e6 = v[2 * d + 1].z * q, e7 = v[2 * d + 1].w * q;
        t = __builtin_amdgcn_cvt_scalef32_pk_fp4_f32(t, order ? e1 : e0, order ? e0 : e1, 1.0f, 0);
        t = __builtin_amdgcn_cvt_scalef32_pk_fp4_f32(t, order ? e3 : e2, order ? e2 : e3, 1.0f, 1);
        t = __builtin_amdgcn_cvt_scalef32_pk_fp4_f32(t, order ? e5 : e4, order ? e4 : e5, 1.0f, 2);
        t = __builtin_amdgcn_cvt_scalef32_pk_fp4_f32(t, order ? e7 : e6, order ? e6 : e7, 1.0f, 3);
        w[d] = t; }
    *(v4u*)(dst + lane * 16) = (v4u){w[0], w[1], w[2], w[3]};
}
__device__ __forceinline__ void row_i4_finish(const f32x4 (&v)[8], unsigned char* dst  , float* scale_out, int lane, bool sliced = false) {
    float ss = 0.f;
#pragma unroll
    for (int j = 0; j < 8; ++j) ss += (v[j].x * v[j].x + v[j].y * v[j].y) + (v[j].z * v[j].z + v[j].w * v[j].w);
    const float sig = sqrtf(wave_sum(ss, lane) * (1.f / 2048.f));
    const float q = sig > 0.f ? 7.0f / (2.5f * sig) : 0.f;
    if (lane == 0) *scale_out = sig * (2.5f / 7.0f);
    unsigned w[4];
    const float MAGIC = 12582912.0f;
#pragma unroll
    for (int d = 0; d < 4; ++d) {
        const float e[8] = {v[2 * d].x, v[2 * d].y, v[2 * d].z, v[2 * d].w, v[2 * d + 1].x, v[2 * d + 1].y, v[2 * d + 1].z, v[2 * d + 1].w};
        unsigned b[8];
#pragma unroll
        for (int n = 0; n < 8; ++n) b[n] = __builtin_bit_cast(unsigned, __builtin_amdgcn_fmed3f(__builtin_fmaf(e[n], q, MAGIC), MAGIC - 8.0f, MAGIC + 7.0f));
        const unsigned p02 = __builtin_amdgcn_perm(b[2], b[0], 0x0c0c0400u), p46 = __builtin_amdgcn_perm(b[6], b[4], 0x0c0c0400u), p13 = __builtin_amdgcn_perm(b[3], b[1], 0x0c0c0400u), p57 = __builtin_amdgcn_perm(b[7], b[5], 0x0c0c0400u);
        const unsigned E = (p46 << 16) | p02, O = (p57 << 16) | p13;
        w[d] = (E & 0x0F0F0F0Fu) | ((O << 4) & 0xF0F0F0F0u); }
    *(v4u*)(dst + (sliced ? (size_t)(lane / (64 / V_SLICES)) * ((size_t)NEXP * (1024 / V_SLICES)) + (lane & (64 / V_SLICES - 1)) * 16 : (size_t)lane * 16)) = (v4u){w[0], w[1], w[2], w[3]};
}
__device__ __forceinline__ void gather_token(const bf16* xin  , float* xrow  , const float* fg  , const int* ids, const float* gates,
                                             const unsigned char* UT, const unsigned char* VT, const float* USC, const float* VSC, bf16* xn_out  , float* rs_out  , int lane,
                                             const float* cv_src = nullptr  , size_t cv_vofs = 0, unsigned char* cv_du = nullptr, unsigned char* cv_dv = nullptr, float* cv_su = nullptr, float* cv_sv = nullptr, int cv_r0 = 0, int f4ord = 0, int f6ord = 0, LAS unsigned char* cv_lds = nullptr  ) {
    f32x2 h[16], acc[16]; float ss = 0.f;
#pragma unroll
    for (int j = 0; j < 8; ++j) { const v2u bw = *(const v2u*)(xin + j * 256 + lane * 4); const f32x4 a = (f32x4){bflo(bw.x), bfhi(bw.x), bflo(bw.y), bfhi(bw.y)};
        h[2 * j] = (f32x2){a.x, a.y}; h[2 * j + 1] = (f32x2){a.z, a.w}; acc[2 * j] = h[2 * j]; acc[2 * j + 1] = h[2 * j + 1];
        ss += (a.x * a.x + a.y * a.y) + (a.z * a.z + a.w * a.w); }
    const float r = 1.0f / sqrtf(wave_sum(ss, lane) * (1.f / 2048.f) + EPS);
#pragma unroll
    for (int j = 0; j < 8; ++j) { const f32x4 a = *(const f32x4*)(fg + j * 256 + lane * 4);
        h[2 * j] *= (f32x2){a.x * r, a.y * r}; h[2 * j + 1] *= (f32x2){a.z * r, a.w * r}; }
    typedef _Float16 h2_t __attribute__((ext_vector_type(2)));
    h2_t h16[16];
#pragma unroll
    for (int j = 0; j < 16; ++j) { h16[j].x = (_Float16)h[j].x; h16[j].y = (_Float16)h[j].y; }
    const int id_lo = ids[lane], id_hi = ids[64 + lane];
    const float ua_lo = USC[id_lo], ua_hi = USC[id_hi];
    const float gb_lo = gates[lane] * VSC[id_lo], gb_hi = gates[64 + lane] * VSC[id_hi];
    constexpr int GB = GATHER_BATCH;
#define CV_SRC(r) ((r) >= NEXP ? cv_src + cv_vofs + (size_t)((r) - NEXP) * DM : cv_src + (size_t)(r) * DM)
#define CV_LOAD(r) do { const float* sp_ = CV_SRC(r); _Pragma("unroll") for (int j_ = 0; j_ < 8; ++j_) __builtin_amdgcn_global_load_lds((const unsigned*)(sp_ + j_ * 256 + lane * 4), (LAS unsigned*)(cv_lds + j_ * 1024), 16, 0, 2); } while (0)
#define CV_FIN(r) do { asm volatile("s_waitcnt vmcnt(0)" ::: "memory"); f32x4 cvr[8]; _Pragma("unroll") for (int j_ = 0; j_ < 8; ++j_) cvr[j_] = *(const LAS f32x4*)(cv_lds + j_ * 1024 + lane * 16); \
        const bool isv_ = (r) >= NEXP; const int rr_ = isv_ ? (r) - NEXP : (r); \
        if ((isv_ && V_FP4) || (!isv_ && U_FP4)) row_fp4_finish(cvr, (isv_ ? cv_dv + (size_t)rr_ * VROWB : cv_du + (size_t)rr_ * UROWB), (isv_ ? cv_sv : cv_su) + rr_, f4ord, lane); \
        else row_fp6_finish(cvr, (isv_ ? cv_dv + (size_t)rr_ * VROWB : cv_du + (size_t)rr_ * UROWB), (isv_ ? cv_sv : cv_su) + rr_, f6ord, lane); asm volatile("s_waitcnt lgkmcnt(0)" ::: "memory"); } while (0)
    if (cv_src) CV_LOAD(cv_r0);
    for (int kk = 0; kk < 128; kk += GB) {
        if (cv_src && kk > 0 && (kk & 31) == 0) { const int rdone = cv_r0 + (kk >> 5) - 1; CV_FIN(rdone); CV_LOAD(rdone + 1); }
        v4u ua[GB], va[GB]; v2u ub[GB], vb[GB];
#pragma unroll
        for (int e = 0; e < GB; ++e) { const int k = kk + e;
            const int id = __builtin_amdgcn_readlane(kk < 64 ? id_lo : id_hi, k & 63);
            const unsigned char* ur = UT + (size_t)id * UROWB; const unsigned char* vr = VT + (size_t)id * VROWB;
            ua[e] = *(const v4u*)(ur + lane * 16); if (!U_FP4) ub[e] = *(const v2u*)(ur + 1024 + lane * 8); va[e] = *(const v4u*)(vr + lane * 16); if (!V_FP4) vb[e] = *(const v2u*)(vr + 1024 + lane * 8); }
        float d[GB];
#pragma unroll
        for (int e = 0; e < GB; ++e) { f32x2 dd = (f32x2){0.f, 0.f};
            if (U_FP4) {
                const unsigned uw[4] = {ua[e].x, ua[e].y, ua[e].z, ua[e].w}; float da = 0.f;
#pragma unroll
                for (int dq = 0; dq < 4; ++dq) { da = __builtin_amdgcn_fdot2(h16[4 * dq], __builtin_amdgcn_cvt_scalef32_pk_f16_fp4(uw[dq], 1.0f, 0), da, false); da = __builtin_amdgcn_fdot2(h16[4 * dq + 1], __builtin_amdgcn_cvt_scalef32_pk_f16_fp4(uw[dq], 1.0f, 1), da, false);
                    da = __builtin_amdgcn_fdot2(h16[4 * dq + 2], __builtin_amdgcn_cvt_scalef32_pk_f16_fp4(uw[dq], 1.0f, 2), da, false); da = __builtin_amdgcn_fdot2(h16[4 * dq + 3], __builtin_amdgcn_cvt_scalef32_pk_f16_fp4(uw[dq], 1.0f, 3), da, false); }
                dd.x = da;
            } else {
                const v32f u = __builtin_amdgcn_cvt_scalef32_pk32_f32_fp6((v6u){ua[e].x, ua[e].y, ua[e].z, ua[e].w, ub[e].x, ub[e].y}, 1.0f);
#pragma unroll
                for (int j = 0; j < 16; ++j) dd += h[j] * (f32x2){u[2 * j], u[2 * j + 1]};
            }
            d[e] = dd.x + dd.y; __builtin_amdgcn_sched_barrier(0); }
#pragma unroll
        for (int step = 1, n = GB; n > 1; step <<= 1, n >>= 1) {
            const bool bb = (lane & step) != 0;
#pragma unroll
            for (int i = 0; i < n / 2; ++i) { const float keep = bb ? d[2 * i + 1] : d[2 * i], send = bb ? d[2 * i] : d[2 * i + 1]; d[i] = keep + SHX(send, step); }
        }
        float s = d[0];
#pragma unroll
        for (int step = GB; step < 64; step <<= 1) s += SHX(s, step);
        const int src = (kk & 63) + (lane & (GB - 1));
        const float a = s * shi_(kk < 64 ? ua_lo : ua_hi, src);
        const float wv = shi_(kk < 64 ? gb_lo : gb_hi, src) * 0.5f * a * (1.0f + erff(a * 0.70710678118654752f));
#pragma unroll
        for (int e = 0; e < GB; ++e) { const float we = __builtin_bit_cast(float, __builtin_amdgcn_readlane(__builtin_bit_cast(int, wv), e)); const f32x2 w2 = (f32x2){we, we};
            if (V_FP4) {
                const unsigned vw[4] = {va[e].x, va[e].y, va[e].z, va[e].w};
#pragma unroll
                for (int dq = 0; dq < 4; ++dq) { acc[4 * dq] += w2 * __builtin_amdgcn_cvt_scalef32_pk_f32_fp4(vw[dq], 1.0f, 0); acc[4 * dq + 1] += w2 * __builtin_amdgcn_cvt_scalef32_pk_f32_fp4(vw[dq], 1.0f, 1);
                    acc[4 * dq + 2] += w2 * __builtin_amdgcn_cvt_scalef32_pk_f32_fp4(vw[dq], 1.0f, 2); acc[4 * dq + 3] += w2 * __builtin_amdgcn_cvt_scalef32_pk_f32_fp4(vw[dq], 1.0f, 3); }
            } else {
                const v32f vv = __builtin_amdgcn_cvt_scalef32_pk32_f32_fp6((v6u){va[e].x, va[e].y, va[e].z, va[e].w, vb[e].x, vb[e].y}, 1.0f);
#pragma unroll
                for (int j = 0; j < 16; ++j) acc[j] += w2 * (f32x2){vv[2 * j], vv[2 * j + 1]};
            }
            __builtin_amdgcn_sched_barrier(0); }
    }
    if (cv_src) { CV_FIN(cv_r0 + 3); }
#undef CV_SRC
#undef CV_FIN
#undef CV_LOAD
    int ln2 = lane; asm volatile("" : "+v"(ln2));
    if (xrow) {
#pragma unroll
        for (int j = 0; j < 8; ++j) *(f32x4*)(xrow + j * 256 + ln2 * 4) = (f32x4){acc[2 * j].x, acc[2 * j].y, acc[2 * j + 1].x, acc[2 * j + 1].y};
    }
    if (xn_out) {
        float s2 = 0.f;
#pragma unroll
        for (int j = 0; j < 16; ++j) s2 += acc[j].x * acc[j].x + acc[j].y * acc[j].y;
        const float r2 = 1.0f / sqrtf(wave_sum(s2, lane) * (1.f / 2048.f) + EPS);
        if (ln2 == 0) *rs_out = r2;
#pragma unroll
        for (int j = 0; j < 8; ++j) { v2u w0; w0.x = pk2(acc[2 * j].x, acc[2 * j].y); w0.y = pk2(acc[2 * j + 1].x, acc[2 * j + 1].y);
            *(v2u*)(xn_out + j * 256 + ln2 * 4) = w0; }
    }
}

__device__ __forceinline__ void gather_u(const bf16* xin, const float* fg, const int* ids, const float* gates, const unsigned char* UT, const float* USC, const float* VSC, float* wexp, int lane, int idmask = 0x7fffffff  , int* wpl = nullptr  , float* swi = nullptr  ) {
    static_assert(U_I4 && V_FP4, "split gather: int4 u rows, fp4 v rows");
    float wk_lo = 0.f, wk_hi = 0.f;
    float hx[32]; float ss = 0.f;
#pragma unroll
    for (int j = 0; j < 8; ++j) { const v2u bw = *(const v2u*)(xin + j * 256 + lane * 4); hx[4 * j] = bflo(bw.x); hx[4 * j + 1] = bfhi(bw.x); hx[4 * j + 2] = bflo(bw.y); hx[4 * j + 3] = bfhi(bw.y);
        ss += (hx[4 * j] * hx[4 * j] + hx[4 * j + 1] * hx[4 * j + 1]) + (hx[4 * j + 2] * hx[4 * j + 2] + hx[4 * j + 3] * hx[4 * j + 3]); }
    const float r = 1.0f / sqrtf(wave_sum(ss, lane) * (1.f / 2048.f) + EPS);
    float hm = 0.f;
#pragma unroll
    for (int j = 0; j < 8; ++j) { const f32x4 a = *(const f32x4*)(fg + j * 256 + lane * 4);
        hx[4 * j] *= a.x * r; hx[4 * j + 1] *= a.y * r; hx[4 * j + 2] *= a.z * r; hx[4 * j + 3] *= a.w * r;
        hm = fmaxf(hm, fmaxf(fmaxf(fabsf(hx[4 * j]), fabsf(hx[4 * j + 1])), fmaxf(fabsf(hx[4 * j + 2]), fabsf(hx[4 * j + 3])))); }
#pragma unroll
    for (int o = 1; o < 64; o <<= 1) hm = fmaxf(hm, SHX(hm, o));
    const float sh = hm > 0.f ? 119.0f / hm : 0.f, shinv = hm * (1.0f / 119.0f);
    unsigned hiP[4], loP[4];
#pragma unroll
    for (int d = 0; d < 4; ++d) { unsigned th = 0u, tl = 0u;
#pragma unroll
        for (int n = 0; n < 8; ++n) { const int hq = (int)rintf(hx[8 * d + n] * sh); const int hi_ = (hq + 8) >> 4, lo_ = hq - 16 * hi_; th |= ((unsigned)hi_ & 15u) << (4 * n); tl |= ((unsigned)lo_ & 15u) << (4 * n); }
        hiP[d] = th; loP[d] = tl; }
    const int id_lo = ids[lane] & idmask, id_hi = ids[64 + lane] & idmask;
    const float ua_lo = USC[id_lo] * shinv, ua_hi = USC[id_hi] * shinv;
    const float gb_lo = gates[lane] * VSC[id_lo], gb_hi = gates[64 + lane] * VSC[id_hi];
    constexpr int GB = 16;
    for (int kk = 0; kk < 128; kk += GB) {
        v4u ua[GB];
#pragma unroll
        for (int e = 0; e < GB; ++e) { const int id = __builtin_amdgcn_readlane(kk < 64 ? id_lo : id_hi, (kk + e) & 63); ua[e] = *(const v4u*)(UT + (size_t)id * UROWB + lane * 16); }
        float d[GB];
#pragma unroll
        for (int e = 0; e < GB; ++e) {
            int ah = __builtin_amdgcn_sdot8((int)ua[e].x, (int)hiP[0], 0, false), al = __builtin_amdgcn_sdot8((int)ua[e].x, (int)loP[0], 0, false);
            ah = __builtin_amdgcn_sdot8((int)ua[e].y, (int)hiP[1], ah, false); al = __builtin_amdgcn_sdot8((int)ua[e].y, (int)loP[1], al, false);
            ah = __builtin_amdgcn_sdot8((int)ua[e].z, (int)hiP[2], ah, false); al = __builtin_amdgcn_sdot8((int)ua[e].z, (int)loP[2], al, false);
            ah = __builtin_amdgcn_sdot8((int)ua[e].w, (int)hiP[3], ah, false); al = __builtin_amdgcn_sdot8((int)ua[e].w, (int)loP[3], al, false);
            d[e] = (float)(16 * ah + al); }
#pragma unroll
        for (int step = 1, n = GB; n > 1; step <<= 1, n >>= 1) {
            const bool bb = (lane & step) != 0;
#pragma unroll
            for (int i = 0; i < n / 2; ++i) { const float keep = bb ? d[2 * i + 1] : d[2 * i], send = bb ? d[2 * i] : d[2 * i + 1]; d[i] = keep + SHX(send, step); }
        }
        float s = d[0];
        s += SHX(s, 16); s += SHX(s, 32);
        const int src = (kk & 63) + (lane & 15);
        const float a = s * shi_(kk < 64 ? ua_lo : ua_hi, src);
        const float wv = shi_(kk < 64 ? gb_lo : gb_hi, src) * 0.5f * a * (1.0f + erff(a * 0.70710678118654752f));
#if V_SLICED
        if ((lane >> 4) == ((kk >> 4) & 3)) { if (kk < 64) wk_lo = wv; else wk_hi = wv; }
#else
        if (lane < 16) wexp[kk + lane] = wv;
#endif
    }
#if V_SLICED
    {
        float wm = fmaxf(fabsf(wk_lo), fabsf(wk_hi));
#pragma unroll
        for (int o = 1; o < 64; o <<= 1) wm = fmaxf(wm, SHX(wm, o));
        const float sw = wm > 0.f ? 119.0f / wm : 0.f;
        const int sh4 = 4 * (lane & 7);
        const int q0 = (int)rintf(wk_lo * sw), q1 = (int)rintf(wk_hi * sw);
        const int h0 = (q0 + 8) >> 4, l0 = q0 - 16 * h0, h1 = (q1 + 8) >> 4, l1 = q1 - 16 * h1;
        int PHlo = (int)(((unsigned)h0 & 15u) << sh4), PLlo = (int)(((unsigned)l0 & 15u) << sh4), PHhi = (int)(((unsigned)h1 & 15u) << sh4), PLhi = (int)(((unsigned)l1 & 15u) << sh4);
#pragma unroll
        for (int o = 1; o < 8; o <<= 1) { PHlo |= SHX(PHlo, o); PLlo |= SHX(PLlo, o); PHhi |= SHX(PHhi, o); PLhi |= SHX(PLhi, o); }
        if ((lane & 7) == 0) { *(v2u*)(wpl + 2 * (lane >> 3)) = (v2u){(unsigned)PHlo, (unsigned)PLlo}; *(v2u*)(wpl + 16 + 2 * (lane >> 3)) = (v2u){(unsigned)PHhi, (unsigned)PLhi}; }
        if (lane == 0) *swi = wm * (1.0f / 119.0f);
    }
#endif
}
__device__ __forceinline__ void gather_v(const bf16* xin, float* xrow, const float* wexp, const int* ids, const unsigned char* VT, bf16* xn_out, float* rs_out, int lane,
                                         const float* cv_src, size_t cv_vofs, unsigned char* cv_du, unsigned char* cv_dv, float* cv_su, float* cv_sv, int cv_r0, int f4ord, int f6ord, LAS unsigned char* cv_lds, int idmask = 0x7fffffff  ) {
#if V_I4
    int accH[32], accL[32];
#pragma unroll
    for (int j = 0; j < 32; ++j) { accH[j] = 0; accL[j] = 0; }
    const int id_lo = ids[lane] & idmask, id_hi = ids[64 + lane] & idmask;
    const float w_lo = wexp[lane], w_hi = wexp[64 + lane];
    float wm = fmaxf(fabsf(w_lo), fabsf(w_hi));
#pragma unroll
    for (int o = 1; o < 64; o <<= 1) wm = fmaxf(wm, SHX(wm, o));
    const float sw = wm > 0.f ? 119.0f / wm : 0.f, swinv = wm * (1.0f / 119.0f);
    int PHlo, PLlo, PHhi, PLhi;
    { const int sh4 = 4 * (lane & 7);
      const int q0 = (int)rintf(w_lo * sw), q1 = (int)rintf(w_hi * sw);
      const int h0 = (q0 + 8) >> 4, l0 = q0 - 16 * h0, h1 = (q1 + 8) >> 4, l1 = q1 - 16 * h1;
      PHlo = (int)(((unsigned)h0 & 15u) << sh4); PLlo = (int)(((unsigned)l0 & 15u) << sh4); PHhi = (int)(((unsigned)h1 & 15u) << sh4); PLhi = (int)(((unsigned)l1 & 15u) << sh4);
#pragma unroll
      for (int o = 1; o < 8; o <<= 1) { PHlo |= SHX(PHlo, o); PLlo |= SHX(PLlo, o); PHhi |= SHX(PHhi, o); PLhi |= SHX(PLhi, o); } }
#else
    typedef _Float16 h2_t __attribute__((ext_vector_type(2)));
    h2_t dacc[16];
#pragma unroll
    for (int j = 0; j < 16; ++j) dacc[j] = (h2_t){(_Float16)0.f, (_Float16)0.f};
    const int id_lo = ids[lane], id_hi = ids[64 + lane];
    const float w_lo = wexp[lane], w_hi = wexp[64 + lane];
#endif
#define CV_SRC(r) ((r) >= NEXP ? cv_src + cv_vofs + (size_t)((r) - NEXP) * DM : cv_src + (size_t)(r) * DM)
#define CV_LOAD(r) do { const float* sp_ = CV_SRC(r); _Pragma("unroll") for (int j_ = 0; j_ < 8; ++j_) __builtin_amdgcn_global_load_lds((const unsigned*)(sp_ + j_ * 256 + lane * 4), (LAS unsigned*)(cv_lds + j_ * 1024), 16, 0, 2); } while (0)
#define CV_FIN(r) do { asm volatile("s_waitcnt vmcnt(0)" ::: "memory"); f32x4 cvr[8]; _Pragma("unroll") for (int j_ = 0; j_ < 8; ++j_) cvr[j_] = *(const LAS f32x4*)(cv_lds + j_ * 1024 + lane * 16); \
        const bool isv_ = (r) >= NEXP; const int rr_ = isv_ ? (r) - NEXP : (r); \
        if ((U_I4 && !isv_) || (V_I4 && isv_)) row_i4_finish(cvr, (isv_ ? cv_dv + (size_t)rr_ * VROWB : cv_du + (size_t)rr_ * UROWB), (isv_ ? cv_sv : cv_su) + rr_, lane); else row_fp4_finish(cvr, (isv_ ? cv_dv + (size_t)rr_ * VROWB : cv_du + (size_t)rr_ * UROWB), (isv_ ? cv_sv : cv_su) + rr_, f4ord, lane); asm volatile("s_waitcnt lgkmcnt(0)" ::: "memory"); } while (0)
    if (cv_src) CV_LOAD(cv_r0);
    constexpr int GB = 16;
    for (int kk = 0; kk < 128; kk += GB) {
        if (cv_src && kk > 0 && (kk & 31) == 0) { const int rdone = cv_r0 + (kk >> 5) - 1; CV_FIN(rdone); CV_LOAD(rdone + 1); }
        v4u va[GB];
#pragma unroll
        for (int e = 0; e < GB; ++e) { const int id = __builtin_amdgcn_readlane(kk < 64 ? id_lo : id_hi, (kk + e) & 63); va[e] = *(const v4u*)(VT + (size_t)id * VROWB + lane * 16); }
#if V_I4
#pragma unroll
        for (int g = 0; g < GB / 8; ++g) {
            const int ph = __builtin_amdgcn_readlane(kk < 64 ? PHlo : PHhi, (kk & 63) + 8 * g), pl = __builtin_amdgcn_readlane(kk < 64 ? PLlo : PLhi, (kk & 63) + 8 * g);
#pragma unroll
            for (int d = 0; d < 4; ++d) {
                unsigned a[8], s1[8], s2[8];
#pragma unroll
                for (int k = 0; k < 8; ++k) a[k] = d == 0 ? va[8 * g + k].x : (d == 1 ? va[8 * g + k].y : (d == 2 ? va[8 * g + k].z : va[8 * g + k].w));
#pragma unroll
                for (int m = 0; m < 4; ++m) { const unsigned x = a[2 * m], y = a[2 * m + 1];
                    s1[2 * m] = (x & 0x0F0F0F0Fu) | ((y << 4) & 0xF0F0F0F0u); s1[2 * m + 1] = ((x >> 4) & 0x0F0F0F0Fu) | (y & 0xF0F0F0F0u); }
#pragma unroll
                for (int r = 0; r < 8; ++r) if (!(r & 2)) { s2[r] = __builtin_amdgcn_perm(s1[r | 2], s1[r], 0x06020400u); s2[r | 2] = __builtin_amdgcn_perm(s1[r | 2], s1[r], 0x07030501u); }
#pragma unroll
                for (int r = 0; r < 8; ++r) if (!(r & 4)) { const unsigned t0 = __builtin_amdgcn_perm(s2[r | 4], s2[r], 0x05040100u), t1 = __builtin_amdgcn_perm(s2[r | 4], s2[r], 0x07060302u);
                    accH[8 * d + r] = __builtin_amdgcn_sdot8((int)t0, ph, accH[8 * d + r], false); accL[8 * d + r] = __builtin_amdgcn_sdot8((int)t0, pl, accL[8 * d + r], false);
                    accH[8 * d + (r | 4)] = __builtin_amdgcn_sdot8((int)t1, ph, accH[8 * d + (r | 4)], false); accL[8 * d + (r | 4)] = __builtin_amdgcn_sdot8((int)t1, pl, accL[8 * d + (r | 4)], false); }
            }
            __builtin_amdgcn_sched_barrier(0);
        }
#else
#pragma unroll
        for (int e = 0; e < GB; ++e) { const float we = __builtin_bit_cast(float, __builtin_amdgcn_readlane(__builtin_bit_cast(int, kk < 64 ? w_lo : w_hi), (kk + e) & 63)); const h2_t w2 = (h2_t){(_Float16)we, (_Float16)we};
            const unsigned vw[4] = {va[e].x, va[e].y, va[e].z, va[e].w};
#pragma unroll
            for (int dq = 0; dq < 4; ++dq) { dacc[4 * dq] = __builtin_elementwise_fma(w2, __builtin_bit_cast(h2_t, __builtin_amdgcn_cvt_scalef32_pk_f16_fp4(vw[dq], 1.0f, 0)), dacc[4 * dq]); dacc[4 * dq + 1] = __builtin_elementwise_fma(w2, __builtin_bit_cast(h2_t, __builtin_amdgcn_cvt_scalef32_pk_f16_fp4(vw[dq], 1.0f, 1)), dacc[4 * dq + 1]);
                dacc[4 * dq + 2] = __builtin_elementwise_fma(w2, __builtin_bit_cast(h2_t, __builtin_amdgcn_cvt_scalef32_pk_f16_fp4(vw[dq], 1.0f, 2)), dacc[4 * dq + 2]); dacc[4 * dq + 3] = __builtin_elementwise_fma(w2, __builtin_bit_cast(h2_t, __builtin_amdgcn_cvt_scalef32_pk_f16_fp4(vw[dq], 1.0f, 3)), dacc[4 * dq + 3]); }
            __builtin_amdgcn_sched_barrier(0); }
#endif
    }
    if (cv_src) { CV_FIN(cv_r0 + 3); }
#undef CV_SRC
#undef CV_FIN
#undef CV_LOAD
    (void)f6ord;
    int ln2 = lane; asm volatile("" : "+v"(ln2));
    f32x2 acc[16];
#pragma unroll
    for (int j = 0; j < 8; ++j) { const v2u bw = *(const v2u*)(xin + j * 256 + ln2 * 4);
#if V_I4
        acc[2 * j] = (f32x2){bflo(bw.x) + (float)(16 * accH[4 * j] + accL[4 * j]) * swinv, bfhi(bw.x) + (float)(16 * accH[4 * j + 1] + accL[4 * j + 1]) * swinv};
        acc[2 * j + 1] = (f32x2){bflo(bw.y) + (float)(16 * accH[4 * j + 2] + accL[4 * j + 2]) * swinv, bfhi(bw.y) + (float)(16 * accH[4 * j + 3] + accL[4 * j + 3]) * swinv}; }
#else
        acc[2 * j] = (f32x2){bflo(bw.x) + (float)dacc[2 * j].x, bfhi(bw.x) + (float)dacc[2 * j].y}; acc[2 * j + 1] = (f32x2){bflo(bw.y) + (float)dacc[2 * j + 1].x, bfhi(bw.y) + (float)dacc[2 * j + 1].y}; }
#endif
    if (xrow) {
#pragma unroll
        for (int j = 0; j < 8; ++j) *(f32x4*)(xrow + j * 256 + ln2 * 4) = (f32x4){acc[2 * j].x, acc[2 * j].y, acc[2 * j + 1].x, acc[2 * j + 1].y};
    }
    if (xn_out) {
        float s2 = 0.f;
#pragma unroll
        for (int j = 0; j < 16; ++j) s2 += acc[j].x * acc[j].x + acc[j].y * acc[j].y;
        const float st2 = wave_sum(s2, lane);
        if (ln2 < 8) rs_out[ln2] = ln2 == 0 ? st2 : 0.f;
#pragma unroll
        for (int j = 0; j < 8; ++j) { v2u w0; w0.x = pk2(acc[2 * j].x, acc[2 * j].y); w0.y = pk2(acc[2 * j + 1].x, acc[2 * j + 1].y);
            *(v2u*)(xn_out + j * 256 + ln2 * 4) = w0; }
    }
}

#if V_SLICED
__device__ __forceinline__ void gather_v_sliced(bf16* xrows  , float* xout  , const int* WPL, const float* SWI, const int* IDS, const unsigned char* VT,
                                                float* ssq  , int uidx, int x, int lane,
                                                const float* cv_src, size_t cv_vofs, unsigned char* cv_du, unsigned char* cv_dv, float* cv_su, float* cv_sv, int cv_r0, int f4ord, LAS unsigned char* cv_lds) {
    static_assert(V_I4 && U_I4, "sliced v sub-pass: int4 tables");
    constexpr int LPT = 64 / V_SLICES, TPW = V_SLICES, SROW = 1024 / V_SLICES;
    const int c = lane & (LPT - 1), L = LPT * x + c, m = TPW * uidx + lane / LPT;
    int accH[32], accL[32];
#pragma unroll
    for (int j = 0; j < 32; ++j) { accH[j] = 0; accL[j] = 0; }
    const int* idp = IDS + (size_t)m * 128; const int* wp = WPL + (size_t)m * 32;
    const unsigned lofs = (unsigned)c * 16u;
#define CV_SRC(r) ((r) >= NEXP ? cv_src + cv_vofs + (size_t)((r) - NEXP) * DM : cv_src + (size_t)(r) * DM)
#define CV_LOAD(r, slot) do { const float* sp_ = CV_SRC(r); _Pragma("unroll") for (int j_ = 0; j_ < 8; ++j_) __builtin_amdgcn_global_load_lds((const unsigned*)(sp_ + j_ * 256 + lane * 4), (LAS unsigned*)(cv_lds + (slot) * 8192 + j_ * 1024), 16, 0, 2); } while (0)
#define CV_FIN(r, slot) do { asm volatile("s_waitcnt vmcnt(0)" ::: "memory"); f32x4 cvr[8]; _Pragma("unroll") for (int j_ = 0; j_ < 8; ++j_) cvr[j_] = *(const LAS f32x4*)(cv_lds + (slot) * 8192 + j_ * 1024 + lane * 16); \
        const bool isv_ = (r) >= NEXP; const int rr_ = isv_ ? (r) - NEXP : (r); \
        row_i4_finish(cvr, (isv_ ? cv_dv + (size_t)rr_ * SROW : cv_du + (size_t)rr_ * UROWB), (isv_ ? cv_sv : cv_su) + rr_, lane, isv_); asm volatile("s_waitcnt lgkmcnt(0)" ::: "memory"); } while (0)
    typedef int v4i_ __attribute__((ext_vector_type(4)));
    v4i_ idn[4], pln;
#pragma unroll
    for (int q = 0; q < 4; ++q) idn[q] = *(const v4i_*)(idp + 4 * q);
    pln = *(const v4i_*)wp;
    constexpr int GB = 16;
    for (int kk = 0; kk < 128; kk += GB) {
        const int idc[16] = {idn[0].x, idn[0].y, idn[0].z, idn[0].w, idn[1].x, idn[1].y, idn[1].z, idn[1].w, idn[2].x, idn[2].y, idn[2].z, idn[2].w, idn[3].x, idn[3].y, idn[3].z, idn[3].w};
        const int plc[4] = {pln.x, pln.y, pln.z, pln.w};
        v4u va[GB];
#pragma unroll
        for (int e = 0; e < GB; ++e) va[e] = *(const v4u*)(VT + (size_t)((unsigned)idc[e] * (unsigned)SROW + lofs));
        { const int kn = kk + GB < 128 ? kk + GB : kk;
#pragma unroll
          for (int q = 0; q < 4; ++q) idn[q] = *(const v4i_*)(idp + kn + 4 * q);
          pln = *(const v4i_*)(wp + (kn >> 2)); }
#pragma unroll
        for (int g = 0; g < GB / 8; ++g) {
            const int ph = plc[2 * g], pl = plc[2 * g + 1];
#pragma unroll
            for (int d = 0; d < 4; ++d) {
                unsigned a[8], s1[8], s2[8];
#pragma unroll
                for (int k = 0; k < 8; ++k) a[k] = d == 0 ? va[8 * g + k].x : (d == 1 ? va[8 * g + k].y : (d == 2 ? va[8 * g + k].z : va[8 * g + k].w));
#pragma unroll
                for (int mm = 0; mm < 4; ++mm) { const unsigned xx = a[2 * mm], yy = a[2 * mm + 1];
                    s1[2 * mm] = (xx & 0x0F0F0F0Fu) | ((yy << 4) & 0xF0F0F0F0u); s1[2 * mm + 1] = ((xx >> 4) & 0x0F0F0F0Fu) | (yy & 0xF0F0F0F0u); }
#pragma unroll
                for (int r = 0; r < 8; ++r) if (!(r & 2)) { s2[r] = __builtin_amdgcn_perm(s1[r | 2], s1[r], 0x06020400u); s2[r | 2] = __builtin_amdgcn_perm(s1[r | 2], s1[r], 0x07030501u); }
#pragma unroll
                for (int r = 0; r < 8; ++r) if (!(r & 4)) { const unsigned t0 = __builtin_amdgcn_perm(s2[r | 4], s2[r], 0x05040100u), t1 = __builtin_amdgcn_perm(s2[r | 4], s2[r], 0x07060302u);
                    accH[8 * d + r] = __builtin_amdgcn_sdot8((int)t0, ph, accH[8 * d + r], false); accL[8 * d + r] = __builtin_amdgcn_sdot8((int)t0, pl, accL[8 * d + r], false);
                    accH[8 * d + (r | 4)] = __builtin_amdgcn_sdot8((int)t1, ph, accH[8 * d + (r | 4)], false); accL[8 * d + (r | 4)] = __builtin_amdgcn_sdot8((int)t1, pl, accL[8 * d + (r | 4)], false); }
            }
            __builtin_amdgcn_sched_barrier(0);
        }
    }
#undef CV_FIN
#undef CV_LOAD
    (void)f4ord;
    int L2_ = L, m2_ = m; asm volatile("" : "+v"(L2_), "+v"(m2_));
    f32x4 cra[8], crb[8], crc[8], crd[8];
    if (cv_src) { int ln_ = lane; asm volatile("" : "+v"(ln_)); row_fp6_load(CV_SRC(cv_r0), cra, ln_); row_fp6_load(CV_SRC(cv_r0 + 1), crb, ln_); row_fp6_load(CV_SRC(cv_r0 + 2), crc, ln_); row_fp6_load(CV_SRC(cv_r0 + 3), crd, ln_); }
    const float swinv = SWI[m2_];
    bf16* xr = xrows + (size_t)m2_ * DM + 4 * L2_;
    f32x2 acc[16];
#pragma unroll
    for (int j = 0; j < 8; ++j) { const v2u bw = *(const v2u*)(xr + j * 256);
        acc[2 * j] = (f32x2){bflo(bw.x) + (float)(16 * accH[4 * j] + accL[4 * j]) * swinv, bfhi(bw.x) + (float)(16 * accH[4 * j + 1] + accL[4 * j + 1]) * swinv};
        acc[2 * j + 1] = (f32x2){bflo(bw.y) + (float)(16 * accH[4 * j + 2] + accL[4 * j + 2]) * swinv, bfhi(bw.y) + (float)(16 * accH[4 * j + 3] + accL[4 * j + 3]) * swinv}; }
    if (xout) {
        float* xo_ = xout + (size_t)m2_ * DM + 4 * L2_;
#pragma unroll
        for (int j = 0; j < 8; ++j) *(f32x4*)(xo_ + j * 256) = (f32x4){acc[2 * j].x, acc[2 * j].y, acc[2 * j + 1].x, acc[2 * j + 1].y};
    } else {
        float sq = 0.f;
#pragma unroll
        for (int j = 0; j < 16; ++j) sq += acc[j].x * acc[j].x + acc[j].y * acc[j].y;
#pragma unroll
        for (int o = 1; o < LPT; o <<= 1) sq += SHX(sq, o);
        if ((L2_ & (LPT - 1)) == 0) {
#pragma unroll
            for (int q = 0; q < 8 / V_SLICES; ++q) ssq[(size_t)m2_ * 8 + L2_ / LPT + q * V_SLICES] = q == 0 ? sq : 0.f; }
#pragma unroll
        for (int j = 0; j < 8; ++j) { v2u w0; w0.x = pk2(acc[2 * j].x, acc[2 * j].y); w0.y = pk2(acc[2 * j + 1].x, acc[2 * j + 1].y); *(v2u*)(xr + j * 256) = w0; }
    }
    if (cv_src) {
#define CV_FINR(V, r) do { const bool isv_ = (r) >= NEXP; const int rr_ = isv_ ? (r) - NEXP : (r); \
        row_i4_finish(V, (isv_ ? cv_dv + (size_t)rr_ * SROW : cv_du + (size_t)rr_ * UROWB), (isv_ ? cv_sv : cv_su) + rr_, lane, isv_); } while (0)
        CV_FINR(cra, cv_r0); CV_FINR(crb, cv_r0 + 1); CV_FINR(crc, cv_r0 + 2); CV_FINR(crd, cv_r0 + 3);
#undef CV_FINR
#undef CV_SRC
    }
}
#endif

__device__ __forceinline__ int lane_id_volatile() { int l_; asm volatile("v_mbcnt_lo_u32_b32 %0, -1, 0\n\tv_mbcnt_hi_u32_b32 %0, -1, %0" : "=v"(l_)); return l_; }
struct Args { const float* in[16]; float* out; unsigned char* ws; int ph_lo, ph_hi; };
constexpr int NPL = 7 + V_SLICED, NPH = 2 + DEPTH * NPL;

__global__ void __launch_bounds__(NWAVES * 64, 2) mk_fwd(Args args) {
    extern __shared__ __attribute__((aligned(16))) unsigned char lds[];
    LAS unsigned char* ldsl = (LAS unsigned char*)lds;
    volatile LAS unsigned* MISC = (volatile LAS unsigned*)(ldsl + MISC_OFF);
    const int G = gridDim.x; const int bx = blockIdx.x; const int vcu = (G % 8 == 0) ? (bx % 8) * (G / 8) + bx / 8 : bx;
    const int NGW = G * NWAVES;
    const int wave_s = __builtin_amdgcn_readfirstlane((int)threadIdx.x >> 6);
#define CAS __attribute__((address_space(4)))
#define GIN(k) ((const float*)(const GAS float*)ap->in[k])
#define PH_BEGIN() \
    int lane_; asm volatile("v_mbcnt_lo_u32_b32 %0, -1, 0\n\tv_mbcnt_hi_u32_b32 %0, -1, %0" : "=v"(lane_)); const int lane = lane_, wave = wave_s, tid = wave_s * 64 + lane_; const int gw = vcu * NWAVES + wave; \
    const CAS Args* ap = (const CAS Args*)__builtin_amdgcn_kernarg_segment_ptr(); asm volatile("" : "+s"(ap)); \
    GAS unsigned char* wsg = (GAS unsigned char*)ap->ws; unsigned char* ws = (unsigned char*)wsg; \
    const float* x_in = GIN(0); float* xo = (float*)(GAS float*)ap->out; \
    bf16* WTIN = (bf16*)(ws + WS_WTIN); bf16* WTOUT = (bf16*)(ws + WS_WTOUT); bf16* WTPQ = (bf16*)(ws + WS_WTPQ); bf16* WTKV = (bf16*)(ws + WS_WTKV); \
    bf16* XN = (bf16*)(ws + WS_XN); bf16* PROJ = (bf16*)(ws + WS_PROJ); bf16* OD = (bf16*)(ws + WS_OD); bf16* MIX = (bf16*)(ws + WS_MIX); bf16* PQ = (bf16*)(ws + WS_PQ); \
    unsigned char* UTAB = ws + WS_UTAB; unsigned char* VTAB = ws + WS_VTAB; float* USC = (float*)(ws + WS_USC); float* VSC = (float*)(ws + WS_VSC); bf16* KEYS = (bf16*)(ws + WS_KEYS); \
    bf16* MEMN = (bf16*)(ws + WS_MEMN); bf16* MEMKV = (bf16*)(ws + WS_MEMKV); \
    float* ROPEC = (float*)(ws + WS_ROPE); float* ROPES = ROPEC + 4096 * 16; \
    int* IDS = (int*)(ws + WS_IDS); float* GATES = (float*)(ws + WS_GATES); float* SSP = (float*)(ws + WS_SSP); float* RS = (float*)(ws + WS_RS); float* WEXP = (float*)(ws + WS_WEXP); \
    const float* xcur = (l == 0) ? x_in : xo; const float* gq = GIN(4) + (size_t)l * 6 * 128; \
    (void)lane; (void)gw; (void)x_in; (void)xo; (void)WTIN; (void)WTOUT; (void)WTPQ; (void)WTKV; (void)XN; (void)PROJ; (void)OD; (void)MIX; (void)PQ; (void)UTAB; (void)VTAB; (void)USC; (void)VSC; (void)KEYS; (void)MEMN; (void)MEMKV; (void)ROPEC; (void)ROPES; (void)IDS; (void)GATES; (void)SSP; (void)RS; (void)WEXP; (void)xcur; (void)gq;
    for (int u = (int)threadIdx.x; u < (LDS_BYTES - LDSCTL_OFF) / 4; u += NWAVES * 64) ((LAS unsigned*)(ldsl + LDSCTL_OFF))[u] = 0u;
    __syncthreads();
    const int lo = args.ph_lo, hi = args.ph_hi;
    XcdBarrier bar; bar.bar = (unsigned*)(args.ws + WS_CTL) + CW_BAR; bar.x = 0; bar.st = nullptr;
    if (hi - lo > 1) bar = xcd_barrier_post((unsigned*)(args.ws + WS_CTL) + CW_BAR, MISC + 8, threadIdx.x == 0);
#define IN(k) (lo <= (k) && (k) < hi)
#define T0() (wave_s == 0 && lane_id_volatile() == 0)
#define SEAM(k) do { if (IN(k) && IN((k) + 1)) xcd_barrier(bar, T0()); } while (0)

    if (PHEN(10) && IN(0)) for (int rep_ = 0; rep_ < PREP(10); ++rep_) { const int l = 0; PH_BEGIN();
        LAS float* scr = (LAS float*)(ldsl + wave * 16384);
        constexpr int I_IN = 32 * 160, I_OUT = 32 * 64, I_PQ = 32 * 64, I_KV = 32 * 32, I_L = I_IN + I_OUT + I_PQ + I_KV;
        for (int rep2_ = 0; rep2_ < PREP(12); ++rep2_)
        for (int it = gw; it < DEPTH * I_L; it += NGW) {
            const int l = it / I_L; int r = it % I_L;
            if (r < I_IN) { transpose_item(GIN(3) + (size_t)l * DM * INW, GIN(2) + l * DM, DM, INW, WTIN + (size_t)l * INW * DM, scr, r, lane); continue; } r -= I_IN;
            if (r < I_OUT) { transpose_item(GIN(10) + (size_t)l * MIXW * DM, nullptr, MIXW, DM, WTOUT + (size_t)l * DM * MIXW, scr, r, lane); continue; } r -= I_OUT;
            if (r < I_PQ) { transpose_item(GIN(12) + (size_t)l * DM * DM, GIN(11) + l * DM, DM, DM, WTPQ + (size_t)l * DM * DM, scr, r, lane); continue; } r -= I_PQ;
            transpose_item(GIN(9) + (size_t)l * DM * KVW, GIN(8) + l * DM, DM, KVW, WTKV + (size_t)l * KVW * DM, scr, r, lane);
        }
        for (int m = gw; m < NB * NMEM; m += NGW) rms_row_to_bf16(GIN(1) + (size_t)m * DM, MEMN + (size_t)m * DM, lane);
    }
    SEAM(0);
    if (PHEN(11) && IN(1)) { const int l = 0; PH_BEGIN();
        constexpr int NGEMM_ = (NB * NMEM / 256) * (DEPTH * KVW / 256);
        const int Gall = gridDim.x; const bool split_ = Gall > NGEMM_;
        if (!split_ || bx >= NGEMM_) {
            const int vcu = split_ ? bx - NGEMM_ : bx, G = split_ ? Gall - NGEMM_ : Gall; const int gw = vcu * NWAVES + wave, NGW = G * NWAVES;
        const int f6ord = fp6_order_probe(); const int f4ord = fp4_order_probe(); (void)f4ord;
        if (vcu == 0 && tid == 0) { ((int*)ws)[64] = f6ord; ((int*)ws)[65] = f4ord; }
        for (int rep3_ = 0; rep3_ < PREP(13); ++rep3_)
        for (int rw = gw; rw < 2 * NEXP; rw += 4 * NGW) {
            f32x4 va[8], vb[8], vc[8], vd[8];
            const int r1 = rw + NGW, r2 = rw + 2 * NGW, r3 = rw + 3 * NGW; const int NR = 2 * NEXP;
#define TSRC(r) (((r) >= NEXP ? GIN(15) + (size_t)((r) - NEXP) * DM : GIN(14) + (size_t)(r) * DM))
#define TDST(r) (((r) >= NEXP ? VTAB + (size_t)((r) - NEXP) * (V_SLICED ? 1024 / V_SLICES : VROWB) : UTAB + (size_t)(r) * UROWB))
#define TSCL(r) (((r) >= NEXP ? VSC + ((r) - NEXP) : USC + (r)))
            row_fp6_load(TSRC(rw), va, lane); if (r1 < NR) row_fp6_load(TSRC(r1), vb, lane); if (r2 < NR) row_fp6_load(TSRC(r2), vc, lane); if (r3 < NR) row_fp6_load(TSRC(r3), vd, lane);
#define TFIN(V, r) do { if ((U_I4 && (r) < NEXP) || (V_I4 && (r) >= NEXP)) row_i4_finish(V, TDST(r), TSCL(r), lane, V_SLICED && (r) >= NEXP); else if ((U_FP4 && (r) < NEXP) || (V_FP4 && (r) >= NEXP)) row_fp4_finish(V, TDST(r), TSCL(r), f4ord, lane); else row_fp6_finish(V, TDST(r), TSCL(r), f6ord, lane); } while (0)
            TFIN(va, rw); if (r1 < NR) TFIN(vb, r1); if (r2 < NR) TFIN(vc, r2); if (r3 < NR) TFIN(vd, r3);
#undef TFIN
#undef TSRC
#undef TDST
#undef TSCL
        }
        {
            const size_t gt = (size_t)vcu * (NWAVES * 64) + tid, NT_ = (size_t)G * NWAVES * 64;
            const size_t nk8 = (size_t)DEPTH * 8 * 2 * 128 * 128 / 8;
            for (size_t i = gt; i < nk8; i += NT_) {
                const float* src = GIN(13);
                const f32x4 a = *(const f32x4*)(src + i * 8), b = *(const f32x4*)(src + i * 8 + 4);
                v4u o; o.x = pk2(a.x, a.y); o.y = pk2(a.z, a.w); o.z = pk2(b.x, b.y); o.w = pk2(b.z, b.w);
                *(v4u*)(KEYS + i * 8) = o;
            }
            for (size_t i = gt; i < 4096 * 16; i += NT_) {
                const int pos = (int)(i >> 4), fi = (int)(i & 15);
                const double inv = exp2(-(double)fi * (18.931568569324174 / 16.0));
                const double rev = (double)pos * inv * 0.15915494309189535;
                const float fr = (float)(rev - floor(rev));
                ROPEC[i] = __builtin_amdgcn_cosf(fr); ROPES[i] = __builtin_amdgcn_sinf(fr);
            }
        }
        for (int m = gw; m < T; m += NGW) row_to_bf16_rs(x_in + (size_t)m * DM, XN + (size_t)m * DM, RS + (size_t)m * 8, lane);
        }
        pg8::Gemm g{MEMN, WTKV, NB * NMEM, DEPTH * KVW, DM}; pg8::StaticOrder S; S.init(NB * NMEM, DEPTH * KVW, Gall, bx);
        EpiProjT<true> E{MEMKV, GIN(4), nullptr, nullptr, (LAS float*)(ldsl + EPI_P_OFF), 0, nullptr};
        pg8::gemm_phase<EpiProjT<true>, pg8::StaticOrder, false>((PG8_LAS unsigned char*)ldsl, g, S, E, nullptr, tid);
    }
    SEAM(1);

    for (int l = 0; l < DEPTH; ++l) {
        const int pb = 2 + l * NPL;
        const float lam_init = 0.8f - 0.6f * expf(-0.3f * (float)l);
        if (PHEN(0) && IN(pb + 0)) { PH_BEGIN();
            for (int rep_ = 0; rep_ < PREP(0); ++rep_) {
            pg8::Gemm g{XN, WTIN + (size_t)l * INW * DM + (size_t)OFF_NQ * DM, T, INW - OFF_NQ, DM}; pg8::StaticOrder S; S.init(T, INW - OFF_NQ, G, bx);
            EpiProj E{PROJ, gq, ROPEC, ROPES, (LAS float*)(ldsl + EPI_P_OFF), OFF_NQ / 256, RS};
            pg8::gemm_phase<EpiProj, pg8::StaticOrder, false>((PG8_LAS unsigned char*)ldsl, g, S, E, nullptr, tid); }
        }
        SEAM(pb + 0);
        if (PHEN(3) && IN(pb + 1)) for (int rep_ = 0; rep_ < PREP(3); ++rep_) { PH_BEGIN();
            {
            pg8::Gemm g{XN, WTIN + (size_t)l * INW * DM, T, OFF_NQ, DM}; pg8::StaticOrder S; S.init(T, OFF_NQ, G, bx);
            EpiProj E{PROJ, gq, ROPEC, ROPES, (LAS float*)(ldsl + EPI_P_OFF), 0, RS};
            pg8::gemm_phase<EpiProj, pg8::StaticOrder, false>((PG8_LAS unsigned char*)ldsl, g, S, E, nullptr, tid);
            }
            float negm;
            { float a4 = fmaxf(fabsf(gq[512 + lane]), fabsf(gq[576 + lane])), a5 = fmaxf(fabsf(gq[640 + lane]), fabsf(gq[704 + lane]));
#pragma unroll
              for (int o = 1; o < 64; o <<= 1) { a4 = fmaxf(a4, SHX(a4, o)); a5 = fmaxf(a5, SHX(a5, o)); }
              negm = -11.313708498984761f * a4 * a5 * 1.4426950408889634f; }
            const int nshort = (G > 128) ? 128 : 0;
            for (int u = (nshort ? bx - (G - 128) : bx); u >= 0 && u < 128; u += (nshort ? 128 : G)) {
                const int rb = u & 15, h = (u >> 4) & 3, b = u >> 6; const int r0 = rb * 4, kr0 = min(max(r0 - 4, 0), 52);
                __syncthreads();
                if (tid < 465) ((float*)(lds + att::SHM_NA_BIAS))[tid] = GIN(7)[((size_t)l * 4 + h) * 465 + tid] * 1.4426950408889634f;
                att::attn_body<1, 1, INW, INW, INW, MIXW, true>(PROJ + (size_t)(b * SEQ + r0 * 64) * INW + OFF_NQ + h * 128,
                    PROJ + (size_t)(b * SEQ + kr0 * 64) * INW + OFF_NK + h * 128, PROJ + (size_t)(b * SEQ + kr0 * 64) * INW + OFF_NV + h * 128,
                    MIX + (size_t)(b * SEQ + r0 * 64) * MIXW + 1024 + h * 128, 768, (char*)lds, r0, kr0, 0.f, tid);
            }
            for (int u = (nshort ? bx - (G - 128) : bx); u >= 0 && u < 128; u += (nshort ? 128 : G)) {
                const int qb = u & 15, h = (u >> 4) & 3, b = u >> 6;
                __syncthreads();
                att::attn_body<0, 2, INW, DEPTH * KVW, DEPTH * KVW, MIXW, true>(PROJ + (size_t)(b * SEQ + qb * 256) * INW + OFF_MQ + h * 128,
                    MEMKV + (size_t)(b * NMEM) * (DEPTH * KVW) + l * KVW + h * 128, MEMKV + (size_t)(b * NMEM) * (DEPTH * KVW) + l * KVW + 512 + h * 128,
                    MIX + (size_t)(b * SEQ + qb * 256) * MIXW + 1536 + h * 128, NMEM, (char*)lds, 0, 0, negm, tid);
            }
            __syncthreads();
        }
        SEAM(pb + 1);
        if (PHEN(4) && IN(pb + 2)) for (int rep_ = 0; rep_ < PREP(4); ++rep_) { PH_BEGIN();
            float negd;
            { float a0 = fmaxf(fabsf(gq[lane]), fabsf(gq[64 + lane])), a1 = fmaxf(fabsf(gq[128 + lane]), fabsf(gq[192 + lane]));
#pragma unroll
              for (int o = 1; o < 64; o <<= 1) { a0 = fmaxf(a0, SHX(a0, o)); a1 = fmaxf(a1, SHX(a1, o)); }
              negd = -11.313708498984761f * a0 * a1 * 1.4426950408889634f; }
            for (int u = vcu; u < 256; u += G) {
                const int qb = u & 15, c = (u >> 4) & 1, h = (u >> 5) & 3, b = u >> 7;
                __syncthreads();
                att::attn_wide_body<INW, INW, INW, 1024>(PROJ + (size_t)(b * SEQ + qb * 256) * INW + OFF_DQ + h * 256 + c * 128,
                    PROJ + (size_t)(b * SEQ) * INW + OFF_DK + h * 256 + c * 128, PROJ + (size_t)(b * SEQ) * INW + OFF_DV + h * 256,
                    OD + ((size_t)c * T + b * SEQ + qb * 256) * 1024 + h * 256, SEQ, ldsl, (char*)lds, negd, tid);
            }
            __syncthreads();
        }
        SEAM(pb + 2);
        if (PHEN(6) && IN(pb + 3)) { PH_BEGIN();
            const float* lq = GIN(5) + (size_t)l * 4 * 128;
            const float d01 = wave_sum(lq[lane] * lq[128 + lane] + lq[64 + lane] * lq[192 + lane], lane);
            const float d23 = wave_sum(lq[256 + lane] * lq[384 + lane] + lq[320 + lane] * lq[448 + lane], lane);
            const float lam = expf(d01) - expf(d23) + lam_init;
            const float* sg_ = GIN(6) + (size_t)l * 256; const int sub = lane & 15, h = lane >> 4;
            float gs[16];
#pragma unroll
            for (int j = 0; j < 16; ++j) gs[j] = sg_[sub * 16 + j] * (1.0f - lam_init);
            for (int m = gw; m < T; m += NGW) {
                const bf16* o0 = OD + (size_t)m * 1024 + h * 256 + sub * 16; const bf16* o1 = o0 + (size_t)T * 1024;
                float v[16]; float s = 0.f;
#pragma unroll
                for (int q = 0; q < 2; ++q) { const v4u a = *(const v4u*)(o0 + q * 8), b2 = *(const v4u*)(o1 + q * 8);
                    v[q * 8 + 0] = bflo(a.x) - lam * bflo(b2.x); v[q * 8 + 1] = bfhi(a.x) - lam * bfhi(b2.x); v[q * 8 + 2] = bflo(a.y) - lam * bflo(b2.y); v[q * 8 + 3] = bfhi(a.y) - lam * bfhi(b2.y);
                    v[q * 8 + 4] = bflo(a.z) - lam * bflo(b2.z); v[q * 8 + 5] = bfhi(a.z) - lam * bfhi(b2.z); v[q * 8 + 6] = bflo(a.w) - lam * bflo(b2.w); v[q * 8 + 7] = bfhi(a.w) - lam * bfhi(b2.w); }
#pragma unroll
                for (int j = 0; j < 16; ++j) s += v[j] * v[j];
                s += SHX(s, 1); s += SHX(s, 2); s += SHX(s, 4); s += SHX(s, 8);
                const float r = 1.0f / sqrtf(s * (1.f / 256.f) + EPS);
                v4u w0, w1;
                w0.x = pk2(v[0] * r * gs[0], v[1] * r * gs[1]); w0.y = pk2(v[2] * r * gs[2], v[3] * r * gs[3]); w0.z = pk2(v[4] * r * gs[4], v[5] * r * gs[5]); w0.w = pk2(v[6] * r * gs[6], v[7] * r * gs[7]);
                w1.x = pk2(v[8] * r * gs[8], v[9] * r * gs[9]); w1.y = pk2(v[10] * r * gs[10], v[11] * r * gs[11]); w1.z = pk2(v[12] * r * gs[12], v[13] * r * gs[13]); w1.w = pk2(v[14] * r * gs[14], v[15] * r * gs[15]);
                bf16* mp = MIX + (size_t)m * MIXW + h * 256 + sub * 16;
                *(v4u*)mp = w0; *(v4u*)(mp + 8) = w1;
            }
        }
        SEAM(pb + 3);
        if (PHEN(5) && IN(pb + 4)) { PH_BEGIN();
            pg8::Gemm g{MIX, WTOUT + (size_t)l * DM * MIXW, T, DM, MIXW}; pg8::StaticOrder S; S.init(T, DM, G, bx);
            EpiResF32 E{XN, SSP, DM};
            pg8::gemm_phase<EpiResF32, pg8::StaticOrder, false>((PG8_LAS unsigned char*)ldsl, g, S, E, nullptr, tid);
        }
        SEAM(pb + 4);
        if (PHEN(7) && IN(pb + 5)) for (int rep_ = 0; rep_ < PREP(7); ++rep_) { PH_BEGIN();
            pg8::Gemm g{XN, WTPQ + (size_t)l * DM * DM, T, DM, DM}; pg8::StaticOrder S; S.init(T, DM, G, bx);
            pg8::EpiBf16<0> E{PQ, DM, nullptr, 0, 0};
            pg8::gemm_phase<pg8::EpiBf16<0>, pg8::StaticOrder, false>((PG8_LAS unsigned char*)ldsl, g, S, E, nullptr, tid);
            LAS int* lscr = (LAS int*)(ldsl + 65536 + wave * 8192);
            if (G == (T / 256) * (DM / 256)) {
                pg8::Unit u; S.next(0, u);
                asm volatile("s_waitcnt vmcnt(0)" ::: "memory"); __syncthreads();
                {
                    const bf16* ksrc_ = KEYS + ((size_t)l * 8 + u.pn) * 2 * 128 * 128;
#pragma unroll
                    for (int i = 0; i < 8; ++i) { const int ch = i * 512 + tid; const int row = ch >> 4, cc = ch & 15;
                        const v4u kv = *(const v4u*)(ksrc_ + (size_t)row * 128 + cc * 8);
                        *(v4u*)(lds + (row >> 6) * 16384 + (row & 63) * 256 + ((cc * 16) ^ ((row & 7) << 4))) = kv; }
                }
                __syncthreads();
                select_task<true>(PQ, SSP, KEYS + (size_t)l * 8 * 2 * 128 * 128, IDS, GATES, u.pm * 8 + wave, u.pn, lscr, lane, (const char*)lds);
            } else if (hi - lo > 1) {
                xcd_barrier(bar, T0());
                for (int task = gw; task < (T / 32) * 8; task += NGW) select_task<false>(PQ, SSP, KEYS + (size_t)l * 8 * 2 * 128 * 128, IDS, GATES, task >> 3, task & 7, lscr, lane);
            }
        }
        SEAM(pb + 5);
        if (PHEN(9) && IN(pb + 6)) { PH_BEGIN();
            const int f6g = ((const int*)ws)[64], f4g = ((const int*)ws)[65];
#if GATHER_SPLIT
#if V_SLICED
            for (int m = gw; m < T; m += NGW) gather_u(XN + (size_t)m * DM, GIN(11) + (size_t)l * DM, IDS + (size_t)m * 128, GATES + (size_t)m * 128, UTAB + (size_t)l * NEXP * UROWB, USC + l * NEXP, VSC + l * NEXP, nullptr, lane, 0x7fffffff,
                                                       (int*)WEXP + (size_t)m * 32, WEXP + (size_t)T * 32 + m);
        }
        SEAM(pb + 6);
        if (PHEN(9) && IN(pb + 7)) { PH_BEGIN();
            const int f4g = ((const int*)ws)[65];
            const int NSW = NGW / V_SLICES;
            const int xs = gw / NSW;
#if PROBE_VL2
            for (int uidx = gw - xs * NSW; uidx < T / V_SLICES; uidx += NSW)
                gather_v_sliced(XN, (float*)PROJ, (const int*)WEXP, WEXP + (size_t)T * 32, IDS, VTAB + (size_t)l * NEXP * VROWB + (size_t)xs * NEXP * (1024 / V_SLICES), RS, uidx, xs, lane, nullptr, 0, nullptr, nullptr, nullptr, nullptr, 0, f4g, ldsl + wave * 8192);
#endif
            for (int uidx = gw - xs * NSW; uidx < T / V_SLICES; uidx += NSW)
                gather_v_sliced(XN, (l + 1 == DEPTH) ? xo : nullptr, (const int*)WEXP, WEXP + (size_t)T * 32, IDS, VTAB + (size_t)l * NEXP * VROWB + (size_t)xs * NEXP * (1024 / V_SLICES), RS, uidx, xs, lane,
                                (l + 1 < DEPTH) ? GIN(14) + (size_t)(l + 1) * NEXP * DM : nullptr, (size_t)(GIN(15) - GIN(14)), UTAB + (size_t)(l + 1) * NEXP * UROWB, VTAB + (size_t)(l + 1) * NEXP * VROWB, USC + (l + 1) * NEXP, VSC + (l + 1) * NEXP,
                                4 * (xs * (T / V_SLICES) + uidx), f4g, ldsl + wave * 16384);
#else
            for (int m = gw; m < T; m += NGW) gather_u(XN + (size_t)m * DM, GIN(11) + (size_t)l * DM, IDS + (size_t)m * 128, GATES + (size_t)m * 128, UTAB + (size_t)l * NEXP * UROWB, USC + l * NEXP, VSC + l * NEXP, WEXP + (size_t)m * 128, lane);
            asm volatile("s_waitcnt vmcnt(0)" ::: "memory");
#if PROBE_VL2
            for (int m = gw; m < T; m += NGW) gather_v(XN + (size_t)m * DM, (float*)PROJ + (size_t)m * DM, WEXP + (size_t)m * 128, IDS + (size_t)m * 128, VTAB + (size_t)l * NEXP * VROWB, nullptr, RS + m, lane,
                                                       nullptr, 0, nullptr, nullptr, nullptr, nullptr, 0, f4g, f6g, ldsl + wave * 8192, PROBE_VL2 == 1 ? 0x7ff : 0x7fffffff);
#endif
            for (int m = gw; m < T; m += NGW) gather_v(XN + (size_t)m * DM, (l + 1 == DEPTH) ? xo + (size_t)m * DM : nullptr, WEXP + (size_t)m * 128, IDS + (size_t)m * 128, VTAB + (size_t)l * NEXP * VROWB,
                                                       (l + 1 < DEPTH) ? XN + (size_t)m * DM : nullptr, RS + (size_t)m * 8, lane,
                                                       (l + 1 < DEPTH) ? GIN(14) + (size_t)(l + 1) * NEXP * DM : nullptr, (size_t)(GIN(15) - GIN(14)), UTAB + (size_t)(l + 1) * NEXP * UROWB, VTAB + (size_t)(l + 1) * NEXP * VROWB, USC + (l + 1) * NEXP, VSC + (l + 1) * NEXP, 4 * m, f4g, f6g, ldsl + wave * 8192);
#endif
#else
            for (int rep_ = PREP(9) - 1; rep_ >= 0; --rep_)
            for (int m = gw; m < T; m += NGW) gather_token(XN + (size_t)m * DM, rep_ ? (float*)PROJ + (size_t)m * DM : ((l + 1 == DEPTH) ? xo + (size_t)m * DM : nullptr), GIN(11) + (size_t)l * DM, IDS + (size_t)m * 128, GATES + (size_t)m * 128,
                                                           UTAB + (size_t)l * NEXP * UROWB, VTAB + (size_t)l * NEXP * VROWB, USC + l * NEXP, VSC + l * NEXP, (l + 1 < DEPTH && !rep_) ? XN + (size_t)m * DM : nullptr, RS + m, lane,
                                                           (l + 1 < DEPTH && !rep_) ? GIN(14) + (size_t)(l + 1) * NEXP * DM : nullptr, (size_t)(GIN(15) - GIN(14)), UTAB + (size_t)(l + 1) * NEXP * UROWB, VTAB + (size_t)(l + 1) * NEXP * VROWB, USC + (l + 1) * NEXP, VSC + (l + 1) * NEXP, 4 * m, f4g, f6g, ldsl + wave * 8192);
#endif
        }
        SEAM(pb + 6 + V_SLICED);
        if (hi - lo > 1) for (int xb_ = 0; xb_ < (PREP(14) - 1) * 16; ++xb_) xcd_barrier(bar, T0());
    }
#undef IN
#undef SEAM
}

extern "C" void kernel_launch(void* const* d_in, const int* in_sizes, int n_in, void* d_out, int out_size, void* d_ws, size_t ws_size, hipStream_t stream) {
    static int grid = 0;
    if (grid == 0) {
        if (n_in != 16 || out_size != T * DM || ws_size < WS_END) { fprintf(stderr, "kernel_launch: unexpected shapes: n_in %d out %d ws %zu (need >= %zu)\n", n_in, out_size, ws_size, (size_t)WS_END); grid = -1; return; }
        int dev = 0, cus = 0, per_cu = 0;
        if (hipGetDevice(&dev) != hipSuccess || hipDeviceGetAttribute(&cus, hipDeviceAttributeMultiprocessorCount, dev) != hipSuccess) { grid = -1; return; }
        if (hipFuncSetAttribute((const void*)mk_fwd, hipFuncAttributeMaxDynamicSharedMemorySize, LDS_BYTES) != hipSuccess) { fprintf(stderr, "kernel_launch: hipFuncSetAttribute failed\n"); grid = -1; return; }
        if (hipOccupancyMaxActiveBlocksPerMultiprocessor(&per_cu, (const void*)mk_fwd, NWAVES * 64, LDS_BYTES) != hipSuccess || per_cu < 1) { fprintf(stderr, "kernel_launch: occupancy query says %d blocks per CU\n", per_cu); }
        (void)hipGetLastError();
        grid = cus;
    }
    if (grid < 0) return;
    if (hipMemsetAsync((char*)d_ws + WS_CTL, 0, CTL_ZERO_BYTES, stream) != hipSuccess) return;
    Args a{};
    for (int i = 0; i < 16; ++i) a.in[i] = (const float*)d_in[i];
    a.out = (float*)d_out; a.ws = (unsigned char*)d_ws;
#if MK_ONE_LAUNCH
    a.ph_lo = 0; a.ph_hi = NPH;
    hipLaunchKernelGGL(mk_fwd, dim3(grid), dim3(NWAVES * 64), LDS_BYTES, stream, a);
#else
    for (int p = 0; p < NPH; ++p) { a.ph_lo = p; a.ph_hi = p + 1; hipLaunchKernelGGL(mk_fwd, dim3(grid), dim3(NWAVES * 64), LDS_BYTES, stream, a); }
#endif
    const hipError_t le = hipPeekAtLastError();
    if (le != hipSuccess) fprintf(stderr, "kernel_launch: launch failed: %s\n", hipGetErrorName(le));
}
```
